# Optimizing an MI355X kernel written in HIP

```python
import jax, jax.numpy as jnp
from jax import lax
import numpy as np

D_MODEL = 1024
BATCH = 8
SEQ = 2048
DEPTH = 1

MLA_HEADS = 8
MLA_NOPE = 64
MLA_ROPE = 32
MLA_V = 64
Q_LORA = 384
KV_LORA = 256
ROPE_THETA = 10000.0
SWA_HEADS = 8
SWA_KV_HEADS = 2
SWA_HEAD_DIM = 64
WINDOW = 128
Q_BLOCK = 128
D_FF = 4 * D_MODEL
EPS = 1e-6
MIX_WIDTH = MLA_HEADS * MLA_V + SWA_HEADS * SWA_HEAD_DIM
SWA_Q_COLS = SWA_HEADS * SWA_HEAD_DIM
SWA_KV_COLS = SWA_KV_HEADS * SWA_HEAD_DIM
IN_COLS = Q_LORA + KV_LORA + MLA_ROPE + SWA_Q_COLS + 2 * SWA_KV_COLS
N_MOD = 6

kernel_name = "hybrid_mla_swa_sink_alibi_sqrelu_adaln"


def rmsnorm(x, g):
    xf = x.astype(jnp.float32)
    y = xf * lax.rsqrt(jnp.mean(xf * xf, axis=-1, keepdims=True) + EPS)
    return (y * g.astype(jnp.float32)).astype(x.dtype)


def rope(x, pos):
    r = x.shape[-1]
    freqs = ROPE_THETA ** (-jnp.arange(0, r, 2, dtype=jnp.float32) / r)
    ang = pos[:, None] * freqs[None, :]
    cos = jnp.cos(ang)[None, :, None, :]
    sin = jnp.sin(ang)[None, :, None, :]
    xf = x.astype(jnp.float32)
    x1, x2 = xf[..., : r // 2], xf[..., r // 2:]
    out = jnp.concatenate([x1 * cos - x2 * sin, x1 * sin + x2 * cos], axis=-1)
    return out.astype(x.dtype)


def alibi_slopes(n):
    return jnp.asarray([2.0 ** (-8.0 * (h + 1) / n) for h in range(n)], dtype=jnp.float32)


def mla_group(q_lat, kv_lat, k_rope, g_qa, w_qb, g_kva, w_kvb):
    b, s, _ = q_lat.shape
    q = jnp.einsum('bsr,rhd->bshd', rmsnorm(q_lat, g_qa), w_qb)
    kv = jnp.einsum('bsr,rhd->bshd', rmsnorm(kv_lat, g_kva), w_kvb)
    pos = jnp.arange(s, dtype=jnp.float32)
    q_nope = q[..., :MLA_NOPE]
    q_pe = rope(q[..., MLA_NOPE:], pos)
    k_nope = kv[..., :MLA_NOPE]
    v = kv[..., MLA_NOPE:]
    k_pe = rope(k_rope[:, :, None, :], pos)[:, :, 0, :]
    scale = (MLA_NOPE + MLA_ROPE) ** -0.5
    nb = s // Q_BLOCK
    qn_b = q_nope.reshape(b, nb, Q_BLOCK, MLA_HEADS, MLA_NOPE).transpose(1, 0, 2, 3, 4)
    qp_b = q_pe.reshape(b, nb, Q_BLOCK, MLA_HEADS, MLA_ROPE).transpose(1, 0, 2, 3, 4)
    kpos = jnp.arange(s)

    def block(args):
        i, qn, qp = args
        sc = (jnp.einsum('bqhd,bkhd->bhqk', qn, k_nope).astype(jnp.float32)
              + jnp.einsum('bqhd,bkd->bhqk', qp, k_pe).astype(jnp.float32)) * scale
        qpos = i * Q_BLOCK + jnp.arange(Q_BLOCK)
        causal = kpos[None, :] <= qpos[:, None]
        sc = jnp.where(causal[None, None], sc, -jnp.inf)
        p = jax.nn.softmax(sc, axis=-1).astype(v.dtype)
        return jnp.einsum('bhqk,bkhd->bqhd', p, v)

    out = lax.map(block, (jnp.arange(nb), qn_b, qp_b))
    return out.transpose(1, 0, 2, 3, 4).reshape(b, s, MLA_HEADS * MLA_V)


def swa_group(q, k, v, sinks):
    b, s, _ = q.shape
    nb = s // Q_BLOCK
    grp = SWA_HEADS // SWA_KV_HEADS
    qb = q.reshape(b, nb, Q_BLOCK, SWA_KV_HEADS, grp, SWA_HEAD_DIM)
    kb = k.reshape(b, nb, Q_BLOCK, SWA_KV_HEADS, SWA_HEAD_DIM)
    vb = v.reshape(b, nb, Q_BLOCK, SWA_KV_HEADS, SWA_HEAD_DIM)
    zpad = jnp.zeros_like(kb[:, :1])
    kw = jnp.concatenate([jnp.concatenate([zpad, kb[:, :-1]], axis=1), kb], axis=2)
    vw = jnp.concatenate([jnp.concatenate([zpad, vb[:, :-1]], axis=1), vb], axis=2)
    sc = jnp.einsum('bnqkgd,bnjkd->bnkgqj', qb, kw).astype(jnp.float32) * (SWA_HEAD_DIM ** -0.5)
    qi = jnp.arange(Q_BLOCK)[:, None] + Q_BLOCK
    kj = jnp.arange(2 * Q_BLOCK)[None, :]
    dist = qi - kj
    blk = jnp.arange(nb)
    valid = ((dist >= 0) & (dist < WINDOW))[None] & ((blk[:, None, None] > 0) | (kj[None] >= Q_BLOCK))
    slopes = alibi_slopes(SWA_HEADS).reshape(SWA_KV_HEADS, grp)
    sc = sc - slopes[:, :, None, None] * dist.astype(jnp.float32)[None, None]
    sc = jnp.where(valid[None, :, None, None], sc, -jnp.inf)
    sink = jnp.broadcast_to(sinks.astype(jnp.float32).reshape(1, 1, SWA_KV_HEADS, grp, 1, 1),
                            sc.shape[:-1] + (1,))
    p = jax.nn.softmax(jnp.concatenate([sc, sink], axis=-1), axis=-1)[..., :-1]
    out = jnp.einsum('bnkgqj,bnjkd->bnqkgd', p.astype(v.dtype), vw)
    return out.reshape(b, s, SWA_Q_COLS)


def setup_inputs(seed: int = 0) -> dict:
    key = jax.random.key(seed)
    ks = jax.random.split(key, 20)
    n = jax.random.normal
    f32 = jnp.float32
    return {
        "x": n(ks[0], (BATCH, SEQ, D_MODEL), f32),
        "c": n(ks[1], (BATCH, D_MODEL), f32),
        "w_ada": n(ks[2], (DEPTH, D_MODEL, N_MOD * D_MODEL), f32) * D_MODEL ** -0.5,
        "b_ada": n(ks[3], (DEPTH, N_MOD * D_MODEL), f32) * 0.02,
        "norm_mix_g": 1.0 + 0.05 * n(ks[4], (DEPTH, D_MODEL), f32),
        "w_in": n(ks[5], (DEPTH, D_MODEL, IN_COLS), f32) * D_MODEL ** -0.5,
        "g_qa": 1.0 + 0.05 * n(ks[6], (DEPTH, Q_LORA), f32),
        "w_qb": n(ks[7], (DEPTH, Q_LORA, MLA_HEADS, MLA_NOPE + MLA_ROPE), f32) * Q_LORA ** -0.5,
        "g_kva": 1.0 + 0.05 * n(ks[8], (DEPTH, KV_LORA), f32),
        "w_kvb": n(ks[9], (DEPTH, KV_LORA, MLA_HEADS, MLA_NOPE + MLA_V), f32) * KV_LORA ** -0.5,
        "sinks": 0.5 * n(ks[10], (DEPTH, SWA_HEADS), f32),
        "w_o": n(ks[11], (DEPTH, MIX_WIDTH, D_MODEL), f32) * MIX_WIDTH ** -0.5,
        "norm_mlp_g": 1.0 + 0.05 * n(ks[12], (DEPTH, D_MODEL), f32),
        "w_up": n(ks[13], (DEPTH, D_MODEL, D_FF), f32) * D_MODEL ** -0.5,
        "w_down": n(ks[14], (DEPTH, D_FF, D_MODEL), f32) * D_FF ** -0.5,
        "final_g": 1.0 + 0.05 * n(ks[15], (D_MODEL,), f32),
    }


def reference(x, c, w_ada, b_ada, norm_mix_g, w_in, g_qa, w_qb, g_kva, w_kvb, sinks,
              w_o, norm_mlp_g, w_up, w_down, final_g):
    o1 = Q_LORA
    o2 = o1 + KV_LORA
    o3 = o2 + MLA_ROPE
    o4 = o3 + SWA_Q_COLS
    o5 = o4 + SWA_KV_COLS
    silu_c = jax.nn.silu(c)
    for l in range(DEPTH):
        mod = jnp.einsum('bd,de->be', silu_c, w_ada[l]) + b_ada[l]
        sh1, sc1, g1, sh2, sc2, g2 = jnp.split(mod[:, None, :], N_MOD, axis=-1)
        h = rmsnorm(x, norm_mix_g[l]) * (1.0 + sc1) + sh1
        proj = jnp.einsum('bsd,de->bse', h, w_in[l])
        y_mla = mla_group(proj[..., :o1], proj[..., o1:o2], proj[..., o2:o3],
                          g_qa[l], w_qb[l], g_kva[l], w_kvb[l])
        y_swa = swa_group(proj[..., o3:o4], proj[..., o4:o5], proj[..., o5:], sinks[l])
        mix = jnp.concatenate([y_mla, y_swa], axis=-1)
        x = x + g1 * jnp.einsum('bse,ed->bsd', mix, w_o[l])
        h = rmsnorm(x, norm_mlp_g[l]) * (1.0 + sc2) + sh2
        u = jnp.square(jax.nn.relu(jnp.einsum('bsd,df->bsf', h, w_up[l])))
        x = x + g2 * jnp.einsum('bsf,fd->bsd', u, w_down[l])
    return rmsnorm(x, final_g)
```

```cpp
#include <hip/hip_runtime.h>
#include <hip/hip_cooperative_groups.h>
#include <cstdio>
#include <cstdint>
namespace cg = cooperative_groups;

#define LAS __attribute__((address_space(3)))
typedef unsigned short bf16_t;
typedef short bf16x8 __attribute__((ext_vector_type(8)));
typedef short s16x4 __attribute__((ext_vector_type(4)));
typedef float f32x4 __attribute__((ext_vector_type(4)));
typedef float f32x2 __attribute__((ext_vector_type(2)));
typedef float f32x16 __attribute__((ext_vector_type(16)));
typedef unsigned u32x4 __attribute__((ext_vector_type(4)));
typedef unsigned u32x2 __attribute__((ext_vector_type(2)));
typedef __bf16 bf2_t __attribute__((ext_vector_type(2)));

#ifndef MK_PER_PHASE
#define MK_PER_PHASE 0
#endif

constexpr int NB = 8, SEQ = 2048, DM = 1024, MT = NB * SEQ, FF = 4096;
constexpr int NPROJ = 1536, IN_COLS = 1440;
constexpr int QL = 384, KVL = 256;
constexpr int QW = 768, KVW = 1024;
constexpr float EPS = 1e-6f;
constexpr float LOG2E = 1.4426950408889634f;
constexpr float QSC_MLA = 0.10206207261596575f * LOG2E;
constexpr float QSC_SWA = 0.125f * LOG2E;

constexpr size_t MiB = 1u << 20;
constexpr size_t WS_MOD = 0, WS_SSQQ = 256 * 1024, WS_SSQKV = 320 * 1024, WS_ZERO_BYTES = 384 * 1024;
constexpr size_t WS_ROPE = 1 * MiB;
constexpr size_t WS_WIN = 2 * MiB, WS_WQB = 5 * MiB, WS_WKVB = 6 * MiB, WS_WO = 7 * MiB, WS_WUP = 9 * MiB, WS_WDN = 17 * MiB;
constexpr size_t WS_H = 25 * MiB, WS_PROJ = 57 * MiB, WS_Q = 105 * MiB, WS_KN = 129 * MiB, WS_VTM = 145 * MiB, WS_VTS = 161 * MiB, WS_MIX = 165 * MiB;
constexpr size_t WS_U = 57 * MiB;
constexpr size_t WS_END = 197 * MiB;
constexpr int LDS_BYTES = 131072;

__device__ __forceinline__ unsigned pk2(float lo, float hi) { f32x2 v = {lo, hi}; bf2_t r = __builtin_convertvector(v, bf2_t); return __builtin_bit_cast(unsigned, r); }
__device__ __forceinline__ bf16_t f2bf(float f) { return (bf16_t)(pk2(f, 0.f) & 0xffffu); }
__device__ __forceinline__ float wave_sum(float v) {
#pragma unroll
    for (int o = 1; o < 64; o <<= 1) v += __shfl_xor(v, o);
    return v;
}

namespace pg8 {
constexpr int BM = 256, BK = 64, HALF = 128, HTB = HALF * BK * 2, STAGE_BYTES = 8 * HTB, NXCD = 8, WGM = 8;
__host__ __device__ __forceinline__ int lds_byte(int r, int c) { const int st = (r >> 4) * 2 + (c >> 5), rr = r & 15, cc = c & 31, ob = rr * 64 + cc * 2; return st * 1024 + (ob ^ (((ob >> 9) & 1) << 5)); }
__host__ __device__ __forceinline__ void stage_rc(int b, int& R, int& C) { const int st = b / 1024, sb = b % 1024, swz = sb ^ (((sb >> 9) & 1) << 5); R = (st >> 1) * 16 + swz / 64; C = (st & 1) * 32 + (swz % 64) / 2; }
__host__ __device__ __forceinline__ int perm32(int rho) { const int n = rho >> 4, i = rho & 15; return 8 * (i >> 2) + 4 * n + (i & 3); }

struct Unit { int pm, pn; };
struct Gemm { const bf16_t* A; const bf16_t* Bt; int M, N, K, lda; };

struct StaticOrder {
    int nM, nN, nwg, G, c;
    __device__ void init(int M, int N, int G_, int c_) { nM = M / BM; nN = N / BM; nwg = nM * nN; G = G_; c = c_; }
    __device__ bool next(int i, Unit& u) const {
        const long L = (long)i * G + c; if (L >= nwg) return false;
        int wgid = (int)L; { const int q = nwg / NXCD, r = nwg % NXCD, xcd = wgid % NXCD, off = wgid / NXCD; wgid = (xcd < r ? xcd * (q + 1) : r * (q + 1) + (xcd - r) * q) + off; }
        const int nig = WGM * nN, gid = wgid / nig, fm = gid * WGM, gsz = (nM - fm) < WGM ? (nM - fm) : WGM;
        u.pm = fm + ((wgid % nig) % gsz); u.pn = (wgid % nig) / gsz; return true;
    }
};

template <class Epi, bool ALIGN_EPI>
__device__ __forceinline__ void gemm_phase(LAS unsigned char* lds, const Gemm g, const StaticOrder& S, const Epi& E) {
    const int tid = threadIdx.x, wid = __builtin_amdgcn_readfirstlane(tid >> 6), lane = tid & 63, wr = wid >> 2, wc = wid & 3, fr = lane & 15, fq = lane >> 4;
    const int K = g.K, nt = K / BK, lda = g.lda;
    unsigned voffA[2], voffB[2];
#pragma unroll
    for (int i = 0; i < 2; ++i) { int R, C; stage_rc(tid * 16 + i * 8192, R, C); const int Rb = Epi::PERM ? ((R & ~31) + perm32(R & 31)) : R;
        voffA[i] = (unsigned)(R * lda + C) * 2u; voffB[i] = (unsigned)(Rb * K + C) * 2u; }
    const size_t kstep = (size_t)(BK * 2);
    const size_t hstepA = (size_t)HALF * lda * 2, hstepB = (size_t)HALF * K * 2;
    const size_t tstepA = 2 * hstepA, tstepB = 2 * hstepB;
    const unsigned ldsw = (unsigned)wid * 1024u;
    const int aoff = lds_byte(wr * 64 + fr, fq * 8), boff = lds_byte(wc * 32 + fr, fq * 8);
#define PG8_SA(b, h) (((b) * 2 + (h)) * HTB)
#define PG8_SB(b, h) ((4 + (b) * 2 + (h)) * HTB)
#define PG8_STAGE(bufoff, gbase, voff) do { _Pragma("unroll") for (int _i = 0; _i < 2; ++_i) \
        __builtin_amdgcn_global_load_lds((const unsigned*)((const char*)(gbase) + (voff)[_i]), (LAS unsigned*)(lds + (bufoff) + ldsw + _i * 8192), 16, 0, 0); } while (0)
#define PG8_LDA(dst, b, h) do { _Pragma("unroll") for (int m = 0; m < 4; ++m) _Pragma("unroll") for (int k = 0; k < 2; ++k) dst[m][k] = *(const LAS bf16x8*)(lds + PG8_SA(b, h) + aoff + m * 2048 + k * 1024); } while (0)
#define PG8_LDB(dst, b, h) do { _Pragma("unroll") for (int n = 0; n < 2; ++n) _Pragma("unroll") for (int k = 0; k < 2; ++k) dst[n][k] = *(const LAS bf16x8*)(lds + PG8_SB(b, h) + boff + n * 2048 + k * 1024); } while (0)
#define PG8_MMA(ai, bj, At, Bt) do { __builtin_amdgcn_s_setprio(1); _Pragma("unroll") for (int m = 0; m < 4; ++m) _Pragma("unroll") for (int n = 0; n < 2; ++n) _Pragma("unroll") for (int k = 0; k < 2; ++k) \
        acc[ai][bj][m][n] = __builtin_amdgcn_mfma_f32_16x16x32_bf16(Bt[n][k], At[m][k], acc[ai][bj][m][n], 0, 0, 0); __builtin_amdgcn_s_setprio(0); } while (0)
#define PG8_WAIT_V(n) asm volatile("s_waitcnt vmcnt(" #n ")" ::: "memory")
#define PG8_WAIT_L(n) asm volatile("s_waitcnt lgkmcnt(" #n ")" ::: "memory")
#define PG8_BAR __builtin_amdgcn_s_barrier()
#define PG8_SCHED __builtin_amdgcn_sched_barrier(0)
    Unit cur, nxt; int ui = 0;
    if (!S.next(0, cur)) return;
    f32x4 acc[2][2][4][2];
#pragma unroll
    for (int a = 0; a < 2; ++a)
#pragma unroll
        for (int b = 0; b < 2; ++b)
#pragma unroll
            for (int m = 0; m < 4; ++m)
#pragma unroll
                for (int n = 0; n < 2; ++n) acc[a][b][m][n] = (f32x4){0.f, 0.f, 0.f, 0.f};
    bf16x8 At[4][2], B0[2][2], B1[2][2];
    const char* cA = (const char*)g.A + (size_t)cur.pm * tstepA; const char* cB = (const char*)g.Bt + (size_t)cur.pn * tstepB;
    {
        PG8_STAGE(PG8_SB(0, 0), cB, voffB); PG8_STAGE(PG8_SB(0, 1), cB + hstepB, voffB); PG8_STAGE(PG8_SA(0, 0), cA, voffA); PG8_STAGE(PG8_SA(0, 1), cA + hstepA, voffA);
        if (wr == 1) PG8_BAR;
        PG8_WAIT_V(2); PG8_BAR;
        PG8_STAGE(PG8_SB(1, 0), cB + kstep, voffB); PG8_STAGE(PG8_SA(1, 0), cA + kstep, voffA); PG8_STAGE(PG8_SB(1, 1), cB + hstepB + kstep, voffB);
        PG8_WAIT_V(6); PG8_BAR;
    }
    for (;;) {
        const bool has_next = S.next(ui + 1, nxt);
        const char* nA = has_next ? (const char*)g.A + (size_t)nxt.pm * tstepA : cA; const char* nB = has_next ? (const char*)g.Bt + (size_t)nxt.pn * tstepB : cB;
#pragma unroll 1
        for (int t = 0; t < nt; t += 2) {
            const bool last = (t == nt - 2);
            const char* a1 = cA + (size_t)(t + 1) * kstep;
            const char* a2 = last ? nA : cA + (size_t)(t + 2) * kstep; const char* b2 = last ? nB : cB + (size_t)(t + 2) * kstep;
            const char* a3 = a2 + kstep; const char* b3 = b2 + kstep;
            PG8_LDB(B0, 0, 0); PG8_LDB(B1, 0, 1); PG8_SCHED; PG8_LDA(At, 0, 0); PG8_STAGE(PG8_SA(1, 1), a1 + hstepA, voffA);
            PG8_WAIT_V(8); PG8_WAIT_L(0); PG8_BAR; PG8_MMA(0, 0, At, B0); PG8_MMA(0, 1, At, B1); PG8_BAR; PG8_SCHED;
            PG8_LDA(At, 0, 1); PG8_STAGE(PG8_SB(0, 0), b2, voffB); PG8_STAGE(PG8_SB(0, 1), b2 + hstepB, voffB); PG8_STAGE(PG8_SA(0, 0), a2, voffA);
            PG8_WAIT_V(8); PG8_WAIT_L(0); PG8_BAR; PG8_MMA(1, 0, At, B0); PG8_MMA(1, 1, At, B1); PG8_BAR; PG8_SCHED;
            PG8_LDB(B0, 1, 0); PG8_LDB(B1, 1, 1); PG8_SCHED; PG8_LDA(At, 1, 0); PG8_STAGE(PG8_SA(0, 1), a2 + hstepA, voffA);
            PG8_WAIT_V(8); PG8_WAIT_L(0); PG8_BAR; PG8_MMA(0, 0, At, B0); PG8_MMA(0, 1, At, B1); PG8_BAR; PG8_SCHED;
            PG8_LDA(At, 1, 1); PG8_STAGE(PG8_SB(1, 0), b3, voffB); PG8_STAGE(PG8_SB(1, 1), b3 + hstepB, voffB); PG8_STAGE(PG8_SA(1, 0), a3, voffA);
            PG8_WAIT_V(8); PG8_WAIT_L(0); PG8_BAR; PG8_MMA(1, 0, At, B0); PG8_MMA(1, 1, At, B1); PG8_BAR; PG8_SCHED;
        }
        if constexpr (ALIGN_EPI) { if (wr == 0) PG8_BAR; }
        E(acc, cur, wr, wc, fr, fq);
        if (!has_next) break;
#pragma unroll
        for (int a = 0; a < 2; ++a)
#pragma unroll
            for (int b = 0; b < 2; ++b)
#pragma unroll
                for (int m = 0; m < 4; ++m)
#pragma unroll
                    for (int n = 0; n < 2; ++n) acc[a][b][m][n] = (f32x4){0.f, 0.f, 0.f, 0.f};
        cur = nxt; cA = nA; cB = nB; ++ui;
        if constexpr (ALIGN_EPI) { if (wr == 1) PG8_BAR; }
    }
    PG8_WAIT_V(0);
    if constexpr (!ALIGN_EPI) { if (wr == 0) PG8_BAR; }
    PG8_BAR;
#undef PG8_SA
#undef PG8_SB
#undef PG8_STAGE
#undef PG8_LDA
#undef PG8_LDB
#undef PG8_MMA
#undef PG8_WAIT_V
#undef PG8_WAIT_L
#undef PG8_BAR
#undef PG8_SCHED
}
}


struct EpiProj {
    static constexpr bool PERM = true;
    bf16_t* P; float* ssq_q; float* ssq_kv; const float* ropec; const float* ropes; bf16_t* vts;
    __device__ __forceinline__ void operator()(const f32x4 (&acc)[2][2][4][2], const pg8::Unit& u, int wr, int wc, int fr, int fq) const {
        const int row0 = u.pm * 256 + wr * 64 + fr;
#pragma unroll
        for (int bj = 0; bj < 2; ++bj) {
            const int cgp = u.pn * 2 + bj;
            const int col = cgp * 128 + wc * 32 + 8 * fq;
            const bool is_q = cgp < 3, is_kv = (cgp == 3 || cgp == 4), is_kpe = (cgp == 5 && wc == 0);
            const bool is_swaq = (cgp == 5 && wc >= 1) || (cgp >= 6 && cgp <= 8) || (cgp == 9 && wc == 0);
            const bool is_swav = (cgp == 10 && wc >= 1) || (cgp == 11 && wc == 0);
#pragma unroll
            for (int ai = 0; ai < 2; ++ai)
#pragma unroll
                for (int m = 0; m < 4; ++m) {
                    const int row = row0 + ai * 128 + m * 16;
                    f32x4 v0 = acc[ai][bj][m][0], v1 = acc[ai][bj][m][1];
                    if (is_q || is_kv) {
                        float s = (v0[0] * v0[0] + v0[1] * v0[1]) + (v0[2] * v0[2] + v0[3] * v0[3]) + (v1[0] * v1[0] + v1[1] * v1[1]) + (v1[2] * v1[2] + v1[3] * v1[3]);
                        s += __shfl_xor(s, 16); s += __shfl_xor(s, 32);
                        if (fq == 0) unsafeAtomicAdd((is_q ? ssq_q : ssq_kv) + row, s);
                    }
                    if (is_kpe) {
                        f32x4 p0, p1;
#pragma unroll
                        for (int j = 0; j < 4; ++j) { p0[j] = __shfl_xor(v0[j], 32); p1[j] = __shfl_xor(v1[j], 32); }
                        const int pos = row & (SEQ - 1), i0 = (8 * fq) & 15;
                        const f32x4 c0 = *(const f32x4*)(ropec + pos * 16 + i0), c1 = *(const f32x4*)(ropec + pos * 16 + i0 + 4);
                        const f32x4 s0 = *(const f32x4*)(ropes + pos * 16 + i0), s1 = *(const f32x4*)(ropes + pos * 16 + i0 + 4);
                        const float sg = fq < 2 ? -1.f : 1.f;
                        v0 = v0 * c0 + p0 * s0 * sg; v1 = v1 * c1 + p1 * s1 * sg;
                    }
                    if (is_swaq) { v0 = v0 * QSC_SWA; v1 = v1 * QSC_SWA; }
                    u32x4 w; w.x = pk2(v0[0], v0[1]); w.y = pk2(v0[2], v0[3]); w.z = pk2(v1[0], v1[1]); w.w = pk2(v1[2], v1[3]);
                    *(u32x4*)(P + (size_t)row * NPROJ + col) = w;
                    if (is_swav) {
                        const int d = col - 1312, kvh = d >> 6, dd = d & 63, b = row >> 11, s = row & (SEQ - 1);
                        bf16_t* base = vts + ((size_t)((b * 2 + kvh) * 64 + dd)) * SEQ + s;
                        base[0 * SEQ] = (bf16_t)(w.x & 0xffffu); base[1 * SEQ] = (bf16_t)(w.x >> 16);
                        base[2 * SEQ] = (bf16_t)(w.y & 0xffffu); base[3 * SEQ] = (bf16_t)(w.y >> 16);
                        base[4 * SEQ] = (bf16_t)(w.z & 0xffffu); base[5 * SEQ] = (bf16_t)(w.z >> 16);
                        base[6 * SEQ] = (bf16_t)(w.w & 0xffffu); base[7 * SEQ] = (bf16_t)(w.w >> 16);
                    }
                }
        }
    }
};
struct EpiQ {
    static constexpr bool PERM = false;
    bf16_t* Q; const float* ssq_q; const float* ropec; const float* ropes;
    __device__ __forceinline__ void operator()(const f32x4 (&acc)[2][2][4][2], const pg8::Unit& u, int wr, int wc, int fr, int fq) const {
        const int row0 = u.pm * 256 + wr * 64 + fr;
#pragma unroll
        for (int ai = 0; ai < 2; ++ai)
#pragma unroll
            for (int m = 0; m < 4; ++m) {
                const int row = row0 + ai * 128 + m * 16, pos = row & (SEQ - 1);
                const float rs = __builtin_amdgcn_rsqf(ssq_q[row] * (1.0f / QL) + EPS) * QSC_MLA;
#pragma unroll
                for (int bj = 0; bj < 2; ++bj) {
                    const int G = u.pn * 8 + bj * 4 + wc;
                    const bool isrope = (G % 3) == 2;
                    f32x4 x1 = acc[ai][bj][m][0] * rs, x2 = acc[ai][bj][m][1] * rs;
                    if (isrope) {
                        const f32x4 c = *(const f32x4*)(ropec + pos * 16 + 4 * fq), s = *(const f32x4*)(ropes + pos * 16 + 4 * fq);
                        const f32x4 o1 = x1 * c - x2 * s, o2 = x1 * s + x2 * c; x1 = o1; x2 = o2;
                    }
                    bf16_t* p = Q + (size_t)row * QW + G * 32 + 4 * fq;
                    u32x2 w1, w2; w1.x = pk2(x1[0], x1[1]); w1.y = pk2(x1[2], x1[3]); w2.x = pk2(x2[0], x2[1]); w2.y = pk2(x2[2], x2[3]);
                    *(u32x2*)p = w1; *(u32x2*)(p + 16) = w2;
                }
                asm volatile("" ::: "memory");
            }
    }
};
struct EpiKV {
    static constexpr bool PERM = false;
    bf16_t* KN; bf16_t* VT; const float* ssq_kv;
    __device__ __forceinline__ void operator()(const f32x4 (&acc)[2][2][4][2], const pg8::Unit& u, int wr, int wc, int fr, int fq) const {
        const int row0 = u.pm * 256 + wr * 64 + fr;
#pragma unroll
        for (int ai = 0; ai < 2; ++ai)
#pragma unroll
            for (int m = 0; m < 4; ++m) {
                const int row = row0 + ai * 128 + m * 16, b = row >> 11, s = row & (SEQ - 1);
                const float rs = __builtin_amdgcn_rsqf(ssq_kv[row] * (1.0f / KVL) + EPS);
#pragma unroll
                for (int bj = 0; bj < 2; ++bj) {
                    const int head = u.pn * 2 + bj;
                    const f32x4 x1 = acc[ai][bj][m][0] * rs, x2 = acc[ai][bj][m][1] * rs;
                    const unsigned a0 = pk2(x1[0], x1[1]), a1 = pk2(x1[2], x1[3]), b0 = pk2(x2[0], x2[1]), b1 = pk2(x2[2], x2[3]);
                    if (wc < 2) {
                        bf16_t* p = KN + (size_t)row * 512 + head * 64 + wc * 32 + 4 * fq;
                        *(u32x2*)p = (u32x2){a0, a1}; *(u32x2*)(p + 16) = (u32x2){b0, b1};
                    } else {
                        bf16_t* base = VT + ((size_t)((b * 8 + head) * 64 + (wc - 2) * 32 + 4 * fq)) * SEQ + s;
                        base[0 * SEQ] = (bf16_t)(a0 & 0xffffu); base[1 * SEQ] = (bf16_t)(a0 >> 16); base[2 * SEQ] = (bf16_t)(a1 & 0xffffu); base[3 * SEQ] = (bf16_t)(a1 >> 16);
                        base[16 * SEQ] = (bf16_t)(b0 & 0xffffu); base[17 * SEQ] = (bf16_t)(b0 >> 16); base[18 * SEQ] = (bf16_t)(b1 & 0xffffu); base[19 * SEQ] = (bf16_t)(b1 >> 16);
                    }
                }
                asm volatile("" ::: "memory");
            }
    }
};
struct EpiRes {
    static constexpr bool PERM = false;
    const float* base; float* out; const float* gate;
    __device__ __forceinline__ void operator()(const f32x4 (&acc)[2][2][4][2], const pg8::Unit& u, int wr, int wc, int fr, int fq) const {
        const int row0 = u.pm * 256 + wr * 64 + fr, b = u.pm >> 3;
#pragma unroll
        for (int bj = 0; bj < 2; ++bj)
#pragma unroll
            for (int n = 0; n < 2; ++n) {
                const int col = u.pn * 256 + bj * 128 + wc * 32 + n * 16 + 4 * fq;
                const f32x4 gv = *(const f32x4*)(gate + b * 6144 + col);
#pragma unroll
                for (int ai = 0; ai < 2; ++ai)
#pragma unroll
                    for (int m = 0; m < 4; ++m) {
                        const size_t off = (size_t)(row0 + ai * 128 + m * 16) * DM + col;
                        const f32x4 bs = *(const f32x4*)(base + off);
                        *(f32x4*)(out + off) = bs + gv * acc[ai][bj][m][n];
                    }
            }
    }
};
struct EpiUp {
    static constexpr bool PERM = true;
    bf16_t* U;
    __device__ __forceinline__ void operator()(const f32x4 (&acc)[2][2][4][2], const pg8::Unit& u, int wr, int wc, int fr, int fq) const {
        const int row0 = u.pm * 256 + wr * 64 + fr, col0 = u.pn * 256 + wc * 32 + 8 * fq;
#pragma unroll
        for (int ai = 0; ai < 2; ++ai)
#pragma unroll
            for (int m = 0; m < 4; ++m) {
                bf16_t* rowp = U + (size_t)(row0 + ai * 128 + m * 16) * FF + col0;
#pragma unroll
                for (int bj = 0; bj < 2; ++bj) {
                    f32x4 v0 = acc[ai][bj][m][0], v1 = acc[ai][bj][m][1];
#pragma unroll
                    for (int j = 0; j < 4; ++j) { const float a = fmaxf(v0[j], 0.f), c = fmaxf(v1[j], 0.f); v0[j] = a * a; v1[j] = c * c; }
                    u32x4 w; w.x = pk2(v0[0], v0[1]); w.y = pk2(v0[2], v0[3]); w.z = pk2(v1[0], v1[1]); w.w = pk2(v1[2], v1[3]);
                    *(u32x4*)(rowp + bj * 128) = w;
                }
            }
    }
};

constexpr int KSTR = 208, VSTR = 136, VOFF = 64 * KSTR;
template <int QKD, int MODE>
__device__ __forceinline__ void attn_unit(LAS unsigned char* lds, const bf16_t* Q, int ldq, const bf16_t* K1, int ldk1, const bf16_t* K2, int ldk2,
                                          const bf16_t* VT, bf16_t* O, int qpos0, int t_lo, int t_hi, float slope2, float sink2, int tid, int wid, int lane) {
    const int r = lane & 31, hi = lane >> 5;
    const int q0 = qpos0 + 32 * wid;
    constexpr int NKB = QKD / 16;
    bf16x8 qf[NKB];
#pragma unroll
    for (int kb = 0; kb < NKB; ++kb) qf[kb] = *(const bf16x8*)(Q + (size_t)(32 * wid + r) * ldq + 16 * kb + 8 * hi);
    f32x16 o0, o1;
#pragma unroll
    for (int i = 0; i < 16; ++i) { o0[i] = 0.f; o1[i] = 0.f; }
    float mrun = (MODE == 1) ? sink2 : -1e30f;
    float lsum = (MODE == 1) ? (hi == 0 ? 1.f : 0.f) : 0.f;
    const int key1 = tid >> 3, ch1 = tid & 7, key2 = (tid >> 2) & 63, ch2 = tid & 3;
    u32x4 kr, k2r, vr;
    kr = *(const u32x4*)(K1 + (size_t)(64 * t_lo + key1) * ldk1 + ch1 * 8);
    if (QKD == 96) { if (tid < 256) k2r = *(const u32x4*)(K2 + (size_t)(64 * t_lo + key2) * ldk2 + ch2 * 8); }
    vr = *(const u32x4*)(VT + (size_t)key1 * SEQ + 64 * t_lo + ch1 * 8);
    for (int t = t_lo; t <= t_hi; ++t) {
        __syncthreads();
        *(LAS u32x4*)(lds + key1 * KSTR + ch1 * 16) = kr;
        if (QKD == 96) { if (tid < 256) *(LAS u32x4*)(lds + key2 * KSTR + 128 + ch2 * 16) = k2r; }
        *(LAS u32x2*)(lds + VOFF + key1 * VSTR + ch1 * 16) = (u32x2){vr.x, vr.y};
        *(LAS u32x2*)(lds + VOFF + key1 * VSTR + ch1 * 16 + 8) = (u32x2){vr.z, vr.w};
        __syncthreads();
        if (t < t_hi) {
            kr = *(const u32x4*)(K1 + (size_t)(64 * (t + 1) + key1) * ldk1 + ch1 * 8);
            if (QKD == 96) { if (tid < 256) k2r = *(const u32x4*)(K2 + (size_t)(64 * (t + 1) + key2) * ldk2 + ch2 * 8); }
            vr = *(const u32x4*)(VT + (size_t)key1 * SEQ + 64 * (t + 1) + ch1 * 8);
        }
        const int k0 = 64 * t;
        const bool active = (MODE == 0) ? (k0 <= q0 + 31) : ((k0 + 63 >= q0 - 127) && (k0 <= q0 + 31));
        if (active) {
            f32x16 s[2];
#pragma unroll
            for (int sub = 0; sub < 2; ++sub) {
#pragma unroll
                for (int i = 0; i < 16; ++i) s[sub][i] = 0.f;
#pragma unroll
                for (int kb = 0; kb < NKB; ++kb) {
                    const bf16x8 kf = *(const LAS bf16x8*)(lds + (32 * sub + r) * KSTR + (16 * kb + 8 * hi) * 2);
                    s[sub] = __builtin_amdgcn_mfma_f32_32x32x16_bf16(kf, qf[kb], s[sub], 0, 0, 0);
                }
            }
            const int qp = q0 + r;
            if (MODE == 0) {
                if (k0 + 63 > q0) {
#pragma unroll
                    for (int sub = 0; sub < 2; ++sub)
#pragma unroll
                        for (int i = 0; i < 16; ++i) { const int key = k0 + 32 * sub + (i & 3) + 8 * (i >> 2) + 4 * hi; if (key > qp) s[sub][i] = -INFINITY; }
                }
            } else {
#pragma unroll
                for (int sub = 0; sub < 2; ++sub)
#pragma unroll
                    for (int i = 0; i < 16; ++i) { const int key = k0 + 32 * sub + (i & 3) + 8 * (i >> 2) + 4 * hi; const int dist = qp - key;
                        s[sub][i] = (dist < 0 || dist >= 128) ? -INFINITY : (s[sub][i] - slope2 * (float)dist); }
            }
            float mx = -INFINITY;
#pragma unroll
            for (int sub = 0; sub < 2; ++sub)
#pragma unroll
                for (int i = 0; i < 16; ++i) mx = fmaxf(mx, s[sub][i]);
            mx = fmaxf(mx, __shfl_xor(mx, 32));
            const float mn = fmaxf(mrun, mx);
            const float alpha = __builtin_amdgcn_exp2f(mrun - mn);
            mrun = mn;
            float psum = 0.f;
#pragma unroll
            for (int sub = 0; sub < 2; ++sub)
#pragma unroll
                for (int i = 0; i < 16; ++i) { const float p = __builtin_amdgcn_exp2f(s[sub][i] - mn); s[sub][i] = p; psum += p; }
            lsum = lsum * alpha + psum;
            o0 = o0 * alpha; o1 = o1 * alpha;
#pragma unroll
            for (int sub = 0; sub < 2; ++sub)
#pragma unroll
                for (int jb = 0; jb < 2; ++jb) {
                    u32x4 pw;
                    pw.x = pk2(s[sub][8 * jb + 0], s[sub][8 * jb + 1]); pw.y = pk2(s[sub][8 * jb + 2], s[sub][8 * jb + 3]);
                    pw.z = pk2(s[sub][8 * jb + 4], s[sub][8 * jb + 5]); pw.w = pk2(s[sub][8 * jb + 6], s[sub][8 * jb + 7]);
                    const bf16x8 pf = __builtin_bit_cast(bf16x8, pw);
                    const LAS unsigned char* vp = lds + VOFF + r * VSTR + (32 * sub + 16 * jb + 4 * hi) * 2;
                    {
                        const u32x2 a = *(const LAS u32x2*)vp, b = *(const LAS u32x2*)(vp + 16);
                        const bf16x8 vf = __builtin_bit_cast(bf16x8, (u32x4){a.x, a.y, b.x, b.y});
                        o0 = __builtin_amdgcn_mfma_f32_32x32x16_bf16(vf, pf, o0, 0, 0, 0);
                    }
                    {
                        const u32x2 a = *(const LAS u32x2*)(vp + 32 * VSTR), b = *(const LAS u32x2*)(vp + 32 * VSTR + 16);
                        const bf16x8 vf = __builtin_bit_cast(bf16x8, (u32x4){a.x, a.y, b.x, b.y});
                        o1 = __builtin_amdgcn_mfma_f32_32x32x16_bf16(vf, pf, o1, 0, 0, 0);
                    }
                }
        }
    }
    const float ltot = lsum + __shfl_xor(lsum, 32);
    const float inv = 1.0f / ltot;
    bf16_t* op = O + (size_t)(32 * wid + r) * DM + 4 * hi;
#pragma unroll
    for (int g = 0; g < 4; ++g) {
        *(u32x2*)(op + 8 * g) = (u32x2){pk2(o0[4 * g] * inv, o0[4 * g + 1] * inv), pk2(o0[4 * g + 2] * inv, o0[4 * g + 3] * inv)};
        *(u32x2*)(op + 32 + 8 * g) = (u32x2){pk2(o1[4 * g] * inv, o1[4 * g + 1] * inv), pk2(o1[4 * g + 2] * inv, o1[4 * g + 3] * inv)};
    }
}

__device__ __forceinline__ void p0_transpose_item(const float* W, int K, int N, bf16_t* WT, const float* kscale, LAS float* scr, int item, int lane) {
    const int nblk = N / 32, kb = item / nblk, nb = item % nblk, k0 = 64 * kb, n0 = 32 * nb;
#pragma unroll 8
    for (int i = 0; i < 32; ++i) { const int kk = 2 * i + (lane >> 5); float v = W[(size_t)(k0 + kk) * N + n0 + (lane & 31)]; if (kscale) v *= kscale[k0 + kk]; scr[kk * 33 + (lane & 31)] = v; }
    asm volatile("s_waitcnt lgkmcnt(0)" ::: "memory");
    const int c = lane & 7;
#pragma unroll
    for (int j = 0; j < 4; ++j) { const int n = (lane >> 3) + 8 * j; const LAS float* s = scr + (8 * c) * 33 + n;
        u32x4 o; o.x = pk2(s[0 * 33], s[1 * 33]); o.y = pk2(s[2 * 33], s[3 * 33]); o.z = pk2(s[4 * 33], s[5 * 33]); o.w = pk2(s[6 * 33], s[7 * 33]);
        *(u32x4*)(WT + (size_t)(n0 + n) * K + k0 + 8 * c) = o; }
    asm volatile("s_waitcnt lgkmcnt(0)" ::: "memory");
}
__device__ __forceinline__ void p0_mod_item(const float* c, const float* w_ada, const float* b_ada, float* mod, LAS float* scr, int item, int lane) {
    const int kc = item / 24, nb = item % 24, k0 = 64 * kc, n0 = 256 * nb + 4 * lane;
#pragma unroll
    for (int b = 0; b < 8; ++b) { const float x = c[b * DM + k0 + lane]; scr[b * 64 + lane] = x / (1.0f + __expf(-x)); }
    asm volatile("s_waitcnt lgkmcnt(0)" ::: "memory");
    f32x4 acc[8];
#pragma unroll
    for (int b = 0; b < 8; ++b) acc[b] = (f32x4){0.f, 0.f, 0.f, 0.f};
#pragma unroll 4
    for (int kk = 0; kk < 64; ++kk) {
        const f32x4 w = *(const f32x4*)(w_ada + (size_t)(k0 + kk) * 6144 + n0);
#pragma unroll
        for (int b = 0; b < 8; ++b) acc[b] += w * scr[b * 64 + kk];
    }
    f32x4 bias = (f32x4){0.f, 0.f, 0.f, 0.f};
    if (kc == 0) bias = *(const f32x4*)(b_ada + n0);
#pragma unroll
    for (int b = 0; b < 8; ++b)
#pragma unroll
        for (int j = 0; j < 4; ++j) unsafeAtomicAdd(mod + b * 6144 + n0 + j, acc[b][j] + bias[j]);
    asm volatile("s_waitcnt lgkmcnt(0)" ::: "memory");
}
__device__ __forceinline__ void row_norm_mod(const float* xrow, bf16_t* orow, const float* g, const float* sc, const float* sh, int lane) {
    const f32x4* xr = (const f32x4*)xrow + lane;
    f32x4 v[4]; float s = 0.f;
#pragma unroll
    for (int j = 0; j < 4; ++j) { v[j] = xr[64 * j]; s += (v[j][0] * v[j][0] + v[j][1] * v[j][1]) + (v[j][2] * v[j][2] + v[j][3] * v[j][3]); }
    const float rstd = 1.0f / sqrtf(wave_sum(s) * (1.0f / DM) + EPS);
    u32x2* o8 = (u32x2*)orow + lane;
#pragma unroll
    for (int j = 0; j < 4; ++j) {
        const f32x4 gg = ((const f32x4*)g)[64 * j + lane], ss = ((const f32x4*)sc)[64 * j + lane], hh = ((const f32x4*)sh)[64 * j + lane];
        const f32x4 y = v[j] * rstd * gg * (ss + 1.0f) + hh;
        o8[64 * j] = (u32x2){pk2(y[0], y[1]), pk2(y[2], y[3])};
    }
}
__device__ __forceinline__ void row_norm_final(const float* xrow, float* orow, const float* g, int lane) {
    const f32x4* xr = (const f32x4*)xrow + lane;
    f32x4 v[4]; float s = 0.f;
#pragma unroll
    for (int j = 0; j < 4; ++j) { v[j] = xr[64 * j]; s += (v[j][0] * v[j][0] + v[j][1] * v[j][1]) + (v[j][2] * v[j][2] + v[j][3] * v[j][3]); }
    const float rstd = 1.0f / sqrtf(wave_sum(s) * (1.0f / DM) + EPS);
    f32x4* o = (f32x4*)orow + lane;
#pragma unroll
    for (int j = 0; j < 4; ++j) o[64 * j] = v[j] * rstd * ((const f32x4*)g)[64 * j + lane];
}

struct Args { const float* in[16]; float* out; unsigned char* ws; int ph_lo, ph_hi, pad0, pad1; };
constexpr int NPHASE = 10;

__global__ void __launch_bounds__(512, 2) fwd_megakernel(Args args) {
    extern __shared__ __attribute__((aligned(16))) unsigned char lds_raw[];
    LAS unsigned char* lds = (LAS unsigned char*)lds_raw;
    cg::grid_group grid = cg::this_grid();
    const int tid = threadIdx.x, lane = tid & 63, wave = __builtin_amdgcn_readfirstlane(tid >> 6);
    const int G = gridDim.x, bx = blockIdx.x;
    const int vcu = (G % 8 == 0) ? (bx % 8) * (G / 8) + bx / 8 : bx;
    const int gw = vcu * 8 + wave, NGW = G * 8;
    unsigned char* ws = args.ws;
    const float* x = args.in[0]; const float* cvec = args.in[1]; const float* w_ada = args.in[2]; const float* b_ada = args.in[3];
    const float* norm_mix_g = args.in[4]; const float* w_in = args.in[5]; const float* g_qa = args.in[6]; const float* w_qb = args.in[7];
    const float* g_kva = args.in[8]; const float* w_kvb = args.in[9]; const float* sinks = args.in[10]; const float* w_o = args.in[11];
    const float* norm_mlp_g = args.in[12]; const float* w_up = args.in[13]; const float* w_down = args.in[14]; const float* final_g = args.in[15];
    float* out = args.out;
    float* mod = (float*)(ws + WS_MOD); float* ssq_q = (float*)(ws + WS_SSQQ); float* ssq_kv = (float*)(ws + WS_SSQKV);
    float* ropec = (float*)(ws + WS_ROPE); float* ropes = ropec + SEQ * 16;
    bf16_t* win_t = (bf16_t*)(ws + WS_WIN); bf16_t* wqb_t = (bf16_t*)(ws + WS_WQB); bf16_t* wkvb_t = (bf16_t*)(ws + WS_WKVB);
    bf16_t* wo_t = (bf16_t*)(ws + WS_WO); bf16_t* wup_t = (bf16_t*)(ws + WS_WUP); bf16_t* wdn_t = (bf16_t*)(ws + WS_WDN);
    bf16_t* hbuf = (bf16_t*)(ws + WS_H); bf16_t* proj = (bf16_t*)(ws + WS_PROJ); bf16_t* qbuf = (bf16_t*)(ws + WS_Q); bf16_t* knope = (bf16_t*)(ws + WS_KN);
    bf16_t* vtm = (bf16_t*)(ws + WS_VTM); bf16_t* vts = (bf16_t*)(ws + WS_VTS); bf16_t* mix = (bf16_t*)(ws + WS_MIX); bf16_t* ubuf = (bf16_t*)(ws + WS_U);

    const int lo = args.ph_lo, hi = args.ph_hi;
#ifndef PH_MASK
#define PH_MASK 0x3ff
#endif
#define IN(k) (((PH_MASK >> (k)) & 1) && lo <= (k) && (k) < hi)
#define SEAM(k) do { if (IN(k) && IN((k) + 1)) grid.sync(); } while (0)

    if (IN(0)) {
        LAS float* scr = (LAS float*)(lds + wave * 16384);
        constexpr int I_MOD = 16 * 24, I_IN = 16 * 45, I_QB = 6 * 24, I_KVB = 4 * 32, I_O = 16 * 32, I_UP = 16 * 128, I_DN = 64 * 32;
        constexpr int NITEMS = I_MOD + I_IN + I_QB + I_KVB + I_O + I_UP + I_DN;
        for (int it = gw; it < NITEMS; it += NGW) {
            int r = it;
            if (r < I_MOD) { p0_mod_item(cvec, w_ada, b_ada, mod, scr, r, lane); continue; } r -= I_MOD;
            if (r < I_IN) { p0_transpose_item(w_in, DM, IN_COLS, win_t, nullptr, scr, r, lane); continue; } r -= I_IN;
            if (r < I_QB) { p0_transpose_item(w_qb, QL, QW, wqb_t, g_qa, scr, r, lane); continue; } r -= I_QB;
            if (r < I_KVB) { p0_transpose_item(w_kvb, KVL, KVW, wkvb_t, g_kva, scr, r, lane); continue; } r -= I_KVB;
            if (r < I_O) { p0_transpose_item(w_o, DM, DM, wo_t, nullptr, scr, r, lane); continue; } r -= I_O;
            if (r < I_UP) { p0_transpose_item(w_up, DM, FF, wup_t, nullptr, scr, r, lane); continue; } r -= I_UP;
            p0_transpose_item(w_down, FF, DM, wdn_t, nullptr, scr, r, lane);
        }
        const int gt = vcu * 512 + tid, NGT = G * 512;
        for (int i = gt; i < (NPROJ - IN_COLS) * DM / 8; i += NGT) ((u32x4*)(win_t + (size_t)IN_COLS * DM))[i] = (u32x4){0u, 0u, 0u, 0u};
        for (int i = gt; i < SEQ * 16; i += NGT) {
            const int pos = i >> 4, fi = i & 15;
            double f = (fi & 3) == 0 ? 1.0 : ((fi & 3) == 1 ? 0.5623413251903491 : ((fi & 3) == 2 ? 0.31622776601683794 : 0.1778279410038923));
            const int dec = fi >> 2; f *= (dec == 0 ? 1.0 : (dec == 1 ? 0.1 : (dec == 2 ? 0.01 : 0.001)));
            const float ang32 = (float)pos * (float)f;
            const double rev = (double)ang32 * 0.15915494309189535;
            const float fr = (float)(rev - __builtin_rint(rev));
            ropec[i] = __builtin_amdgcn_cosf(fr); ropes[i] = __builtin_amdgcn_sinf(fr);
        }
    }
    SEAM(0);
    if (IN(1)) {
        for (int m = gw; m < MT; m += NGW) { const int b = m >> 11;
            row_norm_mod(x + (size_t)m * DM, hbuf + (size_t)m * DM, norm_mix_g, mod + b * 6144 + 1024, mod + b * 6144, lane); }
    }
    SEAM(1);
    if (IN(2)) {
        pg8::Gemm g{hbuf, win_t, MT, NPROJ, DM, DM}; pg8::StaticOrder S; S.init(MT, NPROJ, G, bx);
        EpiProj E{proj, ssq_q, ssq_kv, ropec, ropes, vts};
        pg8::gemm_phase<EpiProj, true>(lds, g, S, E);
    }
    SEAM(2);
    if (IN(3)) {
        { pg8::Gemm g{proj, wqb_t, MT, QW, QL, NPROJ}; pg8::StaticOrder S; S.init(MT, QW, G, bx);
          EpiQ E{qbuf, ssq_q, ropec, ropes}; pg8::gemm_phase<EpiQ, true>(lds, g, S, E); }
        { pg8::Gemm g{proj + QL, wkvb_t, MT, KVW, KVL, NPROJ}; pg8::StaticOrder S; S.init(MT, KVW, G, (bx + 64) % G);
          EpiKV E{knope, vtm, ssq_kv}; pg8::gemm_phase<EpiKV, true>(lds, g, S, E); }
    }
    SEAM(3);
    if (IN(4)) {
        for (int it = vcu; it < 768; it += G) {
            if (it < 256) {
                const int b = it >> 5, h = (it >> 2) & 7, pp = it & 3;
#pragma unroll 1
                for (int k = 0; k < 2; ++k) {
                    const int qb = k == 0 ? 7 - pp : pp;
                    const size_t row0 = (size_t)b * SEQ + qb * 256;
                    attn_unit<96, 0>(lds, qbuf + row0 * QW + h * 96, QW, knope + (size_t)b * SEQ * 512 + h * 64, 512, proj + (size_t)b * SEQ * NPROJ + 640, NPROJ,
                                     vtm + (size_t)(b * 8 + h) * 64 * SEQ, mix + row0 * DM + h * 64, qb * 256, 0, 4 * qb + 3, 0.f, 0.f, tid, wave, lane);
                }
            } else {
                const int id = it - 256, b = id >> 6, hq = (id >> 3) & 7, qb = id & 7, kvh = hq >> 2;
                const size_t row0 = (size_t)b * SEQ + qb * 256;
                const float slope2 = exp2f(-(float)(hq + 1)) * LOG2E, sink2 = sinks[hq] * LOG2E;
                attn_unit<64, 1>(lds, proj + row0 * NPROJ + 672 + hq * 64, NPROJ, proj + (size_t)b * SEQ * NPROJ + 1184 + kvh * 64, NPROJ, nullptr, 0,
                                 vts + (size_t)(b * 2 + kvh) * 64 * SEQ, mix + row0 * DM + 512 + hq * 64, qb * 256, qb == 0 ? 0 : 4 * qb - 2, 4 * qb + 3, slope2, sink2, tid, wave, lane);
            }
        }
        __syncthreads();
    }
    SEAM(4);
    if (IN(5)) {
        pg8::Gemm g{mix, wo_t, MT, DM, DM, DM}; pg8::StaticOrder S; S.init(MT, DM, G, bx);
        EpiRes E{x, out, mod + 2 * 1024};
        pg8::gemm_phase<EpiRes, true>(lds, g, S, E);
    }
    SEAM(5);
    if (IN(6)) {
        for (int m = gw; m < MT; m += NGW) { const int b = m >> 11;
            row_norm_mod(out + (size_t)m * DM, hbuf + (size_t)m * DM, norm_mlp_g, mod + b * 6144 + 4 * 1024, mod + b * 6144 + 3 * 1024, lane); }
    }
    SEAM(6);
    if (IN(7)) {
        pg8::Gemm g{hbuf, wup_t, MT, FF, DM, DM}; pg8::StaticOrder S; S.init(MT, FF, G, bx);
        EpiUp E{ubuf};
        pg8::gemm_phase<EpiUp, true>(lds, g, S, E);
    }
    SEAM(7);
    if (IN(8)) {
        pg8::Gemm g{ubuf, wdn_t, MT, DM, FF, FF}; pg8::StaticOrder S; S.init(MT, DM, G, bx);
        EpiRes E{out, out, mod + 5 * 1024};
        pg8::gemm_phase<EpiRes, true>(lds, g, S, E);
    }
    SEAM(8);
    if (IN(9)) {
        for (int m = gw; m < MT; m += NGW) row_norm_final(out + (size_t)m * DM, out + (size_t)m * DM, final_g, lane);
    }
#undef IN
#undef SEAM
}

extern "C" void kernel_launch(void* const* d_in, const int* in_sizes, int n_in, void* d_out, int out_size, void* d_ws, size_t ws_size, hipStream_t stream) {
    static int grid = 0;
    if (grid == 0) {
        if (n_in != 16 || out_size != MT * DM || ws_size < WS_END) { fprintf(stderr, "kernel_launch: unexpected shapes (n_in %d out %d ws %zu)\n", n_in, out_size, ws_size); grid = -1; return; }
        int dev = 0, cus = 0, per_cu = 0;
        hipGetDevice(&dev);
        hipDeviceGetAttribute(&cus, hipDeviceAttributeMultiprocessorCount, dev);
        if (hipFuncSetAttribute((const void*)fwd_megakernel, hipFuncAttributeMaxDynamicSharedMemorySize, LDS_BYTES) != hipSuccess) { fprintf(stderr, "kernel_launch: hipFuncSetAttribute failed\n"); }
        if (hipOccupancyMaxActiveBlocksPerMultiprocessor(&per_cu, (const void*)fwd_megakernel, 512, LDS_BYTES) != hipSuccess || per_cu < 1) { fprintf(stderr, "kernel_launch: occupancy query says %d\n", per_cu); per_cu = 1; }
        (void)hipGetLastError();
        grid = cus * per_cu;
        if (grid > 256) grid = 256;
    }
    if (grid < 0) return;
    hipMemsetAsync((char*)d_ws, 0, WS_ZERO_BYTES, stream);
    Args a{};
    for (int i = 0; i < 16; ++i) a.in[i] = (const float*)d_in[i];
    a.out = (float*)d_out; a.ws = (unsigned char*)d_ws;
#if MK_PER_PHASE
    for (int p = 0; p < NPHASE; ++p) {
        a.ph_lo = p; a.ph_hi = p + 1;
        hipLaunchKernelGGL(fwd_megakernel, dim3(grid), dim3(512), LDS_BYTES, stream, a);
    }
#else
    a.ph_lo = 0; a.ph_hi = NPHASE;
    void* kargs[] = {&a};
    hipError_t e = hipLaunchCooperativeKernel((const void*)fwd_megakernel, dim3(grid), dim3(512), kargs, LDS_BYTES, stream);
    if (e != hipSuccess) fprintf(stderr, "cooperative launch failed: %s (grid %d)\n", hipGetErrorString(e), grid);
#endif
}
```

```cpp
#include <hip/hip_runtime.h>
#include <hip/hip_cooperative_groups.h>
#include <cstdio>
#include <cstdint>
namespace cg = cooperative_groups;

#define LAS __attribute__((address_space(3)))
typedef unsigned short bf16_t;
typedef short bf16x8 __attribute__((ext_vector_type(8)));
typedef short s16x4 __attribute__((ext_vector_type(4)));
typedef float f32x4 __attribute__((ext_vector_type(4)));
typedef float f32x2 __attribute__((ext_vector_type(2)));
typedef float f32x16 __attribute__((ext_vector_type(16)));
typedef unsigned u32x4 __attribute__((ext_vector_type(4)));
typedef unsigned u32x2 __attribute__((ext_vector_type(2)));
typedef __bf16 bf2_t __attribute__((ext_vector_type(2)));

#ifndef MK_PER_PHASE
#define MK_PER_PHASE 0
#endif

constexpr int NB = 8, SEQ = 2048, DM = 1024, MT = NB * SEQ, FF = 4096;
constexpr int NPROJ = 1536, IN_COLS = 1440;
constexpr int QL = 384, KVL = 256;
constexpr int QW = 768, KVW = 1024;
constexpr float EPS = 1e-6f;
constexpr float LOG2E = 1.4426950408889634f;
constexpr float QSC_MLA = 0.10206207261596575f * LOG2E;
constexpr float QSC_SWA = 0.125f * LOG2E;

constexpr size_t MiB = 1u << 20;
constexpr size_t WS_MOD = 0, WS_SSQQ = 256 * 1024, WS_SSQKV = 320 * 1024, WS_BAR = 384 * 1024, WS_ZERO_BYTES = 400 * 1024;
constexpr size_t WS_ROPE = 1 * MiB;
constexpr size_t WS_WIN = 2 * MiB, WS_WQB = 5 * MiB, WS_WKVB = 6 * MiB, WS_WO = 7 * MiB, WS_WUP = 9 * MiB, WS_WDN = 17 * MiB;
constexpr size_t WS_H = 25 * MiB, WS_PROJ = 57 * MiB, WS_Q = 105 * MiB, WS_KN = 129 * MiB, WS_VTM = 145 * MiB, WS_VTS = 161 * MiB, WS_MIX = 165 * MiB;
constexpr size_t WS_U = 57 * MiB;
constexpr size_t WS_END = 197 * MiB;
constexpr int LDS_BYTES = 131072 + 256;

__device__ __forceinline__ unsigned pk2(float lo, float hi) { f32x2 v = {lo, hi}; bf2_t r = __builtin_convertvector(v, bf2_t); return __builtin_bit_cast(unsigned, r); }
__device__ __forceinline__ bf16_t f2bf(float f) { return (bf16_t)(pk2(f, 0.f) & 0xffffu); }
__device__ __forceinline__ float wave_sum(float v) {
#pragma unroll
    for (int o = 1; o < 64; o <<= 1) v += __shfl_xor(v, o);
    return v;
}

namespace pg8 {
constexpr int BM = 256, BK = 64, HALF = 128, HTB = HALF * BK * 2, STAGE_BYTES = 8 * HTB, NXCD = 8, WGM = 8;
__host__ __device__ __forceinline__ int lds_byte(int r, int c) { const int st = (r >> 4) * 2 + (c >> 5), rr = r & 15, cc = c & 31, ob = rr * 64 + cc * 2; return st * 1024 + (ob ^ (((ob >> 9) & 1) << 5)); }
__host__ __device__ __forceinline__ void stage_rc(int b, int& R, int& C) { const int st = b / 1024, sb = b % 1024, swz = sb ^ (((sb >> 9) & 1) << 5); R = (st >> 1) * 16 + swz / 64; C = (st & 1) * 32 + (swz % 64) / 2; }
__host__ __device__ __forceinline__ int perm32(int rho) { const int n = rho >> 4, i = rho & 15; return 8 * (i >> 2) + 4 * n + (i & 3); }

struct Unit { int pm, pn; };
struct Gemm { const bf16_t* A; const bf16_t* Bt; int M, N, K, lda; };

struct StaticOrder {
    int nM, nN, nwg, G, c;
    __device__ void init(int M, int N, int G_, int c_) { nM = M / BM; nN = N / BM; nwg = nM * nN; G = G_; c = c_; }
    __device__ bool next(int i, Unit& u) const {
        const long L = (long)i * G + c; if (L >= nwg) return false;
        int wgid = (int)L; { const int q = nwg / NXCD, r = nwg % NXCD, xcd = wgid % NXCD, off = wgid / NXCD; wgid = (xcd < r ? xcd * (q + 1) : r * (q + 1) + (xcd - r) * q) + off; }
        const int nig = WGM * nN, gid = wgid / nig, fm = gid * WGM, gsz = (nM - fm) < WGM ? (nM - fm) : WGM;
        u.pm = fm + ((wgid % nig) % gsz); u.pn = (wgid % nig) / gsz; return true;
    }
};

template <class Epi, bool ALIGN_EPI>
__device__ __forceinline__ void gemm_phase(LAS unsigned char* lds, const Gemm g, const StaticOrder& S, const Epi& E) {
    const int tid = threadIdx.x, wid = __builtin_amdgcn_readfirstlane(tid >> 6), lane = tid & 63, wr = wid >> 2, wc = wid & 3, fr = lane & 15, fq = lane >> 4;
    const int K = g.K, nt = K / BK, lda = g.lda;
    unsigned voffA[2], voffB[2];
#pragma unroll
    for (int i = 0; i < 2; ++i) { int R, C; stage_rc(tid * 16 + i * 8192, R, C); const int Rb = Epi::PERM ? ((R & ~31) + perm32(R & 31)) : R;
        voffA[i] = (unsigned)(R * lda + C) * 2u; voffB[i] = (unsigned)(Rb * K + C) * 2u; }
    const size_t kstep = (size_t)(BK * 2);
    const size_t hstepA = (size_t)HALF * lda * 2, hstepB = (size_t)HALF * K * 2;
    const size_t tstepA = 2 * hstepA, tstepB = 2 * hstepB;
    const unsigned ldsw = (unsigned)wid * 1024u;
    const int aoff = lds_byte(wr * 64 + fr, fq * 8), boff = lds_byte(wc * 32 + fr, fq * 8);
#define PG8_SA(b, h) (((b) * 2 + (h)) * HTB)
#define PG8_SB(b, h) ((4 + (b) * 2 + (h)) * HTB)
#define PG8_STAGE(bufoff, gbase, voff) do { _Pragma("unroll") for (int _i = 0; _i < 2; ++_i) \
        __builtin_amdgcn_global_load_lds((const unsigned*)((const char*)(gbase) + (voff)[_i]), (LAS unsigned*)(lds + (bufoff) + ldsw + _i * 8192), 16, 0, 0); } while (0)
#define PG8_LDA(dst, b, h) do { _Pragma("unroll") for (int m = 0; m < 4; ++m) _Pragma("unroll") for (int k = 0; k < 2; ++k) dst[m][k] = *(const LAS bf16x8*)(lds + PG8_SA(b, h) + aoff + m * 2048 + k * 1024); } while (0)
#define PG8_LDB(dst, b, h) do { _Pragma("unroll") for (int n = 0; n < 2; ++n) _Pragma("unroll") for (int k = 0; k < 2; ++k) dst[n][k] = *(const LAS bf16x8*)(lds + PG8_SB(b, h) + boff + n * 2048 + k * 1024); } while (0)
#define PG8_MMA(ai, bj, At, Bt) do { __builtin_amdgcn_s_setprio(1); _Pragma("unroll") for (int m = 0; m < 4; ++m) _Pragma("unroll") for (int n = 0; n < 2; ++n) _Pragma("unroll") for (int k = 0; k < 2; ++k) \
        acc[ai][bj][m][n] = __builtin_amdgcn_mfma_f32_16x16x32_bf16(Bt[n][k], At[m][k], acc[ai][bj][m][n], 0, 0, 0); __builtin_amdgcn_s_setprio(0); } while (0)
#define PG8_WAIT_V(n) asm volatile("s_waitcnt vmcnt(" #n ")" ::: "memory")
#define PG8_WAIT_L(n) asm volatile("s_waitcnt lgkmcnt(" #n ")" ::: "memory")
#define PG8_BAR __builtin_amdgcn_s_barrier()
#define PG8_SCHED __builtin_amdgcn_sched_barrier(0)
    Unit cur, nxt; int ui = 0;
    if (!S.next(0, cur)) return;
    f32x4 acc[2][2][4][2];
#pragma unroll
    for (int a = 0; a < 2; ++a)
#pragma unroll
        for (int b = 0; b < 2; ++b)
#pragma unroll
            for (int m = 0; m < 4; ++m)
#pragma unroll
                for (int n = 0; n < 2; ++n) acc[a][b][m][n] = (f32x4){0.f, 0.f, 0.f, 0.f};
    bf16x8 At[4][2], B0[2][2], B1[2][2];
    const char* cA = (const char*)g.A + (size_t)cur.pm * tstepA; const char* cB = (const char*)g.Bt + (size_t)cur.pn * tstepB;
    {
        PG8_STAGE(PG8_SB(0, 0), cB, voffB); PG8_STAGE(PG8_SB(0, 1), cB + hstepB, voffB); PG8_STAGE(PG8_SA(0, 0), cA, voffA); PG8_STAGE(PG8_SA(0, 1), cA + hstepA, voffA);
        if (wr == 1) PG8_BAR;
        PG8_WAIT_V(2); PG8_BAR;
        PG8_STAGE(PG8_SB(1, 0), cB + kstep, voffB); PG8_STAGE(PG8_SA(1, 0), cA + kstep, voffA); PG8_STAGE(PG8_SB(1, 1), cB + hstepB + kstep, voffB);
        PG8_WAIT_V(6); PG8_BAR;
    }
    for (;;) {
        const bool has_next = S.next(ui + 1, nxt);
        const char* nA = has_next ? (const char*)g.A + (size_t)nxt.pm * tstepA : cA; const char* nB = has_next ? (const char*)g.Bt + (size_t)nxt.pn * tstepB : cB;
#pragma unroll 1
        for (int t = 0; t < nt; t += 2) {
            const bool last = (t == nt - 2);
            const char* a1 = cA + (size_t)(t + 1) * kstep;
            const char* a2 = last ? nA : cA + (size_t)(t + 2) * kstep; const char* b2 = last ? nB : cB + (size_t)(t + 2) * kstep;
            const char* a3 = a2 + kstep; const char* b3 = b2 + kstep;
            PG8_LDB(B0, 0, 0); PG8_LDB(B1, 0, 1); PG8_SCHED; PG8_LDA(At, 0, 0); PG8_STAGE(PG8_SA(1, 1), a1 + hstepA, voffA);
            PG8_WAIT_V(8); PG8_WAIT_L(0); PG8_BAR; PG8_MMA(0, 0, At, B0); PG8_MMA(0, 1, At, B1); PG8_BAR; PG8_SCHED;
            PG8_LDA(At, 0, 1); PG8_STAGE(PG8_SB(0, 0), b2, voffB); PG8_STAGE(PG8_SB(0, 1), b2 + hstepB, voffB); PG8_STAGE(PG8_SA(0, 0), a2, voffA);
            PG8_WAIT_V(8); PG8_WAIT_L(0); PG8_BAR; PG8_MMA(1, 0, At, B0); PG8_MMA(1, 1, At, B1); PG8_BAR; PG8_SCHED;
            PG8_LDB(B0, 1, 0); PG8_LDB(B1, 1, 1); PG8_SCHED; PG8_LDA(At, 1, 0); PG8_STAGE(PG8_SA(0, 1), a2 + hstepA, voffA);
            PG8_WAIT_V(8); PG8_WAIT_L(0); PG8_BAR; PG8_MMA(0, 0, At, B0); PG8_MMA(0, 1, At, B1); PG8_BAR; PG8_SCHED;
            PG8_LDA(At, 1, 1); PG8_STAGE(PG8_SB(1, 0), b3, voffB); PG8_STAGE(PG8_SB(1, 1), b3 + hstepB, voffB); PG8_STAGE(PG8_SA(1, 0), a3, voffA);
            PG8_WAIT_V(8); PG8_WAIT_L(0); PG8_BAR; PG8_MMA(1, 0, At, B0); PG8_MMA(1, 1, At, B1); PG8_BAR; PG8_SCHED;
        }
        if constexpr (ALIGN_EPI) { if (wr == 0) PG8_BAR; }
        E(acc, cur, wr, wc, fr, fq);
        if (!has_next) break;
#pragma unroll
        for (int a = 0; a < 2; ++a)
#pragma unroll
            for (int b = 0; b < 2; ++b)
#pragma unroll
                for (int m = 0; m < 4; ++m)
#pragma unroll
                    for (int n = 0; n < 2; ++n) acc[a][b][m][n] = (f32x4){0.f, 0.f, 0.f, 0.f};
        cur = nxt; cA = nA; cB = nB; ++ui;
        if constexpr (ALIGN_EPI) { if (wr == 1) PG8_BAR; }
    }
    PG8_WAIT_V(0);
    if constexpr (!ALIGN_EPI) { if (wr == 0) PG8_BAR; }
    PG8_BAR;
#undef PG8_SA
#undef PG8_SB
#undef PG8_STAGE
#undef PG8_LDA
#undef PG8_LDB
#undef PG8_MMA
#undef PG8_WAIT_V
#undef PG8_WAIT_L
#undef PG8_BAR
#undef PG8_SCHED
}
}


struct EpiProj {
    static constexpr bool PERM = true;
    bf16_t* P; float* ssq_q; float* ssq_kv; const float* ropec; const float* ropes; bf16_t* vts;
    __device__ __forceinline__ void operator()(const f32x4 (&acc)[2][2][4][2], const pg8::Unit& u, int wr, int wc, int fr, int fq) const {
        const int row0 = u.pm * 256 + wr * 64 + fr;
#pragma unroll
        for (int bj = 0; bj < 2; ++bj) {
            const int cgp = u.pn * 2 + bj;
            const int col = cgp * 128 + wc * 32 + 8 * fq;
            const bool is_q = cgp < 3, is_kv = (cgp == 3 || cgp == 4), is_kpe = (cgp == 5 && wc == 0);
            const bool is_swaq = (cgp == 5 && wc >= 1) || (cgp >= 6 && cgp <= 8) || (cgp == 9 && wc == 0);
            const bool is_swav = (cgp == 10 && wc >= 1) || (cgp == 11 && wc == 0);
#pragma unroll
            for (int ai = 0; ai < 2; ++ai)
#pragma unroll
                for (int m = 0; m < 4; ++m) {
                    const int row = row0 + ai * 128 + m * 16;
                    f32x4 v0 = acc[ai][bj][m][0], v1 = acc[ai][bj][m][1];
                    if (is_q || is_kv) {
                        float s = (v0[0] * v0[0] + v0[1] * v0[1]) + (v0[2] * v0[2] + v0[3] * v0[3]) + (v1[0] * v1[0] + v1[1] * v1[1]) + (v1[2] * v1[2] + v1[3] * v1[3]);
                        s += __shfl_xor(s, 16); s += __shfl_xor(s, 32);
                        if (fq == 0) unsafeAtomicAdd((is_q ? ssq_q : ssq_kv) + row, s);
                    }
                    if (is_kpe) {
                        f32x4 p0, p1;
#pragma unroll
                        for (int j = 0; j < 4; ++j) { p0[j] = __shfl_xor(v0[j], 32); p1[j] = __shfl_xor(v1[j], 32); }
                        const int pos = row & (SEQ - 1), i0 = (8 * fq) & 15;
                        const f32x4 c0 = *(const f32x4*)(ropec + pos * 16 + i0), c1 = *(const f32x4*)(ropec + pos * 16 + i0 + 4);
                        const f32x4 s0 = *(const f32x4*)(ropes + pos * 16 + i0), s1 = *(const f32x4*)(ropes + pos * 16 + i0 + 4);
                        const float sg = fq < 2 ? -1.f : 1.f;
                        v0 = v0 * c0 + p0 * s0 * sg; v1 = v1 * c1 + p1 * s1 * sg;
                    }
                    if (is_swaq) { v0 = v0 * QSC_SWA; v1 = v1 * QSC_SWA; }
                    u32x4 w; w.x = pk2(v0[0], v0[1]); w.y = pk2(v0[2], v0[3]); w.z = pk2(v1[0], v1[1]); w.w = pk2(v1[2], v1[3]);
                    *(u32x4*)(P + (size_t)row * NPROJ + col) = w;
                    if (is_swav) {
                        const int d = col - 1312, kvh = d >> 6, dd = d & 63, b = row >> 11, s = row & (SEQ - 1);
                        bf16_t* base = vts + ((size_t)((b * 2 + kvh) * 64 + dd)) * SEQ + s;
                        base[0 * SEQ] = (bf16_t)(w.x & 0xffffu); base[1 * SEQ] = (bf16_t)(w.x >> 16);
                        base[2 * SEQ] = (bf16_t)(w.y & 0xffffu); base[3 * SEQ] = (bf16_t)(w.y >> 16);
                        base[4 * SEQ] = (bf16_t)(w.z & 0xffffu); base[5 * SEQ] = (bf16_t)(w.z >> 16);
                        base[6 * SEQ] = (bf16_t)(w.w & 0xffffu); base[7 * SEQ] = (bf16_t)(w.w >> 16);
                    }
                }
        }
    }
};
struct EpiQ {
    static constexpr bool PERM = false;
    bf16_t* Q; const float* ssq_q; const float* ropec; const float* ropes;
    __device__ __forceinline__ void operator()(const f32x4 (&acc)[2][2][4][2], const pg8::Unit& u, int wr, int wc, int fr, int fq) const {
        const int row0 = u.pm * 256 + wr * 64 + fr;
#pragma unroll
        for (int ai = 0; ai < 2; ++ai)
#pragma unroll
            for (int m = 0; m < 4; ++m) {
                const int row = row0 + ai * 128 + m * 16, pos = row & (SEQ - 1);
                const float rs = __builtin_amdgcn_rsqf(ssq_q[row] * (1.0f / QL) + EPS) * QSC_MLA;
#pragma unroll
                for (int bj = 0; bj < 2; ++bj) {
                    const int G = u.pn * 8 + bj * 4 + wc;
                    const bool isrope = (G % 3) == 2;
                    f32x4 x1 = acc[ai][bj][m][0] * rs, x2 = acc[ai][bj][m][1] * rs;
                    if (isrope) {
                        const f32x4 c = *(const f32x4*)(ropec + pos * 16 + 4 * fq), s = *(const f32x4*)(ropes + pos * 16 + 4 * fq);
                        const f32x4 o1 = x1 * c - x2 * s, o2 = x1 * s + x2 * c; x1 = o1; x2 = o2;
                    }
                    bf16_t* p = Q + (size_t)row * QW + G * 32 + 4 * fq;
                    u32x2 w1, w2; w1.x = pk2(x1[0], x1[1]); w1.y = pk2(x1[2], x1[3]); w2.x = pk2(x2[0], x2[1]); w2.y = pk2(x2[2], x2[3]);
                    *(u32x2*)p = w1; *(u32x2*)(p + 16) = w2;
                }
                asm volatile("" ::: "memory");
            }
    }
};
struct EpiKV {
    static constexpr bool PERM = false;
    bf16_t* KN; bf16_t* VT; const float* ssq_kv;
    __device__ __forceinline__ void operator()(const f32x4 (&acc)[2][2][4][2], const pg8::Unit& u, int wr, int wc, int fr, int fq) const {
        const int row0 = u.pm * 256 + wr * 64 + fr;
#pragma unroll
        for (int ai = 0; ai < 2; ++ai)
#pragma unroll
            for (int m = 0; m < 4; ++m) {
                const int row = row0 + ai * 128 + m * 16, b = row >> 11, s = row & (SEQ - 1);
                const float rs = __builtin_amdgcn_rsqf(ssq_kv[row] * (1.0f / KVL) + EPS);
#pragma unroll
                for (int bj = 0; bj < 2; ++bj) {
                    const int head = u.pn * 2 + bj;
                    const f32x4 x1 = acc[ai][bj][m][0] * rs, x2 = acc[ai][bj][m][1] * rs;
                    const unsigned a0 = pk2(x1[0], x1[1]), a1 = pk2(x1[2], x1[3]), b0 = pk2(x2[0], x2[1]), b1 = pk2(x2[2], x2[3]);
                    if (wc < 2) {
                        bf16_t* p = KN + (size_t)row * 512 + head * 64 + wc * 32 + 4 * fq;
                        *(u32x2*)p = (u32x2){a0, a1}; *(u32x2*)(p + 16) = (u32x2){b0, b1};
                    } else {
                        bf16_t* base = VT + ((size_t)((b * 8 + head) * 64 + (wc - 2) * 32 + 4 * fq)) * SEQ + s;
                        base[0 * SEQ] = (bf16_t)(a0 & 0xffffu); base[1 * SEQ] = (bf16_t)(a0 >> 16); base[2 * SEQ] = (bf16_t)(a1 & 0xffffu); base[3 * SEQ] = (bf16_t)(a1 >> 16);
                        base[16 * SEQ] = (bf16_t)(b0 & 0xffffu); base[17 * SEQ] = (bf16_t)(b0 >> 16); base[18 * SEQ] = (bf16_t)(b1 & 0xffffu); base[19 * SEQ] = (bf16_t)(b1 >> 16);
                    }
                }
                asm volatile("" ::: "memory");
            }
    }
};
struct EpiRes {
    static constexpr bool PERM = false;
    const float* base; float* out; const float* gate;
    __device__ __forceinline__ void operator()(const f32x4 (&acc)[2][2][4][2], const pg8::Unit& u, int wr, int wc, int fr, int fq) const {
        const int row0 = u.pm * 256 + wr * 64 + fr, b = u.pm >> 3;
#pragma unroll
        for (int bj = 0; bj < 2; ++bj)
#pragma unroll
            for (int n = 0; n < 2; ++n) {
                const int col = u.pn * 256 + bj * 128 + wc * 32 + n * 16 + 4 * fq;
                const f32x4 gv = *(const f32x4*)(gate + b * 6144 + col);
#pragma unroll
                for (int ai = 0; ai < 2; ++ai)
#pragma unroll
                    for (int m = 0; m < 4; ++m) {
                        const size_t off = (size_t)(row0 + ai * 128 + m * 16) * DM + col;
                        const f32x4 bs = *(const f32x4*)(base + off);
                        *(f32x4*)(out + off) = bs + gv * acc[ai][bj][m][n];
                    }
            }
    }
};
struct EpiUp {
    static constexpr bool PERM = true;
    bf16_t* U;
    __device__ __forceinline__ void operator()(const f32x4 (&acc)[2][2][4][2], const pg8::Unit& u, int wr, int wc, int fr, int fq) const {
        const int row0 = u.pm * 256 + wr * 64 + fr, col0 = u.pn * 256 + wc * 32 + 8 * fq;
#pragma unroll
        for (int ai = 0; ai < 2; ++ai)
#pragma unroll
            for (int m = 0; m < 4; ++m) {
                bf16_t* rowp = U + (size_t)(row0 + ai * 128 + m * 16) * FF + col0;
#pragma unroll
                for (int bj = 0; bj < 2; ++bj) {
                    f32x4 v0 = acc[ai][bj][m][0], v1 = acc[ai][bj][m][1];
#pragma unroll
                    for (int j = 0; j < 4; ++j) { const float a = fmaxf(v0[j], 0.f), c = fmaxf(v1[j], 0.f); v0[j] = a * a; v1[j] = c * c; }
                    u32x4 w; w.x = pk2(v0[0], v0[1]); w.y = pk2(v0[2], v0[3]); w.z = pk2(v1[0], v1[1]); w.w = pk2(v1[2], v1[3]);
                    *(u32x4*)(rowp + bj * 128) = w;
                }
            }
    }
};

constexpr int KSTR = 208, VSTR = 136, VOFF = 64 * KSTR;
template <int QKD, int MODE>
__device__ __forceinline__ void attn_unit(LAS unsigned char* lds, const bf16_t* Q, int ldq, const bf16_t* K1, int ldk1, const bf16_t* K2, int ldk2,
                                          const bf16_t* VT, bf16_t* O, int qpos0, int t_lo, int t_hi, float slope2, float sink2, int tid, int wid, int lane) {
    const int r = lane & 31, hi = lane >> 5;
    const int q0 = qpos0 + 32 * wid;
    constexpr int NKB = QKD / 16;
    bf16x8 qf[NKB];
#pragma unroll
    for (int kb = 0; kb < NKB; ++kb) qf[kb] = *(const bf16x8*)(Q + (size_t)(32 * wid + r) * ldq + 16 * kb + 8 * hi);
    f32x16 o0, o1;
#pragma unroll
    for (int i = 0; i < 16; ++i) { o0[i] = 0.f; o1[i] = 0.f; }
    float mrun = (MODE == 1) ? sink2 : -1e30f;
    float lsum = (MODE == 1) ? (hi == 0 ? 1.f : 0.f) : 0.f;
    const int key1 = tid >> 3, ch1 = tid & 7, key2 = (tid >> 2) & 63, ch2 = tid & 3;
    u32x4 kr, k2r, vr;
    kr = *(const u32x4*)(K1 + (size_t)(64 * t_lo + key1) * ldk1 + ch1 * 8);
    if (QKD == 96) { if (tid < 256) k2r = *(const u32x4*)(K2 + (size_t)(64 * t_lo + key2) * ldk2 + ch2 * 8); }
    vr = *(const u32x4*)(VT + (size_t)key1 * SEQ + 64 * t_lo + ch1 * 8);
    for (int t = t_lo; t <= t_hi; ++t) {
        __syncthreads();
        *(LAS u32x4*)(lds + key1 * KSTR + ch1 * 16) = kr;
        if (QKD == 96) { if (tid < 256) *(LAS u32x4*)(lds + key2 * KSTR + 128 + ch2 * 16) = k2r; }
        *(LAS u32x2*)(lds + VOFF + key1 * VSTR + ch1 * 16) = (u32x2){vr.x, vr.y};
        *(LAS u32x2*)(lds + VOFF + key1 * VSTR + ch1 * 16 + 8) = (u32x2){vr.z, vr.w};
        __syncthreads();
        if (t < t_hi) {
            kr = *(const u32x4*)(K1 + (size_t)(64 * (t + 1) + key1) * ldk1 + ch1 * 8);
            if (QKD == 96) { if (tid < 256) k2r = *(const u32x4*)(K2 + (size_t)(64 * (t + 1) + key2) * ldk2 + ch2 * 8); }
            vr = *(const u32x4*)(VT + (size_t)key1 * SEQ + 64 * (t + 1) + ch1 * 8);
        }
        const int k0 = 64 * t;
        const bool active = (MODE == 0) ? (k0 <= q0 + 31) : ((k0 + 63 >= q0 - 127) && (k0 <= q0 + 31));
        if (active) {
            f32x16 s[2];
#pragma unroll
            for (int sub = 0; sub < 2; ++sub) {
#pragma unroll
                for (int i = 0; i < 16; ++i) s[sub][i] = 0.f;
#pragma unroll
                for (int kb = 0; kb < NKB; ++kb) {
                    const bf16x8 kf = *(const LAS bf16x8*)(lds + (32 * sub + r) * KSTR + (16 * kb + 8 * hi) * 2);
                    s[sub] = __builtin_amdgcn_mfma_f32_32x32x16_bf16(kf, qf[kb], s[sub], 0, 0, 0);
                }
            }
            const int qp = q0 + r;
            if (MODE == 0) {
                if (k0 + 63 > q0) {
#pragma unroll
                    for (int sub = 0; sub < 2; ++sub)
#pragma unroll
                        for (int i = 0; i < 16; ++i) { const int key = k0 + 32 * sub + (i & 3) + 8 * (i >> 2) + 4 * hi; if (key > qp) s[sub][i] = -INFINITY; }
                }
            } else {
#pragma unroll
                for (int sub = 0; sub < 2; ++sub)
#pragma unroll
                    for (int i = 0; i < 16; ++i) { const int key = k0 + 32 * sub + (i & 3) + 8 * (i >> 2) + 4 * hi; const int dist = qp - key;
                        s[sub][i] = (dist < 0 || dist >= 128) ? -INFINITY : (s[sub][i] - slope2 * (float)dist); }
            }
            float mx = -INFINITY;
#pragma unroll
            for (int sub = 0; sub < 2; ++sub)
#pragma unroll
                for (int i = 0; i < 16; ++i) mx = fmaxf(mx, s[sub][i]);
            mx = fmaxf(mx, __shfl_xor(mx, 32));
            const float mn = fmaxf(mrun, mx);
            const float alpha = __builtin_amdgcn_exp2f(mrun - mn);
            mrun = mn;
            float psum = 0.f;
#pragma unroll
            for (int sub = 0; sub < 2; ++sub)
#pragma unroll
                for (int i = 0; i < 16; ++i) { const float p = __builtin_amdgcn_exp2f(s[sub][i] - mn); s[sub][i] = p; psum += p; }
            lsum = lsum * alpha + psum;
            o0 = o0 * alpha; o1 = o1 * alpha;
#pragma unroll
            for (int sub = 0; sub < 2; ++sub)
#pragma unroll
                for (int jb = 0; jb < 2; ++jb) {
                    u32x4 pw;
                    pw.x = pk2(s[sub][8 * jb + 0], s[sub][8 * jb + 1]); pw.y = pk2(s[sub][8 * jb + 2], s[sub][8 * jb + 3]);
                    pw.z = pk2(s[sub][8 * jb + 4], s[sub][8 * jb + 5]); pw.w = pk2(s[sub][8 * jb + 6], s[sub][8 * jb + 7]);
                    const bf16x8 pf = __builtin_bit_cast(bf16x8, pw);
                    const LAS unsigned char* vp = lds + VOFF + r * VSTR + (32 * sub + 16 * jb + 4 * hi) * 2;
                    {
                        const u32x2 a = *(const LAS u32x2*)vp, b = *(const LAS u32x2*)(vp + 16);
                        const bf16x8 vf = __builtin_bit_cast(bf16x8, (u32x4){a.x, a.y, b.x, b.y});
                        o0 = __builtin_amdgcn_mfma_f32_32x32x16_bf16(vf, pf, o0, 0, 0, 0);
                    }
                    {
                        const u32x2 a = *(const LAS u32x2*)(vp + 32 * VSTR), b = *(const LAS u32x2*)(vp + 32 * VSTR + 16);
                        const bf16x8 vf = __builtin_bit_cast(bf16x8, (u32x4){a.x, a.y, b.x, b.y});
                        o1 = __builtin_amdgcn_mfma_f32_32x32x16_bf16(vf, pf, o1, 0, 0, 0);
                    }
                }
        }
    }
    const float ltot = lsum + __shfl_xor(lsum, 32);
    const float inv = 1.0f / ltot;
    bf16_t* op = O + (size_t)(32 * wid + r) * DM + 4 * hi;
#pragma unroll
    for (int g = 0; g < 4; ++g) {
        *(u32x2*)(op + 8 * g) = (u32x2){pk2(o0[4 * g] * inv, o0[4 * g + 1] * inv), pk2(o0[4 * g + 2] * inv, o0[4 * g + 3] * inv)};
        *(u32x2*)(op + 32 + 8 * g) = (u32x2){pk2(o1[4 * g] * inv, o1[4 * g + 1] * inv), pk2(o1[4 * g + 2] * inv, o1[4 * g + 3] * inv)};
    }
}

__device__ __forceinline__ void p0_transpose_item(const float* W, int K, int N, bf16_t* WT, const float* kscale, LAS float* scr, int item, int lane) {
    const int nblk = N / 32, kb = item / nblk, nb = item % nblk, k0 = 64 * kb, n0 = 32 * nb;
#pragma unroll 8
    for (int i = 0; i < 32; ++i) { const int kk = 2 * i + (lane >> 5); float v = W[(size_t)(k0 + kk) * N + n0 + (lane & 31)]; if (kscale) v *= kscale[k0 + kk]; scr[kk * 33 + (lane & 31)] = v; }
    asm volatile("s_waitcnt lgkmcnt(0)" ::: "memory");
    const int c = lane & 7;
#pragma unroll
    for (int j = 0; j < 4; ++j) { const int n = (lane >> 3) + 8 * j; const LAS float* s = scr + (8 * c) * 33 + n;
        u32x4 o; o.x = pk2(s[0 * 33], s[1 * 33]); o.y = pk2(s[2 * 33], s[3 * 33]); o.z = pk2(s[4 * 33], s[5 * 33]); o.w = pk2(s[6 * 33], s[7 * 33]);
        *(u32x4*)(WT + (size_t)(n0 + n) * K + k0 + 8 * c) = o; }
    asm volatile("s_waitcnt lgkmcnt(0)" ::: "memory");
}
__device__ __forceinline__ void p0_mod_item(const float* c, const float* w_ada, const float* b_ada, float* mod, LAS float* scr, int item, int lane) {
    const int kc = item / 24, nb = item % 24, k0 = 64 * kc, n0 = 256 * nb + 4 * lane;
#pragma unroll
    for (int b = 0; b < 8; ++b) { const float x = c[b * DM + k0 + lane]; scr[b * 64 + lane] = x / (1.0f + __expf(-x)); }
    asm volatile("s_waitcnt lgkmcnt(0)" ::: "memory");
    f32x4 acc[8];
#pragma unroll
    for (int b = 0; b < 8; ++b) acc[b] = (f32x4){0.f, 0.f, 0.f, 0.f};
#pragma unroll 4
    for (int kk = 0; kk < 64; ++kk) {
        const f32x4 w = *(const f32x4*)(w_ada + (size_t)(k0 + kk) * 6144 + n0);
#pragma unroll
        for (int b = 0; b < 8; ++b) acc[b] += w * scr[b * 64 + kk];
    }
    f32x4 bias = (f32x4){0.f, 0.f, 0.f, 0.f};
    if (kc == 0) bias = *(const f32x4*)(b_ada + n0);
#pragma unroll
    for (int b = 0; b < 8; ++b)
#pragma unroll
        for (int j = 0; j < 4; ++j) unsafeAtomicAdd(mod + b * 6144 + n0 + j, acc[b][j] + bias[j]);
    asm volatile("s_waitcnt lgkmcnt(0)" ::: "memory");
}
__device__ __forceinline__ void row_norm_mod(const float* xrow, bf16_t* orow, const float* g, const float* sc, const float* sh, int lane) {
    const f32x4* xr = (const f32x4*)xrow + lane;
    f32x4 v[4]; float s = 0.f;
#pragma unroll
    for (int j = 0; j < 4; ++j) { v[j] = xr[64 * j]; s += (v[j][0] * v[j][0] + v[j][1] * v[j][1]) + (v[j][2] * v[j][2] + v[j][3] * v[j][3]); }
    const float rstd = 1.0f / sqrtf(wave_sum(s) * (1.0f / DM) + EPS);
    u32x2* o8 = (u32x2*)orow + lane;
#pragma unroll
    for (int j = 0; j < 4; ++j) {
        const f32x4 gg = ((const f32x4*)g)[64 * j + lane], ss = ((const f32x4*)sc)[64 * j + lane], hh = ((const f32x4*)sh)[64 * j + lane];
        const f32x4 y = v[j] * rstd * gg * (ss + 1.0f) + hh;
        o8[64 * j] = (u32x2){pk2(y[0], y[1]), pk2(y[2], y[3])};
    }
}
__device__ __forceinline__ void row_norm_final(const float* xrow, float* orow, const float* g, int lane) {
    const f32x4* xr = (const f32x4*)xrow + lane;
    f32x4 v[4]; float s = 0.f;
#pragma unroll
    for (int j = 0; j < 4; ++j) { v[j] = xr[64 * j]; s += (v[j][0] * v[j][0] + v[j][1] * v[j][1]) + (v[j][2] * v[j][2] + v[j][3] * v[j][3]); }
    const float rstd = 1.0f / sqrtf(wave_sum(s) * (1.0f / DM) + EPS);
    f32x4* o = (f32x4*)orow + lane;
#pragma unroll
    for (int j = 0; j < 4; ++j) o[64 * j] = v[j] * rstd * ((const f32x4*)g)[64 * j + lane];
}


#define XB_TMO      128
#define XB_XCNT(j)  (256  + 64 * (j))
#define XB_XSUB(j)  (1280 + 64 * (j))
#define XB_XGEN(j)  (2304 + 64 * (j))
#define XB_TOP      3328
#define XB_TOPGEN   3392
#define XCD_BAR_WORDS 3456
#define XB_SPIN_CAP (1u << 18)
__device__ __forceinline__ unsigned xb_ld(unsigned* p)              { return __hip_atomic_load(p, __ATOMIC_RELAXED, __HIP_MEMORY_SCOPE_AGENT); }
__device__ __forceinline__ unsigned xb_add(unsigned* p, unsigned v) { return __hip_atomic_fetch_add(p, v, __ATOMIC_RELAXED, __HIP_MEMORY_SCOPE_AGENT); }
__device__ __forceinline__ unsigned xb_xcc_id() { return (unsigned)__builtin_amdgcn_s_getreg((3 << 11) | 20) & 0xFu; }
#define XB_SPIN(cond, bar) do { unsigned _sp = 0; while (cond) { __builtin_amdgcn_s_sleep(1); \
    if ((++_sp & 255u) == 0u) { if (xb_ld(&(bar)[XB_TMO])) break; if (_sp > XB_SPIN_CAP) { atomicAdd(&(bar)[XB_TMO], 1u); break; } } } } while (0)
struct XcdBarrier { unsigned* bar; unsigned x; volatile LAS unsigned* st; };
__device__ __forceinline__ XcdBarrier xcd_barrier_post(unsigned* bar, volatile LAS unsigned* st) {
    XcdBarrier b; b.bar = bar; b.x = xb_xcc_id(); b.st = st;
    if (threadIdx.x == 0) (void)xb_add(&bar[XB_XCNT(b.x)], 1u);
    return b;
}
__device__ __forceinline__ void xcd_barrier_complete(unsigned* bar, unsigned x, unsigned& nloc, unsigned& nx) {
    const unsigned G = gridDim.x * gridDim.y * gridDim.z;
    unsigned sum, cnt, mine, sp = 0u;
    for (;;) {
        sum = 0u; cnt = 0u; mine = 0u;
#pragma unroll
        for (unsigned j = 0; j < 16; ++j) { const unsigned c = xb_ld(&bar[XB_XCNT(j)]); sum += c; cnt += (c > 0u) ? 1u : 0u; mine = (j == x) ? c : mine; }
        if (sum == G) break;
        __builtin_amdgcn_s_sleep(1);
        if ((++sp & 255u) == 0u) { if (xb_ld(&bar[XB_TMO])) break; if (sp > XB_SPIN_CAP) { atomicAdd(&bar[XB_TMO], 1u); break; } }
    }
    nloc = mine > 0u ? mine : 1u; nx = cnt > 0u ? cnt : 1u;
}
__device__ __forceinline__ void xcd_barrier(const XcdBarrier& b) {
    asm volatile("s_waitcnt vmcnt(0)" ::: "memory");
    __syncthreads();
    if (threadIdx.x == 0) {
        unsigned* bar = b.bar;
        __builtin_amdgcn_s_waitcnt(0);
        unsigned nloc = b.st[0], nx = b.st[1];
        if (nloc == 0u) { xcd_barrier_complete(bar, b.x, nloc, nx); b.st[0] = nloc; b.st[1] = nx; }
        const unsigned old = xb_add(&bar[XB_XSUB(b.x)], 1u);
        const unsigned gen = old / nloc;
        if (old + 1u == (gen + 1u) * nloc) {
            __builtin_amdgcn_fence(__ATOMIC_RELEASE, "agent");
            asm volatile("s_waitcnt vmcnt(0)" ::: "memory");
            const unsigned og = xb_add(&bar[XB_TOP], 1u);
            const unsigned tg = og / nx;
            if (og + 1u == (tg + 1u) * nx) xb_add(&bar[XB_TOPGEN], 1u);
            else XB_SPIN(xb_ld(&bar[XB_TOPGEN]) == tg, bar);
            __builtin_amdgcn_fence(__ATOMIC_ACQUIRE, "agent");
            xb_add(&bar[XB_XGEN(b.x)], 1u);
            asm volatile("s_waitcnt vmcnt(0)" ::: "memory");
        } else {
            XB_SPIN(xb_ld(&bar[XB_XGEN(b.x)]) == gen, bar);
            __builtin_amdgcn_fence(__ATOMIC_ACQUIRE, "agent");
            asm volatile("s_waitcnt vmcnt(0)" ::: "memory");
        }
    }
    __syncthreads();
}

struct Args { const float* in[16]; float* out; unsigned char* ws; int ph_lo, ph_hi, pad0, pad1; };
constexpr int NPHASE = 10;

__global__ void __launch_bounds__(512, 2) fwd_megakernel(Args args) {
    extern __shared__ __attribute__((aligned(16))) unsigned char lds_raw[];
    LAS unsigned char* lds = (LAS unsigned char*)lds_raw;
    cg::grid_group grid = cg::this_grid();
    const int tid = threadIdx.x, lane = tid & 63, wave = __builtin_amdgcn_readfirstlane(tid >> 6);
    const int G = gridDim.x, bx = blockIdx.x;
    const int vcu = (G % 8 == 0) ? (bx % 8) * (G / 8) + bx / 8 : bx;
    const int gw = vcu * 8 + wave, NGW = G * 8;
    unsigned char* ws = args.ws;
    const float* x = args.in[0]; const float* cvec = args.in[1]; const float* w_ada = args.in[2]; const float* b_ada = args.in[3];
    const float* norm_mix_g = args.in[4]; const float* w_in = args.in[5]; const float* g_qa = args.in[6]; const float* w_qb = args.in[7];
    const float* g_kva = args.in[8]; const float* w_kvb = args.in[9]; const float* sinks = args.in[10]; const float* w_o = args.in[11];
    const float* norm_mlp_g = args.in[12]; const float* w_up = args.in[13]; const float* w_down = args.in[14]; const float* final_g = args.in[15];
    float* out = args.out;
    float* mod = (float*)(ws + WS_MOD); float* ssq_q = (float*)(ws + WS_SSQQ); float* ssq_kv = (float*)(ws + WS_SSQKV);
    float* ropec = (float*)(ws + WS_ROPE); float* ropes = ropec + SEQ * 16;
    bf16_t* win_t = (bf16_t*)(ws + WS_WIN); bf16_t* wqb_t = (bf16_t*)(ws + WS_WQB); bf16_t* wkvb_t = (bf16_t*)(ws + WS_WKVB);
    bf16_t* wo_t = (bf16_t*)(ws + WS_WO); bf16_t* wup_t = (bf16_t*)(ws + WS_WUP); bf16_t* wdn_t = (bf16_t*)(ws + WS_WDN);
    bf16_t* hbuf = (bf16_t*)(ws + WS_H); bf16_t* proj = (bf16_t*)(ws + WS_PROJ); bf16_t* qbuf = (bf16_t*)(ws + WS_Q); bf16_t* knope = (bf16_t*)(ws + WS_KN);
    bf16_t* vtm = (bf16_t*)(ws + WS_VTM); bf16_t* vts = (bf16_t*)(ws + WS_VTS); bf16_t* mix = (bf16_t*)(ws + WS_MIX); bf16_t* ubuf = (bf16_t*)(ws + WS_U);

    const int lo = args.ph_lo, hi = args.ph_hi;
    volatile LAS unsigned* bst = (volatile LAS unsigned*)(lds + 131072);
    if (tid < 2) bst[tid] = 0u;
    __syncthreads();
    XcdBarrier xbar; xbar.bar = (unsigned*)(ws + WS_BAR); xbar.x = 0; xbar.st = bst;
    if (hi - lo > 1) xbar = xcd_barrier_post((unsigned*)(ws + WS_BAR), bst);
    if (lo < 0) grid.sync();
#ifndef PH_MASK
#define PH_MASK 0x3ff
#endif
#define IN(k) (((PH_MASK >> (k)) & 1) && lo <= (k) && (k) < hi)
#define GSYNC() xcd_barrier(xbar)
#define SEAM(k) do { if (IN(k) && IN((k) + 1)) GSYNC(); } while (0)
#ifndef REPMASK
#define REPMASK 0
#endif
#ifndef REPN
#define REPN 3
#endif
#ifndef XSYNC
#define XSYNC 0
#endif
#define REP(k) for (int rep_ = 0; rep_ < (((REPMASK >> (k)) & 1) ? REPN : 1); ++rep_)

    if (IN(0)) {
        LAS float* scr = (LAS float*)(lds + wave * 16384);
        constexpr int I_MOD = 16 * 24, I_IN = 16 * 45, I_QB = 6 * 24, I_KVB = 4 * 32, I_O = 16 * 32, I_UP = 16 * 128, I_DN = 64 * 32;
        constexpr int NITEMS = I_MOD + I_IN + I_QB + I_KVB + I_O + I_UP + I_DN;
        for (int it = gw; it < NITEMS; it += NGW) {
            int r = it;
            if (r < I_MOD) { p0_mod_item(cvec, w_ada, b_ada, mod, scr, r, lane); continue; } r -= I_MOD;
            if (r < I_IN) { p0_transpose_item(w_in, DM, IN_COLS, win_t, nullptr, scr, r, lane); continue; } r -= I_IN;
            if (r < I_QB) { p0_transpose_item(w_qb, QL, QW, wqb_t, g_qa, scr, r, lane); continue; } r -= I_QB;
            if (r < I_KVB) { p0_transpose_item(w_kvb, KVL, KVW, wkvb_t, g_kva, scr, r, lane); continue; } r -= I_KVB;
            if (r < I_O) { p0_transpose_item(w_o, DM, DM, wo_t, nullptr, scr, r, lane); continue; } r -= I_O;
            if (r < I_UP) { p0_transpose_item(w_up, DM, FF, wup_t, nullptr, scr, r, lane); continue; } r -= I_UP;
            p0_transpose_item(w_down, FF, DM, wdn_t, nullptr, scr, r, lane);
        }
        const int gt = vcu * 512 + tid, NGT = G * 512;
        for (int i = gt; i < (NPROJ - IN_COLS) * DM / 8; i += NGT) ((u32x4*)(win_t + (size_t)IN_COLS * DM))[i] = (u32x4){0u, 0u, 0u, 0u};
        for (int i = gt; i < SEQ * 16; i += NGT) {
            const int pos = i >> 4, fi = i & 15;
            double f = (fi & 3) == 0 ? 1.0 : ((fi & 3) == 1 ? 0.5623413251903491 : ((fi & 3) == 2 ? 0.31622776601683794 : 0.1778279410038923));
            const int dec = fi >> 2; f *= (dec == 0 ? 1.0 : (dec == 1 ? 0.1 : (dec == 2 ? 0.01 : 0.001)));
            const float ang32 = (float)pos * (float)f;
            const double rev = (double)ang32 * 0.15915494309189535;
            const float fr = (float)(rev - __builtin_rint(rev));
            ropec[i] = __builtin_amdgcn_cosf(fr); ropes[i] = __builtin_amdgcn_sinf(fr);
        }
    }
    SEAM(0);
    for (int xs_ = 0; xs_ < XSYNC; ++xs_) GSYNC();
    REP(1) { if (rep_) GSYNC();
    if (IN(1)) {
        for (int m = gw; m < MT; m += NGW) { const int b = m >> 11;
            row_norm_mod(x + (size_t)m * DM, hbuf + (size_t)m * DM, norm_mix_g, mod + b * 6144 + 1024, mod + b * 6144, lane); }
    }
    }
    SEAM(1);
    if (IN(2)) {
        pg8::Gemm g{hbuf, win_t, MT, NPROJ, DM, DM}; pg8::StaticOrder S; S.init(MT, NPROJ, G, bx);
        EpiProj E{proj, ssq_q, ssq_kv, ropec, ropes, vts};
        pg8::gemm_phase<EpiProj, true>(lds, g, S, E);
    }
    SEAM(2);
    REP(3) { if (rep_) GSYNC();
    if (IN(3)) {
        { pg8::Gemm g{proj, wqb_t, MT, QW, QL, NPROJ}; pg8::StaticOrder S; S.init(MT, QW, G, bx);
          EpiQ E{qbuf, ssq_q, ropec, ropes}; pg8::gemm_phase<EpiQ, true>(lds, g, S, E); }
        { pg8::Gemm g{proj + QL, wkvb_t, MT, KVW, KVL, NPROJ}; pg8::StaticOrder S; S.init(MT, KVW, G, (bx + 64) % G);
          EpiKV E{knope, vtm, ssq_kv}; pg8::gemm_phase<EpiKV, true>(lds, g, S, E); }
    }
    }
    SEAM(3);
    REP(4) { if (rep_) GSYNC();
    if (IN(4)) {
        for (int it = vcu; it < 768; it += G) {
            if (it < 256) {
                const int b = it >> 5, h = (it >> 2) & 7, pp = it & 3;
#pragma unroll 1
                for (int k = 0; k < 2; ++k) {
                    const int qb = k == 0 ? 7 - pp : pp;
                    const size_t row0 = (size_t)b * SEQ + qb * 256;
                    attn_unit<96, 0>(lds, qbuf + row0 * QW + h * 96, QW, knope + (size_t)b * SEQ * 512 + h * 64, 512, proj + (size_t)b * SEQ * NPROJ + 640, NPROJ,
                                     vtm + (size_t)(b * 8 + h) * 64 * SEQ, mix + row0 * DM + h * 64, qb * 256, 0, 4 * qb + 3, 0.f, 0.f, tid, wave, lane);
                }
            } else {
                const int id = it - 256, b = id >> 6, hq = (id >> 3) & 7, qb = id & 7, kvh = hq >> 2;
                const size_t row0 = (size_t)b * SEQ + qb * 256;
                const float slope2 = exp2f(-(float)(hq + 1)) * LOG2E, sink2 = sinks[hq] * LOG2E;
                attn_unit<64, 1>(lds, proj + row0 * NPROJ + 672 + hq * 64, NPROJ, proj + (size_t)b * SEQ * NPROJ + 1184 + kvh * 64, NPROJ, nullptr, 0,
                                 vts + (size_t)(b * 2 + kvh) * 64 * SEQ, mix + row0 * DM + 512 + hq * 64, qb * 256, qb == 0 ? 0 : 4 * qb - 2, 4 * qb + 3, slope2, sink2, tid, wave, lane);
            }
        }
        __syncthreads();
    }
    }
    SEAM(4);
    REP(5) { if (rep_) GSYNC();
    if (IN(5)) {
        pg8::Gemm g{mix, wo_t, MT, DM, DM, DM}; pg8::StaticOrder S; S.init(MT, DM, G, bx);
        EpiRes E{x, out, mod + 2 * 1024};
        pg8::gemm_phase<EpiRes, true>(lds, g, S, E);
    }
    }
    SEAM(5);
    REP(6) { if (rep_) GSYNC();
    if (IN(6)) {
        for (int m = gw; m < MT; m += NGW) { const int b = m >> 11;
            row_norm_mod(out + (size_t)m * DM, hbuf + (size_t)m * DM, norm_mlp_g, mod + b * 6144 + 4 * 1024, mod + b * 6144 + 3 * 1024, lane); }
    }
    }
    SEAM(6);
    REP(7) { if (rep_) GSYNC();
    if (IN(7)) {
        pg8::Gemm g{hbuf, wup_t, MT, FF, DM, DM}; pg8::StaticOrder S; S.init(MT, FF, G, bx);
        EpiUp E{ubuf};
        pg8::gemm_phase<EpiUp, true>(lds, g, S, E);
    }
    }
    SEAM(7);
    if (IN(8)) {
        pg8::Gemm g{ubuf, wdn_t, MT, DM, FF, FF}; pg8::StaticOrder S; S.init(MT, DM, G, bx);
        EpiRes E{out, out, mod + 5 * 1024};
        pg8::gemm_phase<EpiRes, true>(lds, g, S, E);
    }
    SEAM(8);
    if (IN(9)) {
        for (int m = gw; m < MT; m += NGW) row_norm_final(out + (size_t)m * DM, out + (size_t)m * DM, final_g, lane);
    }
#undef IN
#undef SEAM
}

extern "C" void kernel_launch(void* const* d_in, const int* in_sizes, int n_in, void* d_out, int out_size, void* d_ws, size_t ws_size, hipStream_t stream) {
    static int grid = 0;
    if (grid == 0) {
        if (n_in != 16 || out_size != MT * DM || ws_size < WS_END) { fprintf(stderr, "kernel_launch: unexpected shapes (n_in %d out %d ws %zu)\n", n_in, out_size, ws_size); grid = -1; return; }
        int dev = 0, cus = 0, per_cu = 0;
        hipGetDevice(&dev);
        hipDeviceGetAttribute(&cus, hipDeviceAttributeMultiprocessorCount, dev);
        if (hipFuncSetAttribute((const void*)fwd_megakernel, hipFuncAttributeMaxDynamicSharedMemorySize, LDS_BYTES) != hipSuccess) { fprintf(stderr, "kernel_launch: hipFuncSetAttribute failed\n"); }
        if (hipOccupancyMaxActiveBlocksPerMultiprocessor(&per_cu, (const void*)fwd_megakernel, 512, LDS_BYTES) != hipSuccess || per_cu < 1) { fprintf(stderr, "kernel_launch: occupancy query says %d\n", per_cu); per_cu = 1; }
        (void)hipGetLastError();
        grid = cus * per_cu;
        if (grid > 256) grid = 256;
    }
    if (grid < 0) return;
    hipMemsetAsync((char*)d_ws, 0, WS_ZERO_BYTES, stream);
    Args a{};
    for (int i = 0; i < 16; ++i) a.in[i] = (const float*)d_in[i];
    a.out = (float*)d_out; a.ws = (unsigned char*)d_ws;
#if MK_PER_PHASE
    for (int p = 0; p < NPHASE; ++p) {
        a.ph_lo = p; a.ph_hi = p + 1;
        hipLaunchKernelGGL(fwd_megakernel, dim3(grid), dim3(512), LDS_BYTES, stream, a);
    }
#else
    a.ph_lo = 0; a.ph_hi = NPHASE;
    void* kargs[] = {&a};
    hipError_t e = hipLaunchCooperativeKernel((const void*)fwd_megakernel, dim3(grid), dim3(512), kargs, LDS_BYTES, stream);
    if (e != hipSuccess) fprintf(stderr, "cooperative launch failed: %s (grid %d)\n", hipGetErrorString(e), grid);
#endif
}
```

```cpp
#include <hip/hip_runtime.h>
#include <hip/hip_cooperative_groups.h>
#include <cstdio>
#include <cstdint>
namespace cg = cooperative_groups;

#define LAS __attribute__((address_space(3)))
typedef unsigned short bf16_t;
typedef short bf16x8 __attribute__((ext_vector_type(8)));
typedef short s16x4 __attribute__((ext_vector_type(4)));
typedef float f32x4 __attribute__((ext_vector_type(4)));
typedef float f32x2 __attribute__((ext_vector_type(2)));
typedef float f32x16 __attribute__((ext_vector_type(16)));
typedef unsigned u32x4 __attribute__((ext_vector_type(4)));
typedef unsigned u32x2 __attribute__((ext_vector_type(2)));
typedef __bf16 bf2_t __attribute__((ext_vector_type(2)));

#ifndef MK_PER_PHASE
#define MK_PER_PHASE 0
#endif

constexpr int NB = 8, SEQ = 2048, DM = 1024, MT = NB * SEQ, FF = 4096;
constexpr int NPROJ = 1536, IN_COLS = 1440;
constexpr int QL = 384, KVL = 256;
constexpr int QW = 768, KVW = 1024;
constexpr float EPS = 1e-6f;
constexpr float LOG2E = 1.4426950408889634f;
constexpr float QSC_MLA = 0.10206207261596575f * LOG2E;
constexpr float QSC_SWA = 0.125f * LOG2E;

constexpr size_t MiB = 1u << 20;
constexpr size_t WS_MOD = 0, WS_SSQQ = 256 * 1024, WS_SSQKV = 320 * 1024, WS_BAR = 384 * 1024, WS_SSQX1 = 400 * 1024, WS_SSQX2 = 464 * 1024, WS_CNT = 528 * 1024, WS_ZERO_BYTES = 560 * 1024;
constexpr size_t WS_ROPE = 1 * MiB;
constexpr size_t WS_WIN = 2 * MiB, WS_WQB = 5 * MiB, WS_WKVB = 6 * MiB, WS_WO = 7 * MiB, WS_WUP = 9 * MiB, WS_WDN = 17 * MiB;
constexpr size_t WS_H = 25 * MiB, WS_PROJ = 57 * MiB, WS_Q = 105 * MiB, WS_KN = 129 * MiB, WS_VTM = 145 * MiB, WS_VTS = 161 * MiB, WS_MIX = 165 * MiB;
constexpr size_t WS_U = 57 * MiB;
constexpr size_t WS_END = 197 * MiB;
constexpr int LDS_BYTES = 131072 + 256;

__device__ __forceinline__ unsigned pk2(float lo, float hi) { f32x2 v = {lo, hi}; bf2_t r = __builtin_convertvector(v, bf2_t); return __builtin_bit_cast(unsigned, r); }
__device__ __forceinline__ bf16_t f2bf(float f) { return (bf16_t)(pk2(f, 0.f) & 0xffffu); }
__device__ __forceinline__ float wave_sum(float v) {
#pragma unroll
    for (int o = 1; o < 64; o <<= 1) v += __shfl_xor(v, o);
    return v;
}

namespace pg8 {
constexpr int BM = 256, BK = 64, HALF = 128, HTB = HALF * BK * 2, STAGE_BYTES = 8 * HTB, NXCD = 8, WGM = 8;
__host__ __device__ __forceinline__ int lds_byte(int r, int c) { const int st = (r >> 4) * 2 + (c >> 5), rr = r & 15, cc = c & 31, ob = rr * 64 + cc * 2; return st * 1024 + (ob ^ (((ob >> 9) & 1) << 5)); }
__host__ __device__ __forceinline__ void stage_rc(int b, int& R, int& C) { const int st = b / 1024, sb = b % 1024, swz = sb ^ (((sb >> 9) & 1) << 5); R = (st >> 1) * 16 + swz / 64; C = (st & 1) * 32 + (swz % 64) / 2; }
__host__ __device__ __forceinline__ int perm32(int rho) { const int n = rho >> 4, i = rho & 15; return 8 * (i >> 2) + 4 * n + (i & 3); }

struct Unit { int pm, pn; };
struct Gemm { const bf16_t* A; const bf16_t* Bt; int M, N, K, lda; };

struct StaticOrder {
    int nM, nN, nwg, G, c;
    __device__ void init(int M, int N, int G_, int c_) { nM = M / BM; nN = N / BM; nwg = nM * nN; G = G_; c = c_; }
    __device__ bool next(int i, Unit& u) const {
        const long L = (long)i * G + c; if (L >= nwg) return false;
        int wgid = (int)L; { const int q = nwg / NXCD, r = nwg % NXCD, xcd = wgid % NXCD, off = wgid / NXCD; wgid = (xcd < r ? xcd * (q + 1) : r * (q + 1) + (xcd - r) * q) + off; }
        const int nig = WGM * nN, gid = wgid / nig, fm = gid * WGM, gsz = (nM - fm) < WGM ? (nM - fm) : WGM;
        u.pm = fm + ((wgid % nig) % gsz); u.pn = (wgid % nig) / gsz; return true;
    }
};

template <class Epi, bool ALIGN_EPI>
__device__ __forceinline__ void gemm_phase(LAS unsigned char* lds, const Gemm g, const StaticOrder& S, const Epi& E) {
    const int tid = threadIdx.x, wid = __builtin_amdgcn_readfirstlane(tid >> 6), lane = tid & 63, wr = wid >> 2, wc = wid & 3, fr = lane & 15, fq = lane >> 4;
    const int K = g.K, nt = K / BK, lda = g.lda;
    unsigned voffA[2], voffB[2];
#pragma unroll
    for (int i = 0; i < 2; ++i) { int R, C; stage_rc(tid * 16 + i * 8192, R, C); const int Rb = Epi::PERM ? ((R & ~31) + perm32(R & 31)) : R;
        voffA[i] = (unsigned)(R * lda + C) * 2u; voffB[i] = (unsigned)(Rb * K + C) * 2u; }
    const size_t kstep = (size_t)(BK * 2);
    const size_t hstepA = (size_t)HALF * lda * 2, hstepB = (size_t)HALF * K * 2;
    const size_t tstepA = 2 * hstepA, tstepB = 2 * hstepB;
    const unsigned ldsw = (unsigned)wid * 1024u;
    const int aoff = lds_byte(wr * 64 + fr, fq * 8), boff = lds_byte(wc * 32 + fr, fq * 8);
#define PG8_SA(b, h) (((b) * 2 + (h)) * HTB)
#define PG8_SB(b, h) ((4 + (b) * 2 + (h)) * HTB)
#define PG8_STAGE(bufoff, gbase, voff) do { _Pragma("unroll") for (int _i = 0; _i < 2; ++_i) \
        __builtin_amdgcn_global_load_lds((const unsigned*)((const char*)(gbase) + (voff)[_i]), (LAS unsigned*)(lds + (bufoff) + ldsw + _i * 8192), 16, 0, 0); } while (0)
#define PG8_LDA(dst, b, h) do { _Pragma("unroll") for (int m = 0; m < 4; ++m) _Pragma("unroll") for (int k = 0; k < 2; ++k) dst[m][k] = *(const LAS bf16x8*)(lds + PG8_SA(b, h) + aoff + m * 2048 + k * 1024); } while (0)
#define PG8_LDB(dst, b, h) do { _Pragma("unroll") for (int n = 0; n < 2; ++n) _Pragma("unroll") for (int k = 0; k < 2; ++k) dst[n][k] = *(const LAS bf16x8*)(lds + PG8_SB(b, h) + boff + n * 2048 + k * 1024); } while (0)
#define PG8_MMA(ai, bj, At, Bt) do { __builtin_amdgcn_s_setprio(1); _Pragma("unroll") for (int m = 0; m < 4; ++m) _Pragma("unroll") for (int n = 0; n < 2; ++n) _Pragma("unroll") for (int k = 0; k < 2; ++k) \
        acc[ai][bj][m][n] = __builtin_amdgcn_mfma_f32_16x16x32_bf16(Bt[n][k], At[m][k], acc[ai][bj][m][n], 0, 0, 0); __builtin_amdgcn_s_setprio(0); } while (0)
#define PG8_WAIT_V(n) asm volatile("s_waitcnt vmcnt(" #n ")" ::: "memory")
#define PG8_WAIT_L(n) asm volatile("s_waitcnt lgkmcnt(" #n ")" ::: "memory")
#define PG8_BAR __builtin_amdgcn_s_barrier()
#define PG8_SCHED __builtin_amdgcn_sched_barrier(0)
    Unit cur, nxt; int ui = 0;
    if (!S.next(0, cur)) return;
    f32x4 acc[2][2][4][2];
#pragma unroll
    for (int a = 0; a < 2; ++a)
#pragma unroll
        for (int b = 0; b < 2; ++b)
#pragma unroll
            for (int m = 0; m < 4; ++m)
#pragma unroll
                for (int n = 0; n < 2; ++n) acc[a][b][m][n] = (f32x4){0.f, 0.f, 0.f, 0.f};
    bf16x8 At[4][2], B0[2][2], B1[2][2];
    const char* cA = (const char*)g.A + (size_t)cur.pm * tstepA; const char* cB = (const char*)g.Bt + (size_t)cur.pn * tstepB;
    {
        PG8_STAGE(PG8_SB(0, 0), cB, voffB); PG8_STAGE(PG8_SB(0, 1), cB + hstepB, voffB); PG8_STAGE(PG8_SA(0, 0), cA, voffA); PG8_STAGE(PG8_SA(0, 1), cA + hstepA, voffA);
        if (wr == 1) PG8_BAR;
        PG8_WAIT_V(2); PG8_BAR;
        PG8_STAGE(PG8_SB(1, 0), cB + kstep, voffB); PG8_STAGE(PG8_SA(1, 0), cA + kstep, voffA); PG8_STAGE(PG8_SB(1, 1), cB + hstepB + kstep, voffB);
        PG8_WAIT_V(6); PG8_BAR;
    }
    for (;;) {
        const bool has_next = S.next(ui + 1, nxt);
        const char* nA = has_next ? (const char*)g.A + (size_t)nxt.pm * tstepA : cA; const char* nB = has_next ? (const char*)g.Bt + (size_t)nxt.pn * tstepB : cB;
#pragma unroll 1
        for (int t = 0; t < nt; t += 2) {
            const bool last = (t == nt - 2);
            const char* a1 = cA + (size_t)(t + 1) * kstep;
            const char* a2 = last ? nA : cA + (size_t)(t + 2) * kstep; const char* b2 = last ? nB : cB + (size_t)(t + 2) * kstep;
            const char* a3 = a2 + kstep; const char* b3 = b2 + kstep;
            PG8_LDB(B0, 0, 0); PG8_LDB(B1, 0, 1); PG8_SCHED; PG8_LDA(At, 0, 0); PG8_STAGE(PG8_SA(1, 1), a1 + hstepA, voffA);
            PG8_WAIT_V(8); PG8_WAIT_L(0); PG8_BAR; PG8_MMA(0, 0, At, B0); PG8_MMA(0, 1, At, B1); PG8_BAR; PG8_SCHED;
            PG8_LDA(At, 0, 1); PG8_STAGE(PG8_SB(0, 0), b2, voffB); PG8_STAGE(PG8_SB(0, 1), b2 + hstepB, voffB); PG8_STAGE(PG8_SA(0, 0), a2, voffA);
            PG8_WAIT_V(8); PG8_WAIT_L(0); PG8_BAR; PG8_MMA(1, 0, At, B0); PG8_MMA(1, 1, At, B1); PG8_BAR; PG8_SCHED;
            PG8_LDB(B0, 1, 0); PG8_LDB(B1, 1, 1); PG8_SCHED; PG8_LDA(At, 1, 0); PG8_STAGE(PG8_SA(0, 1), a2 + hstepA, voffA);
            PG8_WAIT_V(8); PG8_WAIT_L(0); PG8_BAR; PG8_MMA(0, 0, At, B0); PG8_MMA(0, 1, At, B1); PG8_BAR; PG8_SCHED;
            PG8_LDA(At, 1, 1); PG8_STAGE(PG8_SB(1, 0), b3, voffB); PG8_STAGE(PG8_SB(1, 1), b3 + hstepB, voffB); PG8_STAGE(PG8_SA(1, 0), a3, voffA);
            PG8_WAIT_V(8); PG8_WAIT_L(0); PG8_BAR; PG8_MMA(1, 0, At, B0); PG8_MMA(1, 1, At, B1); PG8_BAR; PG8_SCHED;
        }
        if constexpr (ALIGN_EPI) { if (wr == 0) PG8_BAR; }
        if constexpr (!Epi::AFTER_DRAIN) E(acc, cur, wr, wc, fr, fq);
        if (!has_next) break;
#pragma unroll
        for (int a = 0; a < 2; ++a)
#pragma unroll
            for (int b = 0; b < 2; ++b)
#pragma unroll
                for (int m = 0; m < 4; ++m)
#pragma unroll
                    for (int n = 0; n < 2; ++n) acc[a][b][m][n] = (f32x4){0.f, 0.f, 0.f, 0.f};
        cur = nxt; cA = nA; cB = nB; ++ui;
        if constexpr (ALIGN_EPI) { if (wr == 1) PG8_BAR; }
    }
    PG8_WAIT_V(0);
    if constexpr (!ALIGN_EPI) { if (wr == 0) PG8_BAR; }
    PG8_BAR;
    if constexpr (Epi::AFTER_DRAIN) E.fused(acc, cur, wr, wc, fr, fq);
#undef PG8_SA
#undef PG8_SB
#undef PG8_STAGE
#undef PG8_LDA
#undef PG8_LDB
#undef PG8_MMA
#undef PG8_WAIT_V
#undef PG8_WAIT_L
#undef PG8_BAR
#undef PG8_SCHED
}
}


struct EpiProj {
    static constexpr bool PERM = true, AFTER_DRAIN = false;
    bf16_t* P; float* ssq_q; float* ssq_kv; const float* ropec; const float* ropes; bf16_t* vts;
    __device__ __forceinline__ void operator()(const f32x4 (&acc)[2][2][4][2], const pg8::Unit& u, int wr, int wc, int fr, int fq) const {
        const int row0 = u.pm * 256 + wr * 64 + fr;
#pragma unroll
        for (int bj = 0; bj < 2; ++bj) {
            const int cgp = u.pn * 2 + bj;
            const int col = cgp * 128 + wc * 32 + 8 * fq;
            const bool is_q = cgp < 3, is_kv = (cgp == 3 || cgp == 4), is_kpe = (cgp == 5 && wc == 0);
            const bool is_swaq = (cgp == 5 && wc >= 1) || (cgp >= 6 && cgp <= 8) || (cgp == 9 && wc == 0);
            const bool is_swav = (cgp == 10 && wc >= 1) || (cgp == 11 && wc == 0);
#pragma unroll
            for (int ai = 0; ai < 2; ++ai)
#pragma unroll
                for (int m = 0; m < 4; ++m) {
                    const int row = row0 + ai * 128 + m * 16;
                    f32x4 v0 = acc[ai][bj][m][0], v1 = acc[ai][bj][m][1];
                    if (is_q || is_kv) {
                        float s = (v0[0] * v0[0] + v0[1] * v0[1]) + (v0[2] * v0[2] + v0[3] * v0[3]) + (v1[0] * v1[0] + v1[1] * v1[1]) + (v1[2] * v1[2] + v1[3] * v1[3]);
                        s += __shfl_xor(s, 16); s += __shfl_xor(s, 32);
                        if (fq == 0) unsafeAtomicAdd((is_q ? ssq_q : ssq_kv) + row, s);
                    }
                    if (is_kpe) {
                        f32x4 p0, p1;
#pragma unroll
                        for (int j = 0; j < 4; ++j) { p0[j] = __shfl_xor(v0[j], 32); p1[j] = __shfl_xor(v1[j], 32); }
                        const int pos = row & (SEQ - 1), i0 = (8 * fq) & 15;
                        const f32x4 c0 = *(const f32x4*)(ropec + pos * 16 + i0), c1 = *(const f32x4*)(ropec + pos * 16 + i0 + 4);
                        const f32x4 s0 = *(const f32x4*)(ropes + pos * 16 + i0), s1 = *(const f32x4*)(ropes + pos * 16 + i0 + 4);
                        const float sg = fq < 2 ? -1.f : 1.f;
                        v0 = v0 * c0 + p0 * s0 * sg; v1 = v1 * c1 + p1 * s1 * sg;
                    }
                    if (is_swaq) { v0 = v0 * QSC_SWA; v1 = v1 * QSC_SWA; }
                    u32x4 w; w.x = pk2(v0[0], v0[1]); w.y = pk2(v0[2], v0[3]); w.z = pk2(v1[0], v1[1]); w.w = pk2(v1[2], v1[3]);
                    *(u32x4*)(P + (size_t)row * NPROJ + col) = w;
                    if (is_swav) {
                        const int d = col - 1312, kvh = d >> 6, dd = d & 63, b = row >> 11, s = row & (SEQ - 1);
                        bf16_t* base = vts + ((size_t)((b * 2 + kvh) * 64 + dd)) * SEQ + s;
                        base[0 * SEQ] = (bf16_t)(w.x & 0xffffu); base[1 * SEQ] = (bf16_t)(w.x >> 16);
                        base[2 * SEQ] = (bf16_t)(w.y & 0xffffu); base[3 * SEQ] = (bf16_t)(w.y >> 16);
                        base[4 * SEQ] = (bf16_t)(w.z & 0xffffu); base[5 * SEQ] = (bf16_t)(w.z >> 16);
                        base[6 * SEQ] = (bf16_t)(w.w & 0xffffu); base[7 * SEQ] = (bf16_t)(w.w >> 16);
                    }
                }
        }
    }
};
struct EpiQ {
    static constexpr bool PERM = false, AFTER_DRAIN = false;
    bf16_t* Q; const float* ssq_q; const float* ropec; const float* ropes;
    __device__ __forceinline__ void operator()(const f32x4 (&acc)[2][2][4][2], const pg8::Unit& u, int wr, int wc, int fr, int fq) const {
        const int row0 = u.pm * 256 + wr * 64 + fr;
#pragma unroll
        for (int ai = 0; ai < 2; ++ai)
#pragma unroll
            for (int m = 0; m < 4; ++m) {
                const int row = row0 + ai * 128 + m * 16, pos = row & (SEQ - 1);
                const float rs = __builtin_amdgcn_rsqf(ssq_q[row] * (1.0f / QL) + EPS) * QSC_MLA;
#pragma unroll
                for (int bj = 0; bj < 2; ++bj) {
                    const int G = u.pn * 8 + bj * 4 + wc;
                    const bool isrope = (G % 3) == 2;
                    f32x4 x1 = acc[ai][bj][m][0] * rs, x2 = acc[ai][bj][m][1] * rs;
                    if (isrope) {
                        const f32x4 c = *(const f32x4*)(ropec + pos * 16 + 4 * fq), s = *(const f32x4*)(ropes + pos * 16 + 4 * fq);
                        const f32x4 o1 = x1 * c - x2 * s, o2 = x1 * s + x2 * c; x1 = o1; x2 = o2;
                    }
                    bf16_t* p = Q + (size_t)row * QW + G * 32 + 4 * fq;
                    u32x2 w1, w2; w1.x = pk2(x1[0], x1[1]); w1.y = pk2(x1[2], x1[3]); w2.x = pk2(x2[0], x2[1]); w2.y = pk2(x2[2], x2[3]);
                    *(u32x2*)p = w1; *(u32x2*)(p + 16) = w2;
                }
                asm volatile("" ::: "memory");
            }
    }
};
struct EpiKV {
    static constexpr bool PERM = false, AFTER_DRAIN = false;
    bf16_t* KN; bf16_t* VT; const float* ssq_kv;
    __device__ __forceinline__ void operator()(const f32x4 (&acc)[2][2][4][2], const pg8::Unit& u, int wr, int wc, int fr, int fq) const {
        const int row0 = u.pm * 256 + wr * 64 + fr;
#pragma unroll
        for (int ai = 0; ai < 2; ++ai)
#pragma unroll
            for (int m = 0; m < 4; ++m) {
                const int row = row0 + ai * 128 + m * 16, b = row >> 11, s = row & (SEQ - 1);
                const float rs = __builtin_amdgcn_rsqf(ssq_kv[row] * (1.0f / KVL) + EPS);
#pragma unroll
                for (int bj = 0; bj < 2; ++bj) {
                    const int head = u.pn * 2 + bj;
                    const f32x4 x1 = acc[ai][bj][m][0] * rs, x2 = acc[ai][bj][m][1] * rs;
                    const unsigned a0 = pk2(x1[0], x1[1]), a1 = pk2(x1[2], x1[3]), b0 = pk2(x2[0], x2[1]), b1 = pk2(x2[2], x2[3]);
                    if (wc < 2) {
                        bf16_t* p = KN + (size_t)row * 512 + head * 64 + wc * 32 + 4 * fq;
                        *(u32x2*)p = (u32x2){a0, a1}; *(u32x2*)(p + 16) = (u32x2){b0, b1};
                    } else {
                        bf16_t* base = VT + ((size_t)((b * 8 + head) * 64 + (wc - 2) * 32 + 4 * fq)) * SEQ + s;
                        base[0 * SEQ] = (bf16_t)(a0 & 0xffffu); base[1 * SEQ] = (bf16_t)(a0 >> 16); base[2 * SEQ] = (bf16_t)(a1 & 0xffffu); base[3 * SEQ] = (bf16_t)(a1 >> 16);
                        base[16 * SEQ] = (bf16_t)(b0 & 0xffffu); base[17 * SEQ] = (bf16_t)(b0 >> 16); base[18 * SEQ] = (bf16_t)(b1 & 0xffffu); base[19 * SEQ] = (bf16_t)(b1 >> 16);
                    }
                }
                asm volatile("" ::: "memory");
            }
    }
};
struct EpiRes {
    static constexpr bool PERM = false, AFTER_DRAIN = false;
    const float* base; float* out; const float* gate;
    __device__ __forceinline__ void operator()(const f32x4 (&acc)[2][2][4][2], const pg8::Unit& u, int wr, int wc, int fr, int fq) const {
        const int row0 = u.pm * 256 + wr * 64 + fr, b = u.pm >> 3;
#pragma unroll
        for (int bj = 0; bj < 2; ++bj)
#pragma unroll
            for (int n = 0; n < 2; ++n) {
                const int col = u.pn * 256 + bj * 128 + wc * 32 + n * 16 + 4 * fq;
                const f32x4 gv = *(const f32x4*)(gate + b * 6144 + col);
#pragma unroll
                for (int ai = 0; ai < 2; ++ai)
#pragma unroll
                    for (int m = 0; m < 4; ++m) {
                        const size_t off = (size_t)(row0 + ai * 128 + m * 16) * DM + col;
                        const f32x4 bs = *(const f32x4*)(base + off);
                        *(f32x4*)(out + off) = bs + gv * acc[ai][bj][m][n];
                    }
            }
    }
};
struct EpiUp {
    static constexpr bool PERM = true, AFTER_DRAIN = false;
    bf16_t* U;
    __device__ __forceinline__ void operator()(const f32x4 (&acc)[2][2][4][2], const pg8::Unit& u, int wr, int wc, int fr, int fq) const {
        const int row0 = u.pm * 256 + wr * 64 + fr, col0 = u.pn * 256 + wc * 32 + 8 * fq;
#pragma unroll
        for (int ai = 0; ai < 2; ++ai)
#pragma unroll
            for (int m = 0; m < 4; ++m) {
                bf16_t* rowp = U + (size_t)(row0 + ai * 128 + m * 16) * FF + col0;
#pragma unroll
                for (int bj = 0; bj < 2; ++bj) {
                    f32x4 v0 = acc[ai][bj][m][0], v1 = acc[ai][bj][m][1];
#pragma unroll
                    for (int j = 0; j < 4; ++j) { const float a = fmaxf(v0[j], 0.f), c = fmaxf(v1[j], 0.f); v0[j] = a * a; v1[j] = c * c; }
                    u32x4 w; w.x = pk2(v0[0], v0[1]); w.y = pk2(v0[2], v0[3]); w.z = pk2(v1[0], v1[1]); w.w = pk2(v1[2], v1[3]);
                    *(u32x4*)(rowp + bj * 128) = w;
                }
            }
    }
};


struct PanelX {
    float* ssq; unsigned* cnt;
    __device__ __forceinline__ void exchange(const f32x4 (&v)[2][2][4][2], const pg8::Unit& u, int wr, int fr, int fq) const {
        const int row0 = u.pm * 256 + wr * 64 + fr;
#pragma unroll
        for (int ai = 0; ai < 2; ++ai)
#pragma unroll
            for (int m = 0; m < 4; ++m) {
                float s = 0.f;
#pragma unroll
                for (int bj = 0; bj < 2; ++bj)
#pragma unroll
                    for (int n = 0; n < 2; ++n) { const f32x4 x = v[ai][bj][m][n]; s += (x[0] * x[0] + x[1] * x[1]) + (x[2] * x[2] + x[3] * x[3]); }
                s += __shfl_xor(s, 16); s += __shfl_xor(s, 32);
                if (fq == 0) unsafeAtomicAdd(ssq + row0 + ai * 128 + m * 16, s);
            }
        asm volatile("s_waitcnt vmcnt(0)" ::: "memory");
        __syncthreads();
        if (threadIdx.x == 0) {
            unsigned* c = cnt + 64 * u.pm;
            __builtin_amdgcn_fence(__ATOMIC_RELEASE, "agent");
            __hip_atomic_fetch_add(c, 1u, __ATOMIC_RELAXED, __HIP_MEMORY_SCOPE_AGENT);
            unsigned sp = 0;
            while (__hip_atomic_load(c, __ATOMIC_RELAXED, __HIP_MEMORY_SCOPE_AGENT) < 4u) { __builtin_amdgcn_s_sleep(1); if (++sp > (1u << 22)) break; }
            __builtin_amdgcn_fence(__ATOMIC_ACQUIRE, "agent");
        }
        __syncthreads();
    }
    __device__ __forceinline__ float rstd(int row) const { return __builtin_amdgcn_rsqf(__hip_atomic_load(ssq + row, __ATOMIC_RELAXED, __HIP_MEMORY_SCOPE_AGENT) * (1.0f / DM) + EPS); }
};
struct EpiResNorm {
    static constexpr bool PERM = false, AFTER_DRAIN = true;
    const float* base; float* out; bf16_t* H; const float* mod; const float* g; PanelX px;
    __device__ __forceinline__ void fused(f32x4 (&acc)[2][2][4][2], const pg8::Unit& u, int wr, int wc, int fr, int fq) const {
        const int row0 = u.pm * 256 + wr * 64 + fr, b = u.pm >> 3, col0 = u.pn * 256 + wc * 32 + 4 * fq;
        const float* mb = mod + b * 6144 + col0;
        {
            f32x4 gv[2][2];
#pragma unroll
            for (int bj = 0; bj < 2; ++bj)
#pragma unroll
                for (int n = 0; n < 2; ++n) gv[bj][n] = *(const f32x4*)(mb + 2 * 1024 + bj * 128 + n * 16);
#pragma unroll
            for (int ai = 0; ai < 2; ++ai)
#pragma unroll
                for (int m = 0; m < 4; ++m) {
                    const size_t off = (size_t)(row0 + ai * 128 + m * 16) * DM + col0;
                    const float* bp = base + off; float* op = out + off;
#pragma unroll
                    for (int bj = 0; bj < 2; ++bj)
#pragma unroll
                        for (int n = 0; n < 2; ++n) {
                            const f32x4 v = *(const f32x4*)(bp + bj * 128 + n * 16) + gv[bj][n] * acc[ai][bj][m][n];
                            acc[ai][bj][m][n] = v; *(f32x4*)(op + bj * 128 + n * 16) = v;
                        }
                    if (m & 1) asm volatile("" ::: "memory");
                }
        }
        px.exchange(acc, u, wr, fr, fq);
        int row0b = row0; asm volatile("" : "+v"(row0b));
        {
            f32x4 gs[2][2], sh[2][2];
#pragma unroll
            for (int bj = 0; bj < 2; ++bj)
#pragma unroll
                for (int n = 0; n < 2; ++n) {
                    gs[bj][n] = *(const f32x4*)(g + col0 + bj * 128 + n * 16) * (*(const f32x4*)(mb + 4 * 1024 + bj * 128 + n * 16) + 1.0f);
                    sh[bj][n] = *(const f32x4*)(mb + 3 * 1024 + bj * 128 + n * 16);
                }
#pragma unroll
            for (int ai = 0; ai < 2; ++ai)
#pragma unroll
                for (int m = 0; m < 4; ++m) {
                    const int row = row0b + ai * 128 + m * 16;
                    const float rs = px.rstd(row);
                    bf16_t* hp = H + (size_t)row * DM + col0;
#pragma unroll
                    for (int bj = 0; bj < 2; ++bj)
#pragma unroll
                        for (int n = 0; n < 2; ++n) {
                            const f32x4 y = acc[ai][bj][m][n] * rs * gs[bj][n] + sh[bj][n];
                            *(u32x2*)(hp + bj * 128 + n * 16) = (u32x2){pk2(y[0], y[1]), pk2(y[2], y[3])};
                        }
                    if (m & 1) asm volatile("" ::: "memory");
                }
        }
    }
};
struct EpiResFinal {
    static constexpr bool PERM = false, AFTER_DRAIN = true;
    float* out; const float* mod; const float* fg; PanelX px;
    __device__ __forceinline__ void fused(f32x4 (&acc)[2][2][4][2], const pg8::Unit& u, int wr, int wc, int fr, int fq) const {
        const int row0 = u.pm * 256 + wr * 64 + fr, b = u.pm >> 3, col0 = u.pn * 256 + wc * 32 + 4 * fq;
        const float* mb = mod + b * 6144 + col0;
        {
            f32x4 gv[2][2];
#pragma unroll
            for (int bj = 0; bj < 2; ++bj)
#pragma unroll
                for (int n = 0; n < 2; ++n) gv[bj][n] = *(const f32x4*)(mb + 5 * 1024 + bj * 128 + n * 16);
#pragma unroll
            for (int ai = 0; ai < 2; ++ai)
#pragma unroll
                for (int m = 0; m < 4; ++m) {
                    const float* bp = out + (size_t)(row0 + ai * 128 + m * 16) * DM + col0;
#pragma unroll
                    for (int bj = 0; bj < 2; ++bj)
#pragma unroll
                        for (int n = 0; n < 2; ++n) acc[ai][bj][m][n] = *(const f32x4*)(bp + bj * 128 + n * 16) + gv[bj][n] * acc[ai][bj][m][n];
                    asm volatile("" : "+v"(acc[ai][0][m][0]), "+v"(acc[ai][0][m][1]), "+v"(acc[ai][1][m][0]), "+v"(acc[ai][1][m][1]));
                    if (m & 1) asm volatile("" ::: "memory");
                }
        }
        px.exchange(acc, u, wr, fr, fq);
        int row0b = row0; asm volatile("" : "+v"(row0b));
        {
            f32x4 fgv[2][2];
#pragma unroll
            for (int bj = 0; bj < 2; ++bj)
#pragma unroll
                for (int n = 0; n < 2; ++n) fgv[bj][n] = *(const f32x4*)(fg + col0 + bj * 128 + n * 16);
#pragma unroll
            for (int ai = 0; ai < 2; ++ai)
#pragma unroll
                for (int m = 0; m < 4; ++m) {
                    const int row = row0b + ai * 128 + m * 16;
                    const float rs = px.rstd(row);
                    float* op = out + (size_t)row * DM + col0;
#pragma unroll
                    for (int bj = 0; bj < 2; ++bj)
#pragma unroll
                        for (int n = 0; n < 2; ++n) *(f32x4*)(op + bj * 128 + n * 16) = acc[ai][bj][m][n] * rs * fgv[bj][n];
                    if (m & 1) asm volatile("" ::: "memory");
                }
        }
    }
};

constexpr int KSTR = 208, VSTR = 136, VOFF = 64 * KSTR;
template <int QKD, int MODE>
__device__ __forceinline__ void attn_unit(LAS unsigned char* lds, const bf16_t* Q, int ldq, const bf16_t* K1, int ldk1, const bf16_t* K2, int ldk2,
                                          const bf16_t* VT, bf16_t* O, int qpos0, int t_lo, int t_hi, float slope2, float sink2, int tid, int wid, int lane) {
    const int r = lane & 31, hi = lane >> 5;
    const int q0 = qpos0 + 32 * wid;
    constexpr int NKB = QKD / 16;
    bf16x8 qf[NKB];
#pragma unroll
    for (int kb = 0; kb < NKB; ++kb) qf[kb] = *(const bf16x8*)(Q + (size_t)(32 * wid + r) * ldq + 16 * kb + 8 * hi);
    f32x16 o0, o1;
#pragma unroll
    for (int i = 0; i < 16; ++i) { o0[i] = 0.f; o1[i] = 0.f; }
    float mrun = (MODE == 1) ? sink2 : -1e30f;
    float lsum = (MODE == 1) ? (hi == 0 ? 1.f : 0.f) : 0.f;
    const int key1 = tid >> 3, ch1 = tid & 7, key2 = (tid >> 2) & 63, ch2 = tid & 3;
    u32x4 kr, k2r, vr;
    kr = *(const u32x4*)(K1 + (size_t)(64 * t_lo + key1) * ldk1 + ch1 * 8);
    if (QKD == 96) { if (tid < 256) k2r = *(const u32x4*)(K2 + (size_t)(64 * t_lo + key2) * ldk2 + ch2 * 8); }
    vr = *(const u32x4*)(VT + (size_t)key1 * SEQ + 64 * t_lo + ch1 * 8);
    for (int t = t_lo; t <= t_hi; ++t) {
        __syncthreads();
        *(LAS u32x4*)(lds + key1 * KSTR + ch1 * 16) = kr;
        if (QKD == 96) { if (tid < 256) *(LAS u32x4*)(lds + key2 * KSTR + 128 + ch2 * 16) = k2r; }
        *(LAS u32x2*)(lds + VOFF + key1 * VSTR + ch1 * 16) = (u32x2){vr.x, vr.y};
        *(LAS u32x2*)(lds + VOFF + key1 * VSTR + ch1 * 16 + 8) = (u32x2){vr.z, vr.w};
        __syncthreads();
        if (t < t_hi) {
            kr = *(const u32x4*)(K1 + (size_t)(64 * (t + 1) + key1) * ldk1 + ch1 * 8);
            if (QKD == 96) { if (tid < 256) k2r = *(const u32x4*)(K2 + (size_t)(64 * (t + 1) + key2) * ldk2 + ch2 * 8); }
            vr = *(const u32x4*)(VT + (size_t)key1 * SEQ + 64 * (t + 1) + ch1 * 8);
        }
        const int k0 = 64 * t;
        const bool active = (MODE == 0) ? (k0 <= q0 + 31) : ((k0 + 63 >= q0 - 127) && (k0 <= q0 + 31));
        if (active) {
            f32x16 s[2];
#pragma unroll
            for (int sub = 0; sub < 2; ++sub) {
#pragma unroll
                for (int i = 0; i < 16; ++i) s[sub][i] = 0.f;
#pragma unroll
                for (int kb = 0; kb < NKB; ++kb) {
                    const bf16x8 kf = *(const LAS bf16x8*)(lds + (32 * sub + r) * KSTR + (16 * kb + 8 * hi) * 2);
                    s[sub] = __builtin_amdgcn_mfma_f32_32x32x16_bf16(kf, qf[kb], s[sub], 0, 0, 0);
                }
            }
            const int qp = q0 + r;
            if (MODE == 0) {
                if (k0 + 63 > q0) {
#pragma unroll
                    for (int sub = 0; sub < 2; ++sub)
#pragma unroll
                        for (int i = 0; i < 16; ++i) { const int key = k0 + 32 * sub + (i & 3) + 8 * (i >> 2) + 4 * hi; if (key > qp) s[sub][i] = -INFINITY; }
                }
            } else {
#pragma unroll
                for (int sub = 0; sub < 2; ++sub)
#pragma unroll
                    for (int i = 0; i < 16; ++i) { const int key = k0 + 32 * sub + (i & 3) + 8 * (i >> 2) + 4 * hi; const int dist = qp - key;
                        s[sub][i] = (dist < 0 || dist >= 128) ? -INFINITY : (s[sub][i] - slope2 * (float)dist); }
            }
            float mx = -INFINITY;
#pragma unroll
            for (int sub = 0; sub < 2; ++sub)
#pragma unroll
                for (int i = 0; i < 16; ++i) mx = fmaxf(mx, s[sub][i]);
            mx = fmaxf(mx, __shfl_xor(mx, 32));
            const float mn = fmaxf(mrun, mx);
            const float alpha = __builtin_amdgcn_exp2f(mrun - mn);
            mrun = mn;
            float psum = 0.f;
#pragma unroll
            for (int sub = 0; sub < 2; ++sub)
#pragma unroll
                for (int i = 0; i < 16; ++i) { const float p = __builtin_amdgcn_exp2f(s[sub][i] - mn); s[sub][i] = p; psum += p; }
            lsum = lsum * alpha + psum;
            o0 = o0 * alpha; o1 = o1 * alpha;
#pragma unroll
            for (int sub = 0; sub < 2; ++sub)
#pragma unroll
                for (int jb = 0; jb < 2; ++jb) {
                    u32x4 pw;
                    pw.x = pk2(s[sub][8 * jb + 0], s[sub][8 * jb + 1]); pw.y = pk2(s[sub][8 * jb + 2], s[sub][8 * jb + 3]);
                    pw.z = pk2(s[sub][8 * jb + 4], s[sub][8 * jb + 5]); pw.w = pk2(s[sub][8 * jb + 6], s[sub][8 * jb + 7]);
                    const bf16x8 pf = __builtin_bit_cast(bf16x8, pw);
                    const LAS unsigned char* vp = lds + VOFF + r * VSTR + (32 * sub + 16 * jb + 4 * hi) * 2;
                    {
                        const u32x2 a = *(const LAS u32x2*)vp, b = *(const LAS u32x2*)(vp + 16);
                        const bf16x8 vf = __builtin_bit_cast(bf16x8, (u32x4){a.x, a.y, b.x, b.y});
                        o0 = __builtin_amdgcn_mfma_f32_32x32x16_bf16(vf, pf, o0, 0, 0, 0);
                    }
                    {
                        const u32x2 a = *(const LAS u32x2*)(vp + 32 * VSTR), b = *(const LAS u32x2*)(vp + 32 * VSTR + 16);
                        const bf16x8 vf = __builtin_bit_cast(bf16x8, (u32x4){a.x, a.y, b.x, b.y});
                        o1 = __builtin_amdgcn_mfma_f32_32x32x16_bf16(vf, pf, o1, 0, 0, 0);
                    }
                }
        }
    }
    const float ltot = lsum + __shfl_xor(lsum, 32);
    const float inv = 1.0f / ltot;
    bf16_t* op = O + (size_t)(32 * wid + r) * DM + 4 * hi;
#pragma unroll
    for (int g = 0; g < 4; ++g) {
        *(u32x2*)(op + 8 * g) = (u32x2){pk2(o0[4 * g] * inv, o0[4 * g + 1] * inv), pk2(o0[4 * g + 2] * inv, o0[4 * g + 3] * inv)};
        *(u32x2*)(op + 32 + 8 * g) = (u32x2){pk2(o1[4 * g] * inv, o1[4 * g + 1] * inv), pk2(o1[4 * g + 2] * inv, o1[4 * g + 3] * inv)};
    }
}

__device__ __forceinline__ void p0_transpose_item(const float* W, int K, int N, bf16_t* WT, const float* kscale, LAS float* scr, int item, int lane) {
    const int nblk = N / 32, kb = item / nblk, nb = item % nblk, k0 = 64 * kb, n0 = 32 * nb;
#pragma unroll 8
    for (int i = 0; i < 32; ++i) { const int kk = 2 * i + (lane >> 5); float v = W[(size_t)(k0 + kk) * N + n0 + (lane & 31)]; if (kscale) v *= kscale[k0 + kk]; scr[kk * 33 + (lane & 31)] = v; }
    asm volatile("s_waitcnt lgkmcnt(0)" ::: "memory");
    const int c = lane & 7;
#pragma unroll
    for (int j = 0; j < 4; ++j) { const int n = (lane >> 3) + 8 * j; const LAS float* s = scr + (8 * c) * 33 + n;
        u32x4 o; o.x = pk2(s[0 * 33], s[1 * 33]); o.y = pk2(s[2 * 33], s[3 * 33]); o.z = pk2(s[4 * 33], s[5 * 33]); o.w = pk2(s[6 * 33], s[7 * 33]);
        *(u32x4*)(WT + (size_t)(n0 + n) * K + k0 + 8 * c) = o; }
    asm volatile("s_waitcnt lgkmcnt(0)" ::: "memory");
}
__device__ __forceinline__ void p0_mod_item(const float* c, const float* w_ada, const float* b_ada, float* mod, LAS float* scr, int item, int lane) {
    const int kc = item / 24, nb = item % 24, k0 = 64 * kc, n0 = 256 * nb + 4 * lane;
#pragma unroll
    for (int b = 0; b < 8; ++b) { const float x = c[b * DM + k0 + lane]; scr[b * 64 + lane] = x / (1.0f + __expf(-x)); }
    asm volatile("s_waitcnt lgkmcnt(0)" ::: "memory");
    f32x4 acc[8];
#pragma unroll
    for (int b = 0; b < 8; ++b) acc[b] = (f32x4){0.f, 0.f, 0.f, 0.f};
#pragma unroll 4
    for (int kk = 0; kk < 64; ++kk) {
        const f32x4 w = *(const f32x4*)(w_ada + (size_t)(k0 + kk) * 6144 + n0);
#pragma unroll
        for (int b = 0; b < 8; ++b) acc[b] += w * scr[b * 64 + kk];
    }
    f32x4 bias = (f32x4){0.f, 0.f, 0.f, 0.f};
    if (kc == 0) bias = *(const f32x4*)(b_ada + n0);
#pragma unroll
    for (int b = 0; b < 8; ++b)
#pragma unroll
        for (int j = 0; j < 4; ++j) unsafeAtomicAdd(mod + b * 6144 + n0 + j, acc[b][j] + bias[j]);
    asm volatile("s_waitcnt lgkmcnt(0)" ::: "memory");
}
__device__ __forceinline__ void row_norm_mod(const float* xrow, bf16_t* orow, const float* g, const float* sc, const float* sh, int lane) {
    const f32x4* xr = (const f32x4*)xrow + lane;
    f32x4 v[4]; float s = 0.f;
#pragma unroll
    for (int j = 0; j < 4; ++j) { v[j] = xr[64 * j]; s += (v[j][0] * v[j][0] + v[j][1] * v[j][1]) + (v[j][2] * v[j][2] + v[j][3] * v[j][3]); }
    const float rstd = 1.0f / sqrtf(wave_sum(s) * (1.0f / DM) + EPS);
    u32x2* o8 = (u32x2*)orow + lane;
#pragma unroll
    for (int j = 0; j < 4; ++j) {
        const f32x4 gg = ((const f32x4*)g)[64 * j + lane], ss = ((const f32x4*)sc)[64 * j + lane], hh = ((const f32x4*)sh)[64 * j + lane];
        const f32x4 y = v[j] * rstd * gg * (ss + 1.0f) + hh;
        o8[64 * j] = (u32x2){pk2(y[0], y[1]), pk2(y[2], y[3])};
    }
}
__device__ __forceinline__ void row_norm_final(const float* xrow, float* orow, const float* g, int lane) {
    const f32x4* xr = (const f32x4*)xrow + lane;
    f32x4 v[4]; float s = 0.f;
#pragma unroll
    for (int j = 0; j < 4; ++j) { v[j] = xr[64 * j]; s += (v[j][0] * v[j][0] + v[j][1] * v[j][1]) + (v[j][2] * v[j][2] + v[j][3] * v[j][3]); }
    const float rstd = 1.0f / sqrtf(wave_sum(s) * (1.0f / DM) + EPS);
    f32x4* o = (f32x4*)orow + lane;
#pragma unroll
    for (int j = 0; j < 4; ++j) o[64 * j] = v[j] * rstd * ((const f32x4*)g)[64 * j + lane];
}


#define XB_TMO      128
#define XB_XCNT(j)  (256  + 64 * (j))
#define XB_XSUB(j)  (1280 + 64 * (j))
#define XB_XGEN(j)  (2304 + 64 * (j))
#define XB_TOP      3328
#define XB_TOPGEN   3392
#define XCD_BAR_WORDS 3456
#define XB_SPIN_CAP (1u << 18)
__device__ __forceinline__ unsigned xb_ld(unsigned* p)              { return __hip_atomic_load(p, __ATOMIC_RELAXED, __HIP_MEMORY_SCOPE_AGENT); }
__device__ __forceinline__ unsigned xb_add(unsigned* p, unsigned v) { return __hip_atomic_fetch_add(p, v, __ATOMIC_RELAXED, __HIP_MEMORY_SCOPE_AGENT); }
__device__ __forceinline__ unsigned xb_xcc_id() { return (unsigned)__builtin_amdgcn_s_getreg((3 << 11) | 20) & 0xFu; }
#define XB_SPIN(cond, bar) do { unsigned _sp = 0; while (cond) { __builtin_amdgcn_s_sleep(1); \
    if ((++_sp & 255u) == 0u) { if (xb_ld(&(bar)[XB_TMO])) break; if (_sp > XB_SPIN_CAP) { atomicAdd(&(bar)[XB_TMO], 1u); break; } } } } while (0)
struct XcdBarrier { unsigned* bar; unsigned x; volatile LAS unsigned* st; };
__device__ __forceinline__ XcdBarrier xcd_barrier_post(unsigned* bar, volatile LAS unsigned* st) {
    XcdBarrier b; b.bar = bar; b.x = xb_xcc_id(); b.st = st;
    if (threadIdx.x == 0) (void)xb_add(&bar[XB_XCNT(b.x)], 1u);
    return b;
}
__device__ __forceinline__ void xcd_barrier_complete(unsigned* bar, unsigned x, unsigned& nloc, unsigned& nx) {
    const unsigned G = gridDim.x * gridDim.y * gridDim.z;
    unsigned sum, cnt, mine, sp = 0u;
    for (;;) {
        sum = 0u; cnt = 0u; mine = 0u;
#pragma unroll
        for (unsigned j = 0; j < 16; ++j) { const unsigned c = xb_ld(&bar[XB_XCNT(j)]); sum += c; cnt += (c > 0u) ? 1u : 0u; mine = (j == x) ? c : mine; }
        if (sum == G) break;
        __builtin_amdgcn_s_sleep(1);
        if ((++sp & 255u) == 0u) { if (xb_ld(&bar[XB_TMO])) break; if (sp > XB_SPIN_CAP) { atomicAdd(&bar[XB_TMO], 1u); break; } }
    }
    nloc = mine > 0u ? mine : 1u; nx = cnt > 0u ? cnt : 1u;
}
__device__ __forceinline__ void xcd_barrier(const XcdBarrier& b) {
    asm volatile("s_waitcnt vmcnt(0)" ::: "memory");
    __syncthreads();
    if (threadIdx.x == 0) {
        unsigned* bar = b.bar;
        __builtin_amdgcn_s_waitcnt(0);
        unsigned nloc = b.st[0], nx = b.st[1];
        if (nloc == 0u) { xcd_barrier_complete(bar, b.x, nloc, nx); b.st[0] = nloc; b.st[1] = nx; }
        const unsigned old = xb_add(&bar[XB_XSUB(b.x)], 1u);
        const unsigned gen = old / nloc;
        if (old + 1u == (gen + 1u) * nloc) {
            __builtin_amdgcn_fence(__ATOMIC_RELEASE, "agent");
            asm volatile("s_waitcnt vmcnt(0)" ::: "memory");
            const unsigned og = xb_add(&bar[XB_TOP], 1u);
            const unsigned tg = og / nx;
            if (og + 1u == (tg + 1u) * nx) xb_add(&bar[XB_TOPGEN], 1u);
            else XB_SPIN(xb_ld(&bar[XB_TOPGEN]) == tg, bar);
            __builtin_amdgcn_fence(__ATOMIC_ACQUIRE, "agent");
            xb_add(&bar[XB_XGEN(b.x)], 1u);
            asm volatile("s_waitcnt vmcnt(0)" ::: "memory");
        } else {
            XB_SPIN(xb_ld(&bar[XB_XGEN(b.x)]) == gen, bar);
            __builtin_amdgcn_fence(__ATOMIC_ACQUIRE, "agent");
            asm volatile("s_waitcnt vmcnt(0)" ::: "memory");
        }
    }
    __syncthreads();
}

struct Args { const float* in[16]; float* out; unsigned char* ws; int ph_lo, ph_hi, pad0, pad1; };
constexpr int NPHASE = 10;

__global__ void __launch_bounds__(512, 2) fwd_megakernel(Args args) {
    extern __shared__ __attribute__((aligned(16))) unsigned char lds_raw[];
    LAS unsigned char* lds = (LAS unsigned char*)lds_raw;
    cg::grid_group grid = cg::this_grid();
    const int tid = threadIdx.x, lane = tid & 63, wave = __builtin_amdgcn_readfirstlane(tid >> 6);
    const int G = gridDim.x, bx = blockIdx.x;
    const int vcu = (G % 8 == 0) ? (bx % 8) * (G / 8) + bx / 8 : bx;
    const int gw = vcu * 8 + wave, NGW = G * 8;
    unsigned char* ws = args.ws;
    const float* x = args.in[0]; const float* cvec = args.in[1]; const float* w_ada = args.in[2]; const float* b_ada = args.in[3];
    const float* norm_mix_g = args.in[4]; const float* w_in = args.in[5]; const float* g_qa = args.in[6]; const float* w_qb = args.in[7];
    const float* g_kva = args.in[8]; const float* w_kvb = args.in[9]; const float* sinks = args.in[10]; const float* w_o = args.in[11];
    const float* norm_mlp_g = args.in[12]; const float* w_up = args.in[13]; const float* w_down = args.in[14]; const float* final_g = args.in[15];
    float* out = args.out;
    float* mod = (float*)(ws + WS_MOD); float* ssq_q = (float*)(ws + WS_SSQQ); float* ssq_kv = (float*)(ws + WS_SSQKV);
    float* ropec = (float*)(ws + WS_ROPE); float* ropes = ropec + SEQ * 16;
    bf16_t* win_t = (bf16_t*)(ws + WS_WIN); bf16_t* wqb_t = (bf16_t*)(ws + WS_WQB); bf16_t* wkvb_t = (bf16_t*)(ws + WS_WKVB);
    bf16_t* wo_t = (bf16_t*)(ws + WS_WO); bf16_t* wup_t = (bf16_t*)(ws + WS_WUP); bf16_t* wdn_t = (bf16_t*)(ws + WS_WDN);
    bf16_t* hbuf = (bf16_t*)(ws + WS_H); bf16_t* proj = (bf16_t*)(ws + WS_PROJ); bf16_t* qbuf = (bf16_t*)(ws + WS_Q); bf16_t* knope = (bf16_t*)(ws + WS_KN);
    bf16_t* vtm = (bf16_t*)(ws + WS_VTM); bf16_t* vts = (bf16_t*)(ws + WS_VTS); bf16_t* mix = (bf16_t*)(ws + WS_MIX); bf16_t* ubuf = (bf16_t*)(ws + WS_U);

    const int lo = args.ph_lo, hi = args.ph_hi;
    volatile LAS unsigned* bst = (volatile LAS unsigned*)(lds + 131072);
    if (tid < 2) bst[tid] = 0u;
    __syncthreads();
    XcdBarrier xbar; xbar.bar = (unsigned*)(ws + WS_BAR); xbar.x = 0; xbar.st = bst;
    if (hi - lo > 1) xbar = xcd_barrier_post((unsigned*)(ws + WS_BAR), bst);
    if (lo < 0) grid.sync();
#ifndef PH_MASK
#define PH_MASK 0x3ff
#endif
#define IN(k) (((PH_MASK >> (k)) & 1) && lo <= (k) && (k) < hi)
#define GSYNC() xcd_barrier(xbar)
#define SEAM2(k, k2) do { if (IN(k) && IN(k2)) GSYNC(); } while (0)
#define SEAM(k) SEAM2(k, (k) + 1)
#ifndef REPMASK
#define REPMASK 0
#endif
#ifndef REPN
#define REPN 3
#endif
#ifndef XSYNC
#define XSYNC 0
#endif
#define REP(k) for (int rep_ = 0; rep_ < (((REPMASK >> (k)) & 1) ? REPN : 1); ++rep_)

    if (IN(0)) {
        LAS float* scr = (LAS float*)(lds + wave * 16384);
        constexpr int I_MOD = 16 * 24, I_IN = 16 * 45, I_QB = 6 * 24, I_KVB = 4 * 32, I_O = 16 * 32, I_UP = 16 * 128, I_DN = 64 * 32;
        constexpr int NITEMS = I_MOD + I_IN + I_QB + I_KVB + I_O + I_UP + I_DN;
        for (int it = gw; it < NITEMS; it += NGW) {
            int r = it;
            if (r < I_MOD) { p0_mod_item(cvec, w_ada, b_ada, mod, scr, r, lane); continue; } r -= I_MOD;
            if (r < I_IN) { p0_transpose_item(w_in, DM, IN_COLS, win_t, nullptr, scr, r, lane); continue; } r -= I_IN;
            if (r < I_QB) { p0_transpose_item(w_qb, QL, QW, wqb_t, g_qa, scr, r, lane); continue; } r -= I_QB;
            if (r < I_KVB) { p0_transpose_item(w_kvb, KVL, KVW, wkvb_t, g_kva, scr, r, lane); continue; } r -= I_KVB;
            if (r < I_O) { p0_transpose_item(w_o, DM, DM, wo_t, nullptr, scr, r, lane); continue; } r -= I_O;
            if (r < I_UP) { p0_transpose_item(w_up, DM, FF, wup_t, nullptr, scr, r, lane); continue; } r -= I_UP;
            p0_transpose_item(w_down, FF, DM, wdn_t, nullptr, scr, r, lane);
        }
        const int gt = vcu * 512 + tid, NGT = G * 512;
        for (int i = gt; i < (NPROJ - IN_COLS) * DM / 8; i += NGT) ((u32x4*)(win_t + (size_t)IN_COLS * DM))[i] = (u32x4){0u, 0u, 0u, 0u};
        for (int i = gt; i < SEQ * 16; i += NGT) {
            const int pos = i >> 4, fi = i & 15;
            double f = (fi & 3) == 0 ? 1.0 : ((fi & 3) == 1 ? 0.5623413251903491 : ((fi & 3) == 2 ? 0.31622776601683794 : 0.1778279410038923));
            const int dec = fi >> 2; f *= (dec == 0 ? 1.0 : (dec == 1 ? 0.1 : (dec == 2 ? 0.01 : 0.001)));
            const float ang32 = (float)pos * (float)f;
            const double rev = (double)ang32 * 0.15915494309189535;
            const float fr = (float)(rev - __builtin_rint(rev));
            ropec[i] = __builtin_amdgcn_cosf(fr); ropes[i] = __builtin_amdgcn_sinf(fr);
        }
    }
    SEAM(0);
    for (int xs_ = 0; xs_ < XSYNC; ++xs_) GSYNC();
    REP(1) { if (rep_) GSYNC();
    if (IN(1)) {
        for (int m = gw; m < MT; m += NGW) { const int b = m >> 11;
            row_norm_mod(x + (size_t)m * DM, hbuf + (size_t)m * DM, norm_mix_g, mod + b * 6144 + 1024, mod + b * 6144, lane); }
    }
    }
    SEAM(1);
    if (IN(2)) {
        pg8::Gemm g{hbuf, win_t, MT, NPROJ, DM, DM}; pg8::StaticOrder S; S.init(MT, NPROJ, G, bx);
        EpiProj E{proj, ssq_q, ssq_kv, ropec, ropes, vts};
        pg8::gemm_phase<EpiProj, true>(lds, g, S, E);
    }
    SEAM(2);
    REP(3) { if (rep_) GSYNC();
    if (IN(3)) {
        { pg8::Gemm g{proj, wqb_t, MT, QW, QL, NPROJ}; pg8::StaticOrder S; S.init(MT, QW, G, bx);
          EpiQ E{qbuf, ssq_q, ropec, ropes}; pg8::gemm_phase<EpiQ, true>(lds, g, S, E); }
        { pg8::Gemm g{proj + QL, wkvb_t, MT, KVW, KVL, NPROJ}; pg8::StaticOrder S; S.init(MT, KVW, G, (bx + 64) % G);
          EpiKV E{knope, vtm, ssq_kv}; pg8::gemm_phase<EpiKV, true>(lds, g, S, E); }
    }
    }
    SEAM(3);
    REP(4) { if (rep_) GSYNC();
    if (IN(4)) {
        for (int it = vcu; it < 768; it += G) {
            if (it < 256) {
                const int b = it >> 5, h = (it >> 2) & 7, pp = it & 3;
#pragma unroll 1
                for (int k = 0; k < 2; ++k) {
                    const int qb = k == 0 ? 7 - pp : pp;
                    const size_t row0 = (size_t)b * SEQ + qb * 256;
                    attn_unit<96, 0>(lds, qbuf + row0 * QW + h * 96, QW, knope + (size_t)b * SEQ * 512 + h * 64, 512, proj + (size_t)b * SEQ * NPROJ + 640, NPROJ,
                                     vtm + (size_t)(b * 8 + h) * 64 * SEQ, mix + row0 * DM + h * 64, qb * 256, 0, 4 * qb + 3, 0.f, 0.f, tid, wave, lane);
                }
            } else {
                const int id = it - 256, b = id >> 6, hq = (id >> 3) & 7, qb = id & 7, kvh = hq >> 2;
                const size_t row0 = (size_t)b * SEQ + qb * 256;
                const float slope2 = exp2f(-(float)(hq + 1)) * LOG2E, sink2 = sinks[hq] * LOG2E;
                attn_unit<64, 1>(lds, proj + row0 * NPROJ + 672 + hq * 64, NPROJ, proj + (size_t)b * SEQ * NPROJ + 1184 + kvh * 64, NPROJ, nullptr, 0,
                                 vts + (size_t)(b * 2 + kvh) * 64 * SEQ, mix + row0 * DM + 512 + hq * 64, qb * 256, qb == 0 ? 0 : 4 * qb - 2, 4 * qb + 3, slope2, sink2, tid, wave, lane);
            }
        }
        __syncthreads();
    }
    }
    SEAM(4);
    if (IN(5)) {
        pg8::Gemm g{mix, wo_t, MT, DM, DM, DM}; pg8::StaticOrder S; S.init(MT, DM, G, bx);
        EpiResNorm E{x, out, hbuf, mod, norm_mlp_g, PanelX{(float*)(ws + WS_SSQX1), (unsigned*)(ws + WS_CNT)}};
        pg8::gemm_phase<EpiResNorm, false>(lds, g, S, E);
    }
    SEAM2(5, 7);
    REP(7) { if (rep_) GSYNC();
    if (IN(7)) {
        pg8::Gemm g{hbuf, wup_t, MT, FF, DM, DM}; pg8::StaticOrder S; S.init(MT, FF, G, bx);
        EpiUp E{ubuf};
        pg8::gemm_phase<EpiUp, true>(lds, g, S, E);
    }
    }
    SEAM(7);
    if (IN(8)) {
        pg8::Gemm g{ubuf, wdn_t, MT, DM, FF, FF}; pg8::StaticOrder S; S.init(MT, DM, G, bx);
        EpiResFinal E{out, mod, final_g, PanelX{(float*)(ws + WS_SSQX2), (unsigned*)(ws + WS_CNT) + 64 * 64}};
        pg8::gemm_phase<EpiResFinal, false>(lds, g, S, E);
    }
#undef IN
#undef SEAM
}

extern "C" void kernel_launch(void* const* d_in, const int* in_sizes, int n_in, void* d_out, int out_size, void* d_ws, size_t ws_size, hipStream_t stream) {
    static int grid = 0;
    if (grid == 0) {
        if (n_in != 16 || out_size != MT * DM || ws_size < WS_END) { fprintf(stderr, "kernel_launch: unexpected shapes (n_in %d out %d ws %zu)\n", n_in, out_size, ws_size); grid = -1; return; }
        int dev = 0, cus = 0, per_cu = 0;
        hipGetDevice(&dev);
        hipDeviceGetAttribute(&cus, hipDeviceAttributeMultiprocessorCount, dev);
        if (hipFuncSetAttribute((const void*)fwd_megakernel, hipFuncAttributeMaxDynamicSharedMemorySize, LDS_BYTES) != hipSuccess) { fprintf(stderr, "kernel_launch: hipFuncSetAttribute failed\n"); }
        if (hipOccupancyMaxActiveBlocksPerMultiprocessor(&per_cu, (const void*)fwd_megakernel, 512, LDS_BYTES) != hipSuccess || per_cu < 1) { fprintf(stderr, "kernel_launch: occupancy query says %d\n", per_cu); per_cu = 1; }
        (void)hipGetLastError();
        grid = cus * per_cu;
        if (grid != 256) { fprintf(stderr, "kernel_launch: this kernel needs exactly 256 co-resident workgroups (one per CU), got %d\n", grid); grid = -1; return; }
    }
    if (grid < 0) return;
    hipMemsetAsync((char*)d_ws, 0, WS_ZERO_BYTES, stream);
    Args a{};
    for (int i = 0; i < 16; ++i) a.in[i] = (const float*)d_in[i];
    a.out = (float*)d_out; a.ws = (unsigned char*)d_ws;
#if MK_PER_PHASE
    for (int p = 0; p < NPHASE; ++p) {
        a.ph_lo = p; a.ph_hi = p + 1;
        hipLaunchKernelGGL(fwd_megakernel, dim3(grid), dim3(512), LDS_BYTES, stream, a);
    }
#else
    a.ph_lo = 0; a.ph_hi = NPHASE;
    void* kargs[] = {&a};
    hipError_t e = hipLaunchCooperativeKernel((const void*)fwd_megakernel, dim3(grid), dim3(512), kargs, LDS_BYTES, stream);
    if (e != hipSuccess) fprintf(stderr, "cooperative launch failed: %s (grid %d)\n", hipGetErrorString(e), grid);
#endif
}
```

```cpp
#include <hip/hip_runtime.h>
#include <hip/hip_cooperative_groups.h>
#include <cstdio>
#include <cstdint>
namespace cg = cooperative_groups;

#define LAS __attribute__((address_space(3)))
typedef unsigned short bf16_t;
typedef short bf16x8 __attribute__((ext_vector_type(8)));
typedef short s16x4 __attribute__((ext_vector_type(4)));
typedef float f32x4 __attribute__((ext_vector_type(4)));
typedef float f32x2 __attribute__((ext_vector_type(2)));
typedef float f32x16 __attribute__((ext_vector_type(16)));
typedef unsigned u32x4 __attribute__((ext_vector_type(4)));
typedef unsigned u32x2 __attribute__((ext_vector_type(2)));
typedef __bf16 bf2_t __attribute__((ext_vector_type(2)));

#ifndef MK_PER_PHASE
#define MK_PER_PHASE 0
#endif

constexpr int NB = 8, SEQ = 2048, DM = 1024, MT = NB * SEQ, FF = 4096;
constexpr int NPROJ = 1536, IN_COLS = 1440;
constexpr int QL = 384, KVL = 256;
constexpr int QW = 768, KVW = 1024;
constexpr float EPS = 1e-6f;
constexpr float LOG2E = 1.4426950408889634f;
constexpr float QSC_MLA = 0.10206207261596575f * LOG2E;
constexpr float QSC_SWA = 0.125f * LOG2E;

constexpr size_t MiB = 1u << 20;
constexpr size_t WS_MOD = 0, WS_SSQQ = 256 * 1024, WS_SSQKV = 320 * 1024, WS_BAR = 384 * 1024, WS_SSQX1 = 400 * 1024, WS_SSQX2 = 464 * 1024, WS_CNT = 528 * 1024, WS_ZERO_BYTES = 624 * 1024;
constexpr size_t WS_ROPE = 1 * MiB;
constexpr size_t WS_WIN = 2 * MiB, WS_WQB = 5 * MiB, WS_WKVB = 6 * MiB, WS_WO = 7 * MiB, WS_WUP = 9 * MiB, WS_WDN = 17 * MiB;
constexpr size_t WS_H = 25 * MiB, WS_PROJ = 57 * MiB, WS_Q = 105 * MiB, WS_KN = 129 * MiB, WS_VTM = 145 * MiB, WS_VTS = 161 * MiB, WS_MIX = 185 * MiB;
constexpr size_t WS_U = 57 * MiB;
constexpr size_t WS_X1 = 217 * MiB;
constexpr size_t WS_END = 249 * MiB;
constexpr int LDS_BYTES = 131072 + 256;

__device__ __forceinline__ unsigned pk2(float lo, float hi) { f32x2 v = {lo, hi}; bf2_t r = __builtin_convertvector(v, bf2_t); return __builtin_bit_cast(unsigned, r); }
__device__ __forceinline__ bf16_t f2bf(float f) { return (bf16_t)(pk2(f, 0.f) & 0xffffu); }
__device__ __forceinline__ void st16_wt(void* p, u32x4 v) { asm volatile("global_store_dwordx4 %0, %1, off sc1\n\ts_nop 1" :: "v"(p), "v"(v) : "memory"); }
__device__ __forceinline__ void team_wait(unsigned* cnt) {
    asm volatile("s_waitcnt vmcnt(0)" ::: "memory");
    __syncthreads();
    if (threadIdx.x == 0) {
        __hip_atomic_fetch_add(cnt, 1u, __ATOMIC_RELAXED, __HIP_MEMORY_SCOPE_AGENT);
        unsigned sp = 0;
        while (__hip_atomic_load(cnt, __ATOMIC_RELAXED, __HIP_MEMORY_SCOPE_AGENT) < 4u) { __builtin_amdgcn_s_sleep(1); if (++sp > (1u << 22)) break; }
        __builtin_amdgcn_fence(__ATOMIC_ACQUIRE, "agent");
        asm volatile("s_waitcnt vmcnt(0)" ::: "memory");
    }
    __syncthreads();
}
__device__ __forceinline__ float wave_sum(float v) {
#pragma unroll
    for (int o = 1; o < 64; o <<= 1) v += __shfl_xor(v, o);
    return v;
}

namespace pg8 {
constexpr int BM = 256, BK = 64, HALF = 128, HTB = HALF * BK * 2, STAGE_BYTES = 8 * HTB, NXCD = 8, WGM = 8;
__host__ __device__ __forceinline__ int lds_byte(int r, int c) { const int st = (r >> 4) * 2 + (c >> 5), rr = r & 15, cc = c & 31, ob = rr * 64 + cc * 2; return st * 1024 + (ob ^ (((ob >> 9) & 1) << 5)); }
__host__ __device__ __forceinline__ void stage_rc(int b, int& R, int& C) { const int st = b / 1024, sb = b % 1024, swz = sb ^ (((sb >> 9) & 1) << 5); R = (st >> 1) * 16 + swz / 64; C = (st & 1) * 32 + (swz % 64) / 2; }
__host__ __device__ __forceinline__ int perm32(int rho) { const int n = rho >> 4, i = rho & 15; return 8 * (i >> 2) + 4 * n + (i & 3); }

struct Unit { int pm, pn; };
struct Gemm { const bf16_t* A; const bf16_t* Bt; int M, N, K, lda; };

struct StaticOrder {
    int nM, nN, nwg, G, c;
    __device__ void init(int M, int N, int G_, int c_) { nM = M / BM; nN = N / BM; nwg = nM * nN; G = G_; c = c_; }
    __device__ bool next(int i, Unit& u) const {
        const long L = (long)i * G + c; if (L >= nwg) return false;
        int wgid = (int)L; { const int q = nwg / NXCD, r = nwg % NXCD, xcd = wgid % NXCD, off = wgid / NXCD; wgid = (xcd < r ? xcd * (q + 1) : r * (q + 1) + (xcd - r) * q) + off; }
        const int nig = WGM * nN, gid = wgid / nig, fm = gid * WGM, gsz = (nM - fm) < WGM ? (nM - fm) : WGM;
        u.pm = fm + ((wgid % nig) % gsz); u.pn = (wgid % nig) / gsz; return true;
    }
};

struct ListOrder {
    int pm, n, p0, p1;
    __device__ bool next(int i, Unit& u) const { if (i >= n) return false; u.pm = pm; u.pn = (i == 0) ? p0 : p1; return true; }
};
template <class Epi, bool ALIGN_EPI, class Sched = StaticOrder>
__device__ __forceinline__ void gemm_phase(LAS unsigned char* lds, const Gemm g, const Sched& S, const Epi& E) {
    const int tid = threadIdx.x, wid = __builtin_amdgcn_readfirstlane(tid >> 6), lane = tid & 63, wr = wid >> 2, wc = wid & 3, fr = lane & 15, fq = lane >> 4;
    const int K = g.K, nt = K / BK, lda = g.lda;
    unsigned voffA[2], voffB[2];
#pragma unroll
    for (int i = 0; i < 2; ++i) { int R, C; stage_rc(tid * 16 + i * 8192, R, C); const int Rb = Epi::PERM ? ((R & ~31) + perm32(R & 31)) : R;
        voffA[i] = (unsigned)(R * lda + C) * 2u; voffB[i] = (unsigned)(Rb * K + C) * 2u; }
    const size_t kstep = (size_t)(BK * 2);
    const size_t hstepA = (size_t)HALF * lda * 2, hstepB = (size_t)HALF * K * 2;
    const size_t tstepA = 2 * hstepA, tstepB = 2 * hstepB;
    const unsigned ldsw = (unsigned)wid * 1024u;
    const int aoff = lds_byte(wr * 64 + fr, fq * 8), boff = lds_byte(wc * 32 + fr, fq * 8);
#define PG8_SA(b, h) (((b) * 2 + (h)) * HTB)
#define PG8_SB(b, h) ((4 + (b) * 2 + (h)) * HTB)
#define PG8_STAGE(bufoff, gbase, voff) do { _Pragma("unroll") for (int _i = 0; _i < 2; ++_i) \
        __builtin_amdgcn_global_load_lds((const unsigned*)((const char*)(gbase) + (voff)[_i]), (LAS unsigned*)(lds + (bufoff) + ldsw + _i * 8192), 16, 0, 0); } while (0)
#define PG8_LDA(dst, b, h) do { _Pragma("unroll") for (int m = 0; m < 4; ++m) _Pragma("unroll") for (int k = 0; k < 2; ++k) dst[m][k] = *(const LAS bf16x8*)(lds + PG8_SA(b, h) + aoff + m * 2048 + k * 1024); } while (0)
#define PG8_LDB(dst, b, h) do { _Pragma("unroll") for (int n = 0; n < 2; ++n) _Pragma("unroll") for (int k = 0; k < 2; ++k) dst[n][k] = *(const LAS bf16x8*)(lds + PG8_SB(b, h) + boff + n * 2048 + k * 1024); } while (0)
#define PG8_MMA(ai, bj, At, Bt) do { __builtin_amdgcn_s_setprio(1); _Pragma("unroll") for (int m = 0; m < 4; ++m) _Pragma("unroll") for (int n = 0; n < 2; ++n) _Pragma("unroll") for (int k = 0; k < 2; ++k) \
        acc[ai][bj][m][n] = __builtin_amdgcn_mfma_f32_16x16x32_bf16(Bt[n][k], At[m][k], acc[ai][bj][m][n], 0, 0, 0); __builtin_amdgcn_s_setprio(0); } while (0)
#define PG8_WAIT_V(n) asm volatile("s_waitcnt vmcnt(" #n ")" ::: "memory")
#define PG8_WAIT_L(n) asm volatile("s_waitcnt lgkmcnt(" #n ")" ::: "memory")
#define PG8_BAR __builtin_amdgcn_s_barrier()
#define PG8_SCHED __builtin_amdgcn_sched_barrier(0)
    Unit cur, nxt; int ui = 0;
    if (!S.next(0, cur)) return;
    f32x4 acc[2][2][4][2];
#pragma unroll
    for (int a = 0; a < 2; ++a)
#pragma unroll
        for (int b = 0; b < 2; ++b)
#pragma unroll
            for (int m = 0; m < 4; ++m)
#pragma unroll
                for (int n = 0; n < 2; ++n) acc[a][b][m][n] = (f32x4){0.f, 0.f, 0.f, 0.f};
    bf16x8 At[4][2], B0[2][2], B1[2][2];
    const char* cA = (const char*)g.A + (size_t)cur.pm * tstepA; const char* cB = (const char*)g.Bt + (size_t)cur.pn * tstepB;
    {
        PG8_STAGE(PG8_SB(0, 0), cB, voffB); PG8_STAGE(PG8_SB(0, 1), cB + hstepB, voffB); PG8_STAGE(PG8_SA(0, 0), cA, voffA); PG8_STAGE(PG8_SA(0, 1), cA + hstepA, voffA);
        if (wr == 1) PG8_BAR;
        PG8_WAIT_V(2); PG8_BAR;
        PG8_STAGE(PG8_SB(1, 0), cB + kstep, voffB); PG8_STAGE(PG8_SA(1, 0), cA + kstep, voffA); PG8_STAGE(PG8_SB(1, 1), cB + hstepB + kstep, voffB);
        PG8_WAIT_V(6); PG8_BAR;
    }
    for (;;) {
        const bool has_next = S.next(ui + 1, nxt);
        const char* nA = has_next ? (const char*)g.A + (size_t)nxt.pm * tstepA : cA; const char* nB = has_next ? (const char*)g.Bt + (size_t)nxt.pn * tstepB : cB;
#pragma unroll 1
        for (int t = 0; t < nt; t += 2) {
            const bool last = (t == nt - 2);
            const char* a1 = cA + (size_t)(t + 1) * kstep;
            const char* a2 = last ? nA : cA + (size_t)(t + 2) * kstep; const char* b2 = last ? nB : cB + (size_t)(t + 2) * kstep;
            const char* a3 = a2 + kstep; const char* b3 = b2 + kstep;
            PG8_LDB(B0, 0, 0); PG8_LDB(B1, 0, 1); PG8_SCHED; PG8_LDA(At, 0, 0); PG8_STAGE(PG8_SA(1, 1), a1 + hstepA, voffA);
            PG8_WAIT_V(8); PG8_WAIT_L(0); PG8_BAR; PG8_MMA(0, 0, At, B0); PG8_MMA(0, 1, At, B1); PG8_BAR; PG8_SCHED;
            PG8_LDA(At, 0, 1); PG8_STAGE(PG8_SB(0, 0), b2, voffB); PG8_STAGE(PG8_SB(0, 1), b2 + hstepB, voffB); PG8_STAGE(PG8_SA(0, 0), a2, voffA);
            PG8_WAIT_V(8); PG8_WAIT_L(0); PG8_BAR; PG8_MMA(1, 0, At, B0); PG8_MMA(1, 1, At, B1); PG8_BAR; PG8_SCHED;
            PG8_LDB(B0, 1, 0); PG8_LDB(B1, 1, 1); PG8_SCHED; PG8_LDA(At, 1, 0); PG8_STAGE(PG8_SA(0, 1), a2 + hstepA, voffA);
            PG8_WAIT_V(8); PG8_WAIT_L(0); PG8_BAR; PG8_MMA(0, 0, At, B0); PG8_MMA(0, 1, At, B1); PG8_BAR; PG8_SCHED;
            PG8_LDA(At, 1, 1); PG8_STAGE(PG8_SB(1, 0), b3, voffB); PG8_STAGE(PG8_SB(1, 1), b3 + hstepB, voffB); PG8_STAGE(PG8_SA(1, 0), a3, voffA);
            PG8_WAIT_V(8); PG8_WAIT_L(0); PG8_BAR; PG8_MMA(1, 0, At, B0); PG8_MMA(1, 1, At, B1); PG8_BAR; PG8_SCHED;
        }
        if constexpr (ALIGN_EPI) { if (wr == 0) PG8_BAR; }
        if constexpr (!Epi::AFTER_DRAIN) E(acc, cur, wr, wc, fr, fq);
        if (!has_next) break;
#pragma unroll
        for (int a = 0; a < 2; ++a)
#pragma unroll
            for (int b = 0; b < 2; ++b)
#pragma unroll
                for (int m = 0; m < 4; ++m)
#pragma unroll
                    for (int n = 0; n < 2; ++n) acc[a][b][m][n] = (f32x4){0.f, 0.f, 0.f, 0.f};
        cur = nxt; cA = nA; cB = nB; ++ui;
        if constexpr (ALIGN_EPI) { if (wr == 1) PG8_BAR; }
    }
    PG8_WAIT_V(0);
    if constexpr (!ALIGN_EPI) { if (wr == 0) PG8_BAR; }
    PG8_BAR;
    if constexpr (Epi::AFTER_DRAIN) E.fused(acc, cur, wr, wc, fr, fq);
#undef PG8_SA
#undef PG8_SB
#undef PG8_STAGE
#undef PG8_LDA
#undef PG8_LDB
#undef PG8_MMA
#undef PG8_WAIT_V
#undef PG8_WAIT_L
#undef PG8_BAR
#undef PG8_SCHED
}
}


struct EpiProj {
    static constexpr bool PERM = true, AFTER_DRAIN = false;
    bf16_t* P; float* ssq_q; float* ssq_kv; const float* ropec; const float* ropes; bf16_t* vts;
    __device__ __forceinline__ void operator()(const f32x4 (&acc)[2][2][4][2], const pg8::Unit& u, int wr, int wc, int fr, int fq) const {
        const int row0 = u.pm * 256 + wr * 64 + fr;
#pragma unroll
        for (int bj = 0; bj < 2; ++bj) {
            const int cgp = u.pn * 2 + bj;
            const int col = cgp * 128 + wc * 32 + 8 * fq;
            const bool is_q = cgp < 3, is_kv = (cgp == 3 || cgp == 4), is_kpe = (cgp == 5 && wc == 0);
            const bool is_swaq = (cgp == 5 && wc >= 1) || (cgp >= 6 && cgp <= 8) || (cgp == 9 && wc == 0);
            const bool is_swav = (cgp == 10 && wc >= 1) || (cgp == 11 && wc == 0);
#pragma unroll
            for (int ai = 0; ai < 2; ++ai)
#pragma unroll
                for (int m = 0; m < 4; ++m) {
                    const int row = row0 + ai * 128 + m * 16;
                    f32x4 v0 = acc[ai][bj][m][0], v1 = acc[ai][bj][m][1];
                    if (is_q || is_kv) {
                        float s = (v0[0] * v0[0] + v0[1] * v0[1]) + (v0[2] * v0[2] + v0[3] * v0[3]) + (v1[0] * v1[0] + v1[1] * v1[1]) + (v1[2] * v1[2] + v1[3] * v1[3]);
                        s += __shfl_xor(s, 16); s += __shfl_xor(s, 32);
                        if (fq == 0) unsafeAtomicAdd((is_q ? ssq_q : ssq_kv) + row, s);
                    }
                    if (is_kpe) {
                        f32x4 p0, p1;
#pragma unroll
                        for (int j = 0; j < 4; ++j) { p0[j] = __shfl_xor(v0[j], 32); p1[j] = __shfl_xor(v1[j], 32); }
                        const int pos = row & (SEQ - 1), i0 = (8 * fq) & 15;
                        const f32x4 c0 = *(const f32x4*)(ropec + pos * 16 + i0), c1 = *(const f32x4*)(ropec + pos * 16 + i0 + 4);
                        const f32x4 s0 = *(const f32x4*)(ropes + pos * 16 + i0), s1 = *(const f32x4*)(ropes + pos * 16 + i0 + 4);
                        const float sg = fq < 2 ? -1.f : 1.f;
                        v0 = v0 * c0 + p0 * s0 * sg; v1 = v1 * c1 + p1 * s1 * sg;
                    }
                    if (is_swaq) { v0 = v0 * QSC_SWA; v1 = v1 * QSC_SWA; }
                    u32x4 w; w.x = pk2(v0[0], v0[1]); w.y = pk2(v0[2], v0[3]); w.z = pk2(v1[0], v1[1]); w.w = pk2(v1[2], v1[3]);
                    st16_wt(P + (size_t)row * NPROJ + col, w);
                    if (is_swav) {
                        const int d = col - 1312, kvh = d >> 6, dd = d & 63, b = row >> 11, s = row & (SEQ - 1);
                        bf16_t* base = vts + ((size_t)((b * 2 + kvh) * 64 + dd)) * SEQ + s;
                        base[0 * SEQ] = (bf16_t)(w.x & 0xffffu); base[1 * SEQ] = (bf16_t)(w.x >> 16);
                        base[2 * SEQ] = (bf16_t)(w.y & 0xffffu); base[3 * SEQ] = (bf16_t)(w.y >> 16);
                        base[4 * SEQ] = (bf16_t)(w.z & 0xffffu); base[5 * SEQ] = (bf16_t)(w.z >> 16);
                        base[6 * SEQ] = (bf16_t)(w.w & 0xffffu); base[7 * SEQ] = (bf16_t)(w.w >> 16);
                    }
                }
        }
    }
};
struct EpiQ {
    static constexpr bool PERM = true, AFTER_DRAIN = false;
    bf16_t* Q; const float* ssq_q; const float* ropec; const float* ropes;
    __device__ __forceinline__ void operator()(const f32x4 (&acc)[2][2][4][2], const pg8::Unit& u, int wr, int wc, int fr, int fq) const {
        const int row0 = u.pm * 256 + wr * 64 + fr;
        const int i0 = (8 * fq) & 15; const float sg = fq < 2 ? -1.f : 1.f;
#pragma unroll
        for (int ai = 0; ai < 2; ++ai)
#pragma unroll
            for (int m = 0; m < 4; ++m) {
                const int row = row0 + ai * 128 + m * 16, pos = row & (SEQ - 1);
                const float rs = __builtin_amdgcn_rsqf(__hip_atomic_load(ssq_q + row, __ATOMIC_RELAXED, __HIP_MEMORY_SCOPE_AGENT) * (1.0f / QL) + EPS) * QSC_MLA;
#pragma unroll
                for (int bj = 0; bj < 2; ++bj) {
                    const int G = u.pn * 8 + bj * 4 + wc;
                    f32x4 v0 = acc[ai][bj][m][0] * rs, v1 = acc[ai][bj][m][1] * rs;
                    if ((G % 3) == 2) {
                        f32x4 p0, p1;
#pragma unroll
                        for (int j = 0; j < 4; ++j) { p0[j] = __shfl_xor(v0[j], 32); p1[j] = __shfl_xor(v1[j], 32); }
                        const f32x4 c0 = *(const f32x4*)(ropec + pos * 16 + i0), c1 = *(const f32x4*)(ropec + pos * 16 + i0 + 4);
                        const f32x4 s0 = *(const f32x4*)(ropes + pos * 16 + i0), s1 = *(const f32x4*)(ropes + pos * 16 + i0 + 4);
                        v0 = v0 * c0 + p0 * s0 * sg; v1 = v1 * c1 + p1 * s1 * sg;
                    }
                    *(u32x4*)(Q + (size_t)row * QW + G * 32 + 8 * fq) = (u32x4){pk2(v0[0], v0[1]), pk2(v0[2], v0[3]), pk2(v1[0], v1[1]), pk2(v1[2], v1[3])};
                }
                asm volatile("" ::: "memory");
            }
    }
};
struct EpiKV {
    static constexpr bool PERM = false, AFTER_DRAIN = false;
    bf16_t* KN; bf16_t* VT; const float* ssq_kv;
    __device__ __forceinline__ void operator()(const f32x4 (&acc)[2][2][4][2], const pg8::Unit& u, int wr, int wc, int fr, int fq) const {
        const int row0 = u.pm * 256 + wr * 64 + fr;
#pragma unroll
        for (int ai = 0; ai < 2; ++ai)
#pragma unroll
            for (int m = 0; m < 4; ++m) {
                const int row = row0 + ai * 128 + m * 16, b = row >> 11, s = row & (SEQ - 1);
                const float rs = __builtin_amdgcn_rsqf(__hip_atomic_load(ssq_kv + row, __ATOMIC_RELAXED, __HIP_MEMORY_SCOPE_AGENT) * (1.0f / KVL) + EPS);
#pragma unroll
                for (int bj = 0; bj < 2; ++bj) {
                    const int head = u.pn * 2 + bj;
                    const f32x4 x1 = acc[ai][bj][m][0] * rs, x2 = acc[ai][bj][m][1] * rs;
                    const unsigned a0 = pk2(x1[0], x1[1]), a1 = pk2(x1[2], x1[3]), b0 = pk2(x2[0], x2[1]), b1 = pk2(x2[2], x2[3]);
                    if (wc < 2) {
                        bf16_t* p = KN + (size_t)row * 512 + head * 64 + wc * 32 + 4 * fq;
                        *(u32x2*)p = (u32x2){a0, a1}; *(u32x2*)(p + 16) = (u32x2){b0, b1};
                    } else {
                        bf16_t* base = VT + ((size_t)((b * 8 + head) * 64 + (wc - 2) * 32 + 4 * fq)) * SEQ + s;
                        base[0 * SEQ] = (bf16_t)(a0 & 0xffffu); base[1 * SEQ] = (bf16_t)(a0 >> 16); base[2 * SEQ] = (bf16_t)(a1 & 0xffffu); base[3 * SEQ] = (bf16_t)(a1 >> 16);
                        base[16 * SEQ] = (bf16_t)(b0 & 0xffffu); base[17 * SEQ] = (bf16_t)(b0 >> 16); base[18 * SEQ] = (bf16_t)(b1 & 0xffffu); base[19 * SEQ] = (bf16_t)(b1 >> 16);
                    }
                }
                asm volatile("" ::: "memory");
            }
    }
};
struct EpiRes {
    static constexpr bool PERM = false, AFTER_DRAIN = false;
    const float* base; float* out; const float* gate;
    __device__ __forceinline__ void operator()(const f32x4 (&acc)[2][2][4][2], const pg8::Unit& u, int wr, int wc, int fr, int fq) const {
        const int row0 = u.pm * 256 + wr * 64 + fr, b = u.pm >> 3;
#pragma unroll
        for (int bj = 0; bj < 2; ++bj)
#pragma unroll
            for (int n = 0; n < 2; ++n) {
                const int col = u.pn * 256 + bj * 128 + wc * 32 + n * 16 + 4 * fq;
                const f32x4 gv = *(const f32x4*)(gate + b * 6144 + col);
#pragma unroll
                for (int ai = 0; ai < 2; ++ai)
#pragma unroll
                    for (int m = 0; m < 4; ++m) {
                        const size_t off = (size_t)(row0 + ai * 128 + m * 16) * DM + col;
                        const f32x4 bs = *(const f32x4*)(base + off);
                        *(f32x4*)(out + off) = bs + gv * acc[ai][bj][m][n];
                    }
            }
    }
};
struct EpiUp {
    static constexpr bool PERM = true, AFTER_DRAIN = false;
    bf16_t* U;
    __device__ __forceinline__ void operator()(const f32x4 (&acc)[2][2][4][2], const pg8::Unit& u, int wr, int wc, int fr, int fq) const {
        const int row0 = u.pm * 256 + wr * 64 + fr, col0 = u.pn * 256 + wc * 32 + 8 * fq;
#pragma unroll
        for (int ai = 0; ai < 2; ++ai)
#pragma unroll
            for (int m = 0; m < 4; ++m) {
                bf16_t* rowp = U + (size_t)(row0 + ai * 128 + m * 16) * FF + col0;
#pragma unroll
                for (int bj = 0; bj < 2; ++bj) {
                    f32x4 v0 = acc[ai][bj][m][0], v1 = acc[ai][bj][m][1];
#pragma unroll
                    for (int j = 0; j < 4; ++j) { const float a = fmaxf(v0[j], 0.f), c = fmaxf(v1[j], 0.f); v0[j] = a * a; v1[j] = c * c; }
                    u32x4 w; w.x = pk2(v0[0], v0[1]); w.y = pk2(v0[2], v0[3]); w.z = pk2(v1[0], v1[1]); w.w = pk2(v1[2], v1[3]);
                    st16_wt(rowp + bj * 128, w);
                }
            }
    }
};


struct PanelX {
    float* ssq; unsigned* cnt;
    __device__ __forceinline__ void exchange(const f32x4 (&v)[2][2][4][2], const pg8::Unit& u, int wr, int fr, int fq) const {
        const int row0 = u.pm * 256 + wr * 64 + fr;
#pragma unroll
        for (int ai = 0; ai < 2; ++ai)
#pragma unroll
            for (int m = 0; m < 4; ++m) {
                float s = 0.f;
#pragma unroll
                for (int bj = 0; bj < 2; ++bj)
#pragma unroll
                    for (int n = 0; n < 2; ++n) { const f32x4 x = v[ai][bj][m][n]; s += (x[0] * x[0] + x[1] * x[1]) + (x[2] * x[2] + x[3] * x[3]); }
                s += __shfl_xor(s, 16); s += __shfl_xor(s, 32);
                if (fq == 0) unsafeAtomicAdd(ssq + row0 + ai * 128 + m * 16, s);
            }
        asm volatile("s_waitcnt vmcnt(0)" ::: "memory");
        __syncthreads();
        if (threadIdx.x == 0) {
            unsigned* c = cnt + 64 * u.pm;
            __builtin_amdgcn_fence(__ATOMIC_RELEASE, "agent");
            __hip_atomic_fetch_add(c, 1u, __ATOMIC_RELAXED, __HIP_MEMORY_SCOPE_AGENT);
            unsigned sp = 0;
            while (__hip_atomic_load(c, __ATOMIC_RELAXED, __HIP_MEMORY_SCOPE_AGENT) < 4u) { __builtin_amdgcn_s_sleep(1); if (++sp > (1u << 22)) break; }
            __builtin_amdgcn_fence(__ATOMIC_ACQUIRE, "agent");
        }
        __syncthreads();
    }
    __device__ __forceinline__ float rstd(int row) const { return __builtin_amdgcn_rsqf(__hip_atomic_load(ssq + row, __ATOMIC_RELAXED, __HIP_MEMORY_SCOPE_AGENT) * (1.0f / DM) + EPS); }
};
struct EpiResNorm {
    static constexpr bool PERM = true, AFTER_DRAIN = true;
    const float* base; bf16_t* X1; bf16_t* H; const float* mod; const float* g; PanelX px;
    __device__ __forceinline__ void fused(f32x4 (&acc)[2][2][4][2], const pg8::Unit& u, int wr, int wc, int fr, int fq) const {
        const int row0 = u.pm * 256 + wr * 64 + fr, b = u.pm >> 3, col0 = u.pn * 256 + wc * 32 + 8 * fq;
        const float* mb = mod + b * 6144 + col0;
        {
            f32x4 gv[2][2];
#pragma unroll
            for (int bj = 0; bj < 2; ++bj)
#pragma unroll
                for (int n = 0; n < 2; ++n) gv[bj][n] = *(const f32x4*)(mb + 2 * 1024 + bj * 128 + n * 4);
#pragma unroll
            for (int ai = 0; ai < 2; ++ai)
#pragma unroll
                for (int m = 0; m < 4; ++m) {
                    const size_t off = (size_t)(row0 + ai * 128 + m * 16) * DM + col0;
                    const float* bp = base + off; bf16_t* op = X1 + off;
#pragma unroll
                    for (int bj = 0; bj < 2; ++bj) {
                        const f32x4 v0 = *(const f32x4*)(bp + bj * 128) + gv[bj][0] * acc[ai][bj][m][0], v1 = *(const f32x4*)(bp + bj * 128 + 4) + gv[bj][1] * acc[ai][bj][m][1];
                        acc[ai][bj][m][0] = v0; acc[ai][bj][m][1] = v1;
                        *(u32x4*)(op + bj * 128) = (u32x4){pk2(v0[0], v0[1]), pk2(v0[2], v0[3]), pk2(v1[0], v1[1]), pk2(v1[2], v1[3])};
                    }
                    if (m & 1) asm volatile("" ::: "memory");
                }
        }
        px.exchange(acc, u, wr, fr, fq);
        int row0b = row0; asm volatile("" : "+v"(row0b));
        {
            f32x4 gs[2][2], sh[2][2];
#pragma unroll
            for (int bj = 0; bj < 2; ++bj)
#pragma unroll
                for (int n = 0; n < 2; ++n) {
                    gs[bj][n] = *(const f32x4*)(g + col0 + bj * 128 + n * 4) * (*(const f32x4*)(mb + 4 * 1024 + bj * 128 + n * 4) + 1.0f);
                    sh[bj][n] = *(const f32x4*)(mb + 3 * 1024 + bj * 128 + n * 4);
                }
#pragma unroll
            for (int ai = 0; ai < 2; ++ai)
#pragma unroll
                for (int m = 0; m < 4; ++m) {
                    const int row = row0b + ai * 128 + m * 16;
                    const float rs = px.rstd(row);
                    bf16_t* hp = H + (size_t)row * DM + col0;
#pragma unroll
                    for (int bj = 0; bj < 2; ++bj) {
                        const f32x4 y0 = acc[ai][bj][m][0] * rs * gs[bj][0] + sh[bj][0], y1 = acc[ai][bj][m][1] * rs * gs[bj][1] + sh[bj][1];
                        st16_wt(hp + bj * 128, (u32x4){pk2(y0[0], y0[1]), pk2(y0[2], y0[3]), pk2(y1[0], y1[1]), pk2(y1[2], y1[3])});
                    }
                    if (m & 1) asm volatile("" ::: "memory");
                }
        }
    }
};
struct EpiResFinal {
    static constexpr bool PERM = false, AFTER_DRAIN = true;
    const bf16_t* X1; float* out; const float* mod; const float* fg; PanelX px;
    __device__ __forceinline__ void fused(f32x4 (&acc)[2][2][4][2], const pg8::Unit& u, int wr, int wc, int fr, int fq) const {
        const int row0 = u.pm * 256 + wr * 64 + fr, b = u.pm >> 3, col0 = u.pn * 256 + wc * 32 + 4 * fq;
        const float* mb = mod + b * 6144 + col0;
        {
            f32x4 gv[2][2];
#pragma unroll
            for (int bj = 0; bj < 2; ++bj)
#pragma unroll
                for (int n = 0; n < 2; ++n) gv[bj][n] = *(const f32x4*)(mb + 5 * 1024 + bj * 128 + n * 16);
#pragma unroll
            for (int ai = 0; ai < 2; ++ai)
#pragma unroll
                for (int m = 0; m < 4; ++m) {
                    const bf16_t* bp = X1 + (size_t)(row0 + ai * 128 + m * 16) * DM + col0;
#pragma unroll
                    for (int bj = 0; bj < 2; ++bj)
#pragma unroll
                        for (int n = 0; n < 2; ++n) { const u32x2 w = *(const u32x2*)(bp + bj * 128 + n * 16);
                            const f32x4 xb = (f32x4){__uint_as_float(w.x << 16), __uint_as_float(w.x & 0xffff0000u), __uint_as_float(w.y << 16), __uint_as_float(w.y & 0xffff0000u)};
                            acc[ai][bj][m][n] = xb + gv[bj][n] * acc[ai][bj][m][n]; }
                    asm volatile("" : "+v"(acc[ai][0][m][0]), "+v"(acc[ai][0][m][1]), "+v"(acc[ai][1][m][0]), "+v"(acc[ai][1][m][1]));
                    if (m & 1) asm volatile("" ::: "memory");
                }
        }
        px.exchange(acc, u, wr, fr, fq);
        int row0b = row0; asm volatile("" : "+v"(row0b));
        {
            f32x4 fgv[2][2];
#pragma unroll
            for (int bj = 0; bj < 2; ++bj)
#pragma unroll
                for (int n = 0; n < 2; ++n) fgv[bj][n] = *(const f32x4*)(fg + col0 + bj * 128 + n * 16);
#pragma unroll
            for (int ai = 0; ai < 2; ++ai)
#pragma unroll
                for (int m = 0; m < 4; ++m) {
                    const int row = row0b + ai * 128 + m * 16;
                    const float rs = px.rstd(row);
                    float* op = out + (size_t)row * DM + col0;
#pragma unroll
                    for (int bj = 0; bj < 2; ++bj)
#pragma unroll
                        for (int n = 0; n < 2; ++n) *(f32x4*)(op + bj * 128 + n * 16) = acc[ai][bj][m][n] * rs * fgv[bj][n];
                    if (m & 1) asm volatile("" ::: "memory");
                }
        }
    }
};

constexpr int KSTR = 208, VSTR = 136, VOFF = 64 * KSTR;
template <int QKD, int MODE>
__device__ __forceinline__ void attn_unit(LAS unsigned char* lds, const bf16_t* Q, int ldq, const bf16_t* K1, int ldk1, const bf16_t* K2, int ldk2,
                                          const bf16_t* VT, bf16_t* O, int qpos0, int t_lo, int t_hi, float slope2, float sink2, int tid, int wid, int lane) {
    const int r = lane & 31, hi = lane >> 5;
    const int q0 = qpos0 + 32 * wid;
    constexpr int NKB = QKD / 16;
    bf16x8 qf[NKB];
#pragma unroll
    for (int kb = 0; kb < NKB; ++kb) qf[kb] = *(const bf16x8*)(Q + (size_t)(32 * wid + r) * ldq + 16 * kb + 8 * hi);
    f32x16 o0, o1;
#pragma unroll
    for (int i = 0; i < 16; ++i) { o0[i] = 0.f; o1[i] = 0.f; }
    float mrun = (MODE == 1) ? sink2 : -1e30f;
    float lsum = (MODE == 1) ? (hi == 0 ? 1.f : 0.f) : 0.f;
    const int key1 = tid >> 3, ch1 = tid & 7, key2 = (tid >> 2) & 63, ch2 = tid & 3;
    u32x4 kr, k2r, vr;
    kr = *(const u32x4*)(K1 + (size_t)(64 * t_lo + key1) * ldk1 + ch1 * 8);
    if (QKD == 96) { if (tid < 256) k2r = *(const u32x4*)(K2 + (size_t)(64 * t_lo + key2) * ldk2 + ch2 * 8); }
    vr = *(const u32x4*)(VT + (size_t)key1 * SEQ + 64 * t_lo + ch1 * 8);
    for (int t = t_lo; t <= t_hi; ++t) {
        __syncthreads();
        *(LAS u32x4*)(lds + key1 * KSTR + ch1 * 16) = kr;
        if (QKD == 96) { if (tid < 256) *(LAS u32x4*)(lds + key2 * KSTR + 128 + ch2 * 16) = k2r; }
        *(LAS u32x2*)(lds + VOFF + key1 * VSTR + ch1 * 16) = (u32x2){vr.x, vr.y};
        *(LAS u32x2*)(lds + VOFF + key1 * VSTR + ch1 * 16 + 8) = (u32x2){vr.z, vr.w};
        __syncthreads();
        if (t < t_hi) {
            kr = *(const u32x4*)(K1 + (size_t)(64 * (t + 1) + key1) * ldk1 + ch1 * 8);
            if (QKD == 96) { if (tid < 256) k2r = *(const u32x4*)(K2 + (size_t)(64 * (t + 1) + key2) * ldk2 + ch2 * 8); }
            vr = *(const u32x4*)(VT + (size_t)key1 * SEQ + 64 * (t + 1) + ch1 * 8);
        }
        const int k0 = 64 * t;
        const bool active = (MODE == 0) ? (k0 <= q0 + 31) : ((k0 + 63 >= q0 - 127) && (k0 <= q0 + 31));
        if (active) {
            f32x16 s[2];
#pragma unroll
            for (int sub = 0; sub < 2; ++sub) {
#pragma unroll
                for (int i = 0; i < 16; ++i) s[sub][i] = 0.f;
#pragma unroll
                for (int kb = 0; kb < NKB; ++kb) {
                    const bf16x8 kf = *(const LAS bf16x8*)(lds + (32 * sub + r) * KSTR + (16 * kb + 8 * hi) * 2);
                    s[sub] = __builtin_amdgcn_mfma_f32_32x32x16_bf16(kf, qf[kb], s[sub], 0, 0, 0);
                }
            }
            const int qp = q0 + r;
            if (MODE == 0) {
                if (k0 + 63 > q0) {
#pragma unroll
                    for (int sub = 0; sub < 2; ++sub)
#pragma unroll
                        for (int i = 0; i < 16; ++i) { const int key = k0 + 32 * sub + (i & 3) + 8 * (i >> 2) + 4 * hi; if (key > qp) s[sub][i] = -INFINITY; }
                }
            } else {
#pragma unroll
                for (int sub = 0; sub < 2; ++sub)
#pragma unroll
                    for (int i = 0; i < 16; ++i) { const int key = k0 + 32 * sub + (i & 3) + 8 * (i >> 2) + 4 * hi; const int dist = qp - key;
                        s[sub][i] = (dist < 0 || dist >= 128) ? -INFINITY : (s[sub][i] - slope2 * (float)dist); }
            }
            float mx = -INFINITY;
#pragma unroll
            for (int sub = 0; sub < 2; ++sub)
#pragma unroll
                for (int i = 0; i < 16; ++i) mx = fmaxf(mx, s[sub][i]);
            mx = fmaxf(mx, __shfl_xor(mx, 32));
            const float mn = fmaxf(mrun, mx);
            const float alpha = __builtin_amdgcn_exp2f(mrun - mn);
            mrun = mn;
            float psum = 0.f;
#pragma unroll
            for (int sub = 0; sub < 2; ++sub)
#pragma unroll
                for (int i = 0; i < 16; ++i) { const float p = __builtin_amdgcn_exp2f(s[sub][i] - mn); s[sub][i] = p; psum += p; }
            lsum = lsum * alpha + psum;
            o0 = o0 * alpha; o1 = o1 * alpha;
#pragma unroll
            for (int sub = 0; sub < 2; ++sub)
#pragma unroll
                for (int jb = 0; jb < 2; ++jb) {
                    u32x4 pw;
                    pw.x = pk2(s[sub][8 * jb + 0], s[sub][8 * jb + 1]); pw.y = pk2(s[sub][8 * jb + 2], s[sub][8 * jb + 3]);
                    pw.z = pk2(s[sub][8 * jb + 4], s[sub][8 * jb + 5]); pw.w = pk2(s[sub][8 * jb + 6], s[sub][8 * jb + 7]);
                    const bf16x8 pf = __builtin_bit_cast(bf16x8, pw);
                    const LAS unsigned char* vp = lds + VOFF + r * VSTR + (32 * sub + 16 * jb + 4 * hi) * 2;
                    {
                        const u32x2 a = *(const LAS u32x2*)vp, b = *(const LAS u32x2*)(vp + 16);
                        const bf16x8 vf = __builtin_bit_cast(bf16x8, (u32x4){a.x, a.y, b.x, b.y});
                        o0 = __builtin_amdgcn_mfma_f32_32x32x16_bf16(vf, pf, o0, 0, 0, 0);
                    }
                    {
                        const u32x2 a = *(const LAS u32x2*)(vp + 32 * VSTR), b = *(const LAS u32x2*)(vp + 32 * VSTR + 16);
                        const bf16x8 vf = __builtin_bit_cast(bf16x8, (u32x4){a.x, a.y, b.x, b.y});
                        o1 = __builtin_amdgcn_mfma_f32_32x32x16_bf16(vf, pf, o1, 0, 0, 0);
                    }
                }
        }
    }
    const float ltot = lsum + __shfl_xor(lsum, 32);
    const float inv = 1.0f / ltot;
    bf16_t* op = O + (size_t)(32 * wid + r) * DM + 4 * hi;
#pragma unroll
    for (int g = 0; g < 4; ++g) {
        *(u32x2*)(op + 8 * g) = (u32x2){pk2(o0[4 * g] * inv, o0[4 * g + 1] * inv), pk2(o0[4 * g + 2] * inv, o0[4 * g + 3] * inv)};
        *(u32x2*)(op + 32 + 8 * g) = (u32x2){pk2(o1[4 * g] * inv, o1[4 * g + 1] * inv), pk2(o1[4 * g + 2] * inv, o1[4 * g + 3] * inv)};
    }
}

struct TrDesc { const float* W; bf16_t* WT; const float* ks; int K, N, item; };
__device__ __forceinline__ void tr_load(const TrDesc& d, f32x4 (&v)[8], int lane) {
    const int nblk = d.N / 32, kb = d.item / nblk, nb = d.item % nblk, k0 = 64 * kb, n0 = 32 * nb;
    const int kk0 = lane >> 3, n4 = lane & 7;
#pragma unroll
    for (int i = 0; i < 8; ++i) v[i] = *(const f32x4*)(d.W + (size_t)(k0 + kk0 + 8 * i) * d.N + n0 + 4 * n4);
}
__device__ __forceinline__ void tr_finish(const TrDesc& d, f32x4 (&v)[8], LAS float* scr, int lane) {
    const int nblk = d.N / 32, kb = d.item / nblk, nb = d.item % nblk, k0 = 64 * kb, n0 = 32 * nb;
    const int kk0 = lane >> 3, n4 = lane & 7;
    if (d.ks) {
#pragma unroll
        for (int i = 0; i < 8; ++i) v[i] = v[i] * d.ks[k0 + kk0 + 8 * i];
    }
#pragma unroll
    for (int i = 0; i < 8; ++i) { LAS float* p = scr + (kk0 + 8 * i) * 33 + 4 * n4; p[0] = v[i][0]; p[1] = v[i][1]; p[2] = v[i][2]; p[3] = v[i][3]; }
    asm volatile("s_waitcnt lgkmcnt(0)" ::: "memory");
    const int c = lane & 7;
#pragma unroll
    for (int j = 0; j < 4; ++j) { const int n = (lane >> 3) + 8 * j; const LAS float* s = scr + (8 * c) * 33 + n;
        u32x4 o; o.x = pk2(s[0 * 33], s[1 * 33]); o.y = pk2(s[2 * 33], s[3 * 33]); o.z = pk2(s[4 * 33], s[5 * 33]); o.w = pk2(s[6 * 33], s[7 * 33]);
        *(u32x4*)(d.WT + (size_t)(n0 + n) * d.K + k0 + 8 * c) = o; }
    asm volatile("s_waitcnt lgkmcnt(0)" ::: "memory");
}
struct TrSet { const float *w_in, *w_qb, *w_kvb, *w_o, *w_up, *w_down, *g_qa, *g_kva; bf16_t *win_t, *wqb_t, *wkvb_t, *wo_t, *wup_t, *wdn_t; };
constexpr int I_IN = 16 * 45, I_QB = 6 * 24, I_KVB = 4 * 32, I_O = 16 * 32, I_UP = 16 * 128, I_DN = 64 * 32;
constexpr int NITEMS_EARLY = I_IN + I_QB + I_KVB, NITEMS_LATE = I_O + I_UP + I_DN;
__device__ __forceinline__ TrDesc tr_desc(const TrSet& T, int it) {
    int r = it;
    if (r < I_IN) return TrDesc{T.w_in, T.win_t, nullptr, DM, IN_COLS, r}; r -= I_IN;
    if (r < I_QB) return TrDesc{T.w_qb, T.wqb_t, T.g_qa, QL, QW, r}; r -= I_QB;
    if (r < I_KVB) return TrDesc{T.w_kvb, T.wkvb_t, T.g_kva, KVL, KVW, r}; r -= I_KVB;
    if (r < I_O) return TrDesc{T.w_o, T.wo_t, nullptr, DM, DM, r}; r -= I_O;
    if (r < I_UP) return TrDesc{T.w_up, T.wup_t, nullptr, DM, FF, r}; r -= I_UP;
    return TrDesc{T.w_down, T.wdn_t, nullptr, FF, DM, r};
}
__device__ __forceinline__ void tr_run(const TrSet& T, int first, int last, int w, int nw, LAS float* scr, int lane) {
    int it = first + w;
    if (it >= last) return;
    TrDesc d = tr_desc(T, it); f32x4 v[8]; tr_load(d, v, lane);
    for (;;) {
        const int itn = it + nw;
        if (itn < last) {
            const TrDesc dn = tr_desc(T, itn); f32x4 vn[8]; tr_load(dn, vn, lane);
            tr_finish(d, v, scr, lane);
            d = dn;
#pragma unroll
            for (int i = 0; i < 8; ++i) v[i] = vn[i];
            it = itn;
        } else { tr_finish(d, v, scr, lane); break; }
    }
}
__device__ __forceinline__ void p0_mod_block(const float* c, const float* w_ada, const float* b_ada, float* mod, LAS unsigned char* lds, int blk, int tid) {
    LAS float* sl = (LAS float*)lds;
    LAS float* part = (LAS float*)(lds + 32768);
    for (int i = tid; i < 8 * DM; i += 512) { const float x = c[i]; sl[i] = x / (1.0f + __expf(-x)); }
    __syncthreads();
    const int c4 = tid % 6, r = tid / 6;
    if (r < 85) {
        f32x4 acc[8];
#pragma unroll
        for (int b = 0; b < 8; ++b) acc[b] = (f32x4){0.f, 0.f, 0.f, 0.f};
        const float* wp = w_ada + (size_t)r * 6144 + 24 * blk + 4 * c4;
        f32x4 w[12];
#pragma unroll
        for (int i = 0; i < 12; ++i) w[i] = *(const f32x4*)(wp + (size_t)(85 * i) * 6144);
        f32x4 wt = (f32x4){0.f, 0.f, 0.f, 0.f};
        if (r < 4) wt = *(const f32x4*)(wp + (size_t)1020 * 6144);
#pragma unroll
        for (int i = 0; i < 12; ++i) {
#pragma unroll
            for (int b = 0; b < 8; ++b) acc[b] += w[i] * sl[b * DM + r + 85 * i];
        }
        if (r < 4) {
#pragma unroll
            for (int b = 0; b < 8; ++b) acc[b] += wt * sl[b * DM + r + 1020];
        }
#pragma unroll
        for (int b = 0; b < 8; ++b)
#pragma unroll
            for (int j = 0; j < 4; ++j) part[r * 192 + b * 24 + 4 * c4 + j] = acc[b][j];
    }
    __syncthreads();
    if (tid < 192) {
        float sum = 0.f;
        for (int rr = 0; rr < 85; ++rr) sum += part[rr * 192 + tid];
        const int b = tid / 24, cc = tid % 24;
        mod[b * 6144 + 24 * blk + cc] = sum + b_ada[24 * blk + cc];
    }
    __syncthreads();
}
__device__ __forceinline__ void rows_load4(const float* x, int m, f32x4 (&v)[16], int lane) {
    const f32x4* xr = (const f32x4*)(x + (size_t)m * DM) + 2 * lane;
#pragma unroll
    for (int q = 0; q < 4; ++q)
#pragma unroll
        for (int jj = 0; jj < 2; ++jj) { v[4 * q + 2 * jj] = xr[256 * q + 128 * jj]; v[4 * q + 2 * jj + 1] = xr[256 * q + 128 * jj + 1]; }
}
__device__ __forceinline__ void rows_finish4(const f32x4 (&v)[16], bf16_t* orow, const float* g, const float* sc, const float* sh, int lane) {
    float rs[4];
#pragma unroll
    for (int q = 0; q < 4; ++q) { float t = 0.f;
#pragma unroll
        for (int j = 0; j < 4; ++j) { const f32x4 a = v[4 * q + j]; t += (a[0] * a[0] + a[1] * a[1]) + (a[2] * a[2] + a[3] * a[3]); }
        rs[q] = t; }
#pragma unroll
    for (int o = 1; o < 64; o <<= 1) {
#pragma unroll
        for (int q = 0; q < 4; ++q) rs[q] += __shfl_xor(rs[q], o);
    }
#pragma unroll
    for (int q = 0; q < 4; ++q) rs[q] = 1.0f / sqrtf(rs[q] * (1.0f / DM) + EPS);
#pragma unroll
    for (int jj = 0; jj < 2; ++jj) {
        const int ci = 128 * jj + 2 * lane;
        const f32x4 g0 = ((const f32x4*)g)[ci] * (((const f32x4*)sc)[ci] + 1.0f), g1 = ((const f32x4*)g)[ci + 1] * (((const f32x4*)sc)[ci + 1] + 1.0f);
        const f32x4 h0 = ((const f32x4*)sh)[ci], h1 = ((const f32x4*)sh)[ci + 1];
#pragma unroll
        for (int q = 0; q < 4; ++q) {
            const f32x4 y0 = v[4 * q + 2 * jj] * rs[q] * g0 + h0, y1 = v[4 * q + 2 * jj + 1] * rs[q] * g1 + h1;
            st16_wt(orow + (size_t)q * DM + 512 * jj + 8 * lane, (u32x4){pk2(y0[0], y0[1]), pk2(y0[2], y0[3]), pk2(y1[0], y1[1]), pk2(y1[2], y1[3])});
        }
    }
}
#define XB_TMO      128
#define XB_XCNT(j)  (256  + 64 * (j))
#define XB_XSUB(j)  (1280 + 64 * (j))
#define XB_XGEN(j)  (2304 + 64 * (j))
#define XB_TOP      3328
#define XB_TOPGEN   3392
#define XCD_BAR_WORDS 3456
#define XB_SPIN_CAP (1u << 18)
__device__ __forceinline__ unsigned xb_ld(unsigned* p)              { return __hip_atomic_load(p, __ATOMIC_RELAXED, __HIP_MEMORY_SCOPE_AGENT); }
__device__ __forceinline__ unsigned xb_add(unsigned* p, unsigned v) { return __hip_atomic_fetch_add(p, v, __ATOMIC_RELAXED, __HIP_MEMORY_SCOPE_AGENT); }
__device__ __forceinline__ unsigned xb_xcc_id() { return (unsigned)__builtin_amdgcn_s_getreg((3 << 11) | 20) & 0xFu; }
#define XB_SPIN(cond, bar) do { unsigned _sp = 0; while (cond) { __builtin_amdgcn_s_sleep(1); \
    if ((++_sp & 255u) == 0u) { if (xb_ld(&(bar)[XB_TMO])) break; if (_sp > XB_SPIN_CAP) { atomicAdd(&(bar)[XB_TMO], 1u); break; } } } } while (0)
struct XcdBarrier { unsigned* bar; unsigned x; volatile LAS unsigned* st; };
__device__ __forceinline__ XcdBarrier xcd_barrier_post(unsigned* bar, volatile LAS unsigned* st) {
    XcdBarrier b; b.bar = bar; b.x = xb_xcc_id(); b.st = st;
    if (threadIdx.x == 0) (void)xb_add(&bar[XB_XCNT(b.x)], 1u);
    return b;
}
__device__ __forceinline__ void xcd_barrier_complete(unsigned* bar, unsigned x, unsigned& nloc, unsigned& nx) {
    const unsigned G = gridDim.x * gridDim.y * gridDim.z;
    unsigned sum, cnt, mine, sp = 0u;
    for (;;) {
        sum = 0u; cnt = 0u; mine = 0u;
#pragma unroll
        for (unsigned j = 0; j < 16; ++j) { const unsigned c = xb_ld(&bar[XB_XCNT(j)]); sum += c; cnt += (c > 0u) ? 1u : 0u; mine = (j == x) ? c : mine; }
        if (sum == G) break;
        __builtin_amdgcn_s_sleep(1);
        if ((++sp & 255u) == 0u) { if (xb_ld(&bar[XB_TMO])) break; if (sp > XB_SPIN_CAP) { atomicAdd(&bar[XB_TMO], 1u); break; } }
    }
    nloc = mine > 0u ? mine : 1u; nx = cnt > 0u ? cnt : 1u;
}
__device__ __forceinline__ void xcd_barrier(const XcdBarrier& b) {
    asm volatile("s_waitcnt vmcnt(0)" ::: "memory");
    __syncthreads();
    if (threadIdx.x == 0) {
        unsigned* bar = b.bar;
        __builtin_amdgcn_s_waitcnt(0);
        unsigned nloc = b.st[0], nx = b.st[1];
        if (nloc == 0u) { xcd_barrier_complete(bar, b.x, nloc, nx); b.st[0] = nloc; b.st[1] = nx; }
        const unsigned old = xb_add(&bar[XB_XSUB(b.x)], 1u);
        const unsigned gen = old / nloc;
        if (old + 1u == (gen + 1u) * nloc) {
            __builtin_amdgcn_fence(__ATOMIC_RELEASE, "agent");
            asm volatile("s_waitcnt vmcnt(0)" ::: "memory");
            const unsigned og = xb_add(&bar[XB_TOP], 1u);
            const unsigned tg = og / nx;
            if (og + 1u == (tg + 1u) * nx) xb_add(&bar[XB_TOPGEN], 1u);
            else XB_SPIN(xb_ld(&bar[XB_TOPGEN]) == tg, bar);
            __builtin_amdgcn_fence(__ATOMIC_ACQUIRE, "agent");
            xb_add(&bar[XB_XGEN(b.x)], 1u);
            asm volatile("s_waitcnt vmcnt(0)" ::: "memory");
        } else {
            XB_SPIN(xb_ld(&bar[XB_XGEN(b.x)]) == gen, bar);
            __builtin_amdgcn_fence(__ATOMIC_ACQUIRE, "agent");
            asm volatile("s_waitcnt vmcnt(0)" ::: "memory");
        }
    }
    __syncthreads();
}

struct Args { const float* in[16]; float* out; unsigned char* ws; int ph_lo, ph_hi, pad0, pad1; };
constexpr int NPHASE = 10;

__global__ void __launch_bounds__(512, 2) fwd_megakernel(Args args) {
    extern __shared__ __attribute__((aligned(16))) unsigned char lds_raw[];
    LAS unsigned char* lds = (LAS unsigned char*)lds_raw;
    cg::grid_group grid = cg::this_grid();
    const int tid = threadIdx.x, lane = tid & 63, wave = __builtin_amdgcn_readfirstlane(tid >> 6);
    const int G = gridDim.x, bx = blockIdx.x;
    const int vcu = (G % 8 == 0) ? (bx % 8) * (G / 8) + bx / 8 : bx;
    const int gw = vcu * 8 + wave, NGW = G * 8;
    unsigned char* ws = args.ws;
    const float* x = args.in[0]; const float* cvec = args.in[1]; const float* w_ada = args.in[2]; const float* b_ada = args.in[3];
    const float* norm_mix_g = args.in[4]; const float* w_in = args.in[5]; const float* g_qa = args.in[6]; const float* w_qb = args.in[7];
    const float* g_kva = args.in[8]; const float* w_kvb = args.in[9]; const float* sinks = args.in[10]; const float* w_o = args.in[11];
    const float* norm_mlp_g = args.in[12]; const float* w_up = args.in[13]; const float* w_down = args.in[14]; const float* final_g = args.in[15];
    float* out = args.out;
    float* mod = (float*)(ws + WS_MOD); float* ssq_q = (float*)(ws + WS_SSQQ); float* ssq_kv = (float*)(ws + WS_SSQKV);
    float* ropec = (float*)(ws + WS_ROPE); float* ropes = ropec + SEQ * 16;
    bf16_t* win_t = (bf16_t*)(ws + WS_WIN); bf16_t* wqb_t = (bf16_t*)(ws + WS_WQB); bf16_t* wkvb_t = (bf16_t*)(ws + WS_WKVB);
    bf16_t* wo_t = (bf16_t*)(ws + WS_WO); bf16_t* wup_t = (bf16_t*)(ws + WS_WUP); bf16_t* wdn_t = (bf16_t*)(ws + WS_WDN);
    bf16_t* hbuf = (bf16_t*)(ws + WS_H); bf16_t* proj = (bf16_t*)(ws + WS_PROJ); bf16_t* qbuf = (bf16_t*)(ws + WS_Q); bf16_t* knope = (bf16_t*)(ws + WS_KN);
    bf16_t* vtm = (bf16_t*)(ws + WS_VTM); bf16_t* vts = (bf16_t*)(ws + WS_VTS); bf16_t* mix = (bf16_t*)(ws + WS_MIX); bf16_t* ubuf = (bf16_t*)(ws + WS_U); bf16_t* x1b = (bf16_t*)(ws + WS_X1);

    const TrSet TS{w_in, w_qb, w_kvb, w_o, w_up, w_down, g_qa, g_kva, win_t, wqb_t, wkvb_t, wo_t, wup_t, wdn_t};
    const int lo = args.ph_lo, hi = args.ph_hi;
    volatile LAS unsigned* bst = (volatile LAS unsigned*)(lds + 131072);
    if (tid < 2) bst[tid] = 0u;
    __syncthreads();
    XcdBarrier xbar; xbar.bar = (unsigned*)(ws + WS_BAR); xbar.x = 0; xbar.st = bst;
    if (hi - lo > 1) xbar = xcd_barrier_post((unsigned*)(ws + WS_BAR), bst);
    if (lo < 0) grid.sync();
#ifndef PH_MASK
#define PH_MASK 0x3ff
#endif
#define IN(k) (((PH_MASK >> (k)) & 1) && lo <= (k) && (k) < hi)
#define GSYNC() xcd_barrier(xbar)
#define SEAM2(k, k2) do { if (IN(k) && IN(k2)) GSYNC(); } while (0)
#define SEAM(k) SEAM2(k, (k) + 1)
#ifndef REPMASK
#define REPMASK 0
#endif
#ifndef REPN
#define REPN 3
#endif
#ifndef XSYNC
#define XSYNC 0
#endif
#ifndef TPROBE
#define TPROBE -1
#endif
#define STAMP(j) do { if (TPROBE >= 0 && bx == 0 && wave == 0) { if ((j) == TPROBE) tp0 = __builtin_amdgcn_s_memrealtime(); if ((j) == TPROBE + 1) tp1 = __builtin_amdgcn_s_memrealtime(); } } while (0)
#define REP(k) for (int rep_ = 0; rep_ < (((REPMASK >> (k)) & 1) ? REPN : 1); ++rep_)

    unsigned long long tp0 = 0, tp1 = 0;
    STAMP(0);
    const int pm_t = 8 * (bx & 7) + ((bx >> 3) & 7), mj = bx >> 6, bt = pm_t >> 3;
    const int rm0 = 256 * pm_t + 64 * mj + 8 * wave;
    if (IN(0)) {
        LAS float* scr = (LAS float*)(lds + wave * 16384);
        p0_mod_block(cvec, w_ada, b_ada, mod, lds, bx, tid);
        tr_run(TS, 0, NITEMS_EARLY, gw, NGW, scr, lane);
        const int gt = vcu * 512 + tid, NGT = G * 512;
        for (int i = gt; i < (NPROJ - IN_COLS) * DM / 8; i += NGT) ((u32x4*)(win_t + (size_t)IN_COLS * DM))[i] = (u32x4){0u, 0u, 0u, 0u};
        for (int i = gt; i < SEQ * 16; i += NGT) {
            const int pos = i >> 4, fi = i & 15;
            double f = (fi & 3) == 0 ? 1.0 : ((fi & 3) == 1 ? 0.5623413251903491 : ((fi & 3) == 2 ? 0.31622776601683794 : 0.1778279410038923));
            const int dec = fi >> 2; f *= (dec == 0 ? 1.0 : (dec == 1 ? 0.1 : (dec == 2 ? 0.01 : 0.001)));
            const float ang32 = (float)pos * (float)f;
            const double rev = (double)ang32 * 0.15915494309189535;
            const float fr = (float)(rev - __builtin_rint(rev));
            ropec[i] = __builtin_amdgcn_cosf(fr); ropes[i] = __builtin_amdgcn_sinf(fr);
        }
    }
    f32x4 rv[16], rvn[16];
    rows_load4(x, rm0, rv, lane); rows_load4(x, rm0 + 4, rvn, lane);
    SEAM(0);
    STAMP(1);
    for (int xs_ = 0; xs_ < XSYNC; ++xs_) GSYNC();
    if (IN(1)) {
        unsigned* tc = (unsigned*)(ws + WS_CNT) + 64 * pm_t;
        {
            rows_finish4(rv, hbuf + (size_t)rm0 * DM, norm_mix_g, mod + bt * 6144 + 1024, mod + bt * 6144, lane);
            rows_finish4(rvn, hbuf + (size_t)(rm0 + 4) * DM, norm_mix_g, mod + bt * 6144 + 1024, mod + bt * 6144, lane);
        }
        team_wait(tc + 4 * 64 * 64);
#pragma unroll 1
        for (int rnd = 0; rnd < 2; ++rnd) {
            if (rnd == 0 || mj < 2) {
                pg8::Gemm g{hbuf, win_t, MT, NPROJ, DM, DM}; const pg8::ListOrder S{pm_t, 1, rnd == 0 ? mj : 4 + mj, 0};
                EpiProj E{proj, ssq_q, ssq_kv, ropec, ropes, vts};
                pg8::gemm_phase<EpiProj, true, pg8::ListOrder>(lds, g, S, E);
            }
            if (rnd == 0) team_wait(tc + 5 * 64 * 64);
        }
        { pg8::Gemm g{proj, wqb_t, MT, QW, QL, NPROJ}; const pg8::ListOrder S{pm_t, mj == 2 ? 2 : (mj == 3 ? 1 : 0), mj == 2 ? 0 : 2, 1};
          EpiQ E{qbuf, ssq_q, ropec, ropes}; pg8::gemm_phase<EpiQ, true, pg8::ListOrder>(lds, g, S, E); }
        { pg8::Gemm g{proj + QL, wkvb_t, MT, KVW, KVL, NPROJ}; const pg8::ListOrder S{pm_t, mj == 3 ? 2 : (mj == 2 ? 0 : 1), mj == 3 ? 2 : mj, 3};
          EpiKV E{knope, vtm, ssq_kv}; pg8::gemm_phase<EpiKV, true, pg8::ListOrder>(lds, g, S, E); }
        if (mj < 3) {
            LAS float* scr = (LAS float*)(lds + wave * 16384);
            const int f0 = NITEMS_EARLY + 72 * pm_t + 24 * mj;
            tr_run(TS, f0, f0 + 24, wave, 8, scr, lane);
        }
    }
    STAMP(2); STAMP(3);
    SEAM2(1, 4);
    STAMP(4);
    REP(4) { if (rep_) GSYNC();
    if (IN(4)) {
        if (wave >= 4) __builtin_amdgcn_s_setprio(1);
        for (int it = vcu; it < 768; it += G) {
            if (it < 256) {
                const int b = it >> 5, h = (it >> 2) & 7, pp = it & 3;
#pragma unroll 1
                for (int k = 0; k < 2; ++k) {
                    const int qb = k == 0 ? 7 - pp : pp;
                    const size_t row0 = (size_t)b * SEQ + qb * 256;
                    attn_unit<96, 0>(lds, qbuf + row0 * QW + h * 96, QW, knope + (size_t)b * SEQ * 512 + h * 64, 512, proj + (size_t)b * SEQ * NPROJ + 640, NPROJ,
                                     vtm + (size_t)(b * 8 + h) * 64 * SEQ, mix + row0 * DM + h * 64, qb * 256, 0, 4 * qb + 3, 0.f, 0.f, tid, wave, lane);
                }
            } else {
                const int id = it - 256, b = id >> 6, hq = (id >> 3) & 7, qb = id & 7, kvh = hq >> 2;
                const size_t row0 = (size_t)b * SEQ + qb * 256;
                const float slope2 = exp2f(-(float)(hq + 1)) * LOG2E, sink2 = sinks[hq] * LOG2E;
                attn_unit<64, 1>(lds, proj + row0 * NPROJ + 672 + hq * 64, NPROJ, proj + (size_t)b * SEQ * NPROJ + 1184 + kvh * 64, NPROJ, nullptr, 0,
                                 vts + (size_t)(b * 2 + kvh) * 64 * SEQ, mix + row0 * DM + 512 + hq * 64, qb * 256, qb == 0 ? 0 : 4 * qb - 2, 4 * qb + 3, slope2, sink2, tid, wave, lane);
            }
        }
        __builtin_amdgcn_s_setprio(0);
        __syncthreads();
    }
    }
    SEAM(4);
    STAMP(5);
    if (IN(5)) {
        pg8::Gemm g{mix, wo_t, MT, DM, DM, DM}; pg8::StaticOrder S; S.init(MT, DM, G, bx);
        EpiResNorm E{x, x1b, hbuf, mod, norm_mlp_g, PanelX{(float*)(ws + WS_SSQX1), (unsigned*)(ws + WS_CNT)}};
        pg8::gemm_phase<EpiResNorm, false>(lds, g, S, E);
    }
    if (IN(5) && IN(7)) { pg8::StaticOrder S; S.init(MT, DM, G, bx); pg8::Unit u; S.next(0, u); team_wait((unsigned*)(ws + WS_CNT) + 2 * 64 * 64 + 64 * u.pm); }
    STAMP(6);
    REP(7) { if (rep_) GSYNC();
    if (IN(7)) {
        pg8::Gemm g{hbuf, wup_t, MT, FF, DM, DM}; pg8::StaticOrder S; S.init(MT, FF, G, bx);
        EpiUp E{ubuf};
        pg8::gemm_phase<EpiUp, false>(lds, g, S, E);
    }
    }
    if (IN(7) && IN(8)) { pg8::StaticOrder S; S.init(MT, DM, G, bx); pg8::Unit u; S.next(0, u); team_wait((unsigned*)(ws + WS_CNT) + 3 * 64 * 64 + 64 * u.pm); }
    STAMP(7);
    if (IN(8)) {
        pg8::Gemm g{ubuf, wdn_t, MT, DM, FF, FF}; pg8::StaticOrder S; S.init(MT, DM, G, bx);
        EpiResFinal E{x1b, out, mod, final_g, PanelX{(float*)(ws + WS_SSQX2), (unsigned*)(ws + WS_CNT) + 64 * 64}};
        pg8::gemm_phase<EpiResFinal, false>(lds, g, S, E);
    }
    STAMP(8);
    if (TPROBE >= 0 && bx == 0 && wave == 0) { const unsigned long long tgt = __builtin_amdgcn_s_memrealtime() + 4ull * (tp1 - tp0); while (__builtin_amdgcn_s_memrealtime() < tgt) __builtin_amdgcn_s_sleep(8); }
#undef IN
#undef SEAM
}

extern "C" void kernel_launch(void* const* d_in, const int* in_sizes, int n_in, void* d_out, int out_size, void* d_ws, size_t ws_size, hipStream_t stream) {
    static int grid = 0;
    if (grid == 0) {
        if (n_in != 16 || out_size != MT * DM || ws_size < WS_END) { fprintf(stderr, "kernel_launch: unexpected shapes (n_in %d out %d ws %zu)\n", n_in, out_size, ws_size); grid = -1; return; }
        int dev = 0, cus = 0, per_cu = 0;
        hipGetDevice(&dev);
        hipDeviceGetAttribute(&cus, hipDeviceAttributeMultiprocessorCount, dev);
        if (hipFuncSetAttribute((const void*)fwd_megakernel, hipFuncAttributeMaxDynamicSharedMemorySize, LDS_BYTES) != hipSuccess) { fprintf(stderr, "kernel_launch: hipFuncSetAttribute failed\n"); }
        if (hipOccupancyMaxActiveBlocksPerMultiprocessor(&per_cu, (const void*)fwd_megakernel, 512, LDS_BYTES) != hipSuccess || per_cu < 1) { fprintf(stderr, "kernel_launch: occupancy query says %d\n", per_cu); per_cu = 1; }
        (void)hipGetLastError();
        grid = cus * per_cu;
        if (grid != 256) { fprintf(stderr, "kernel_launch: this kernel needs exactly 256 co-resident workgroups (one per CU), got %d\n", grid); grid = -1; return; }
    }
    if (grid < 0) return;
    hipMemsetAsync((char*)d_ws, 0, WS_ZERO_BYTES, stream);
    Args a{};
    for (int i = 0; i < 16; ++i) a.in[i] = (const float*)d_in[i];
    a.out = (float*)d_out; a.ws = (unsigned char*)d_ws;
#if MK_PER_PHASE
    for (int p = 0; p < NPHASE; ++p) {
        a.ph_lo = p; a.ph_hi = p + 1;
        hipLaunchKernelGGL(fwd_megakernel, dim3(grid), dim3(512), LDS_BYTES, stream, a);
    }
#else
    a.ph_lo = 0; a.ph_hi = NPHASE;
    void* kargs[] = {&a};
    hipError_t e = hipLaunchCooperativeKernel((const void*)fwd_megakernel, dim3(grid), dim3(512), kargs, LDS_BYTES, stream);
    if (e != hipSuccess) fprintf(stderr, "cooperative launch failed: %s (grid %d)\n", hipGetErrorString(e), grid);
#endif
}
```

```cpp
#include <hip/hip_runtime.h>
#include <hip/hip_cooperative_groups.h>
#include <cstdio>
#include <cstdint>
namespace cg = cooperative_groups;

#define LAS __attribute__((address_space(3)))
typedef unsigned short bf16_t;
typedef short bf16x8 __attribute__((ext_vector_type(8)));
typedef short s16x4 __attribute__((ext_vector_type(4)));
typedef float f32x4 __attribute__((ext_vector_type(4)));
typedef float f32x2 __attribute__((ext_vector_type(2)));
typedef float f32x16 __attribute__((ext_vector_type(16)));
typedef unsigned u32x4 __attribute__((ext_vector_type(4)));
typedef unsigned u32x2 __attribute__((ext_vector_type(2)));
typedef __bf16 bf2_t __attribute__((ext_vector_type(2)));

#ifndef MK_PER_PHASE
#define MK_PER_PHASE 0
#endif

constexpr int NB = 8, SEQ = 2048, DM = 1024, MT = NB * SEQ, FF = 4096;
constexpr int NPROJ = 1536, IN_COLS = 1440;
constexpr int QL = 384, KVL = 256;
constexpr int QW = 768, KVW = 1024;
constexpr float EPS = 1e-6f;
constexpr float LOG2E = 1.4426950408889634f;
constexpr float QSC_MLA = 0.10206207261596575f * LOG2E;
constexpr float QSC_SWA = 0.125f * LOG2E;

constexpr size_t MiB = 1u << 20;
constexpr size_t WS_MOD = 0, WS_SSQQ = 256 * 1024, WS_SSQKV = 320 * 1024, WS_BAR = 384 * 1024, WS_SSQX1 = 400 * 1024, WS_SSQX2 = 464 * 1024, WS_CNT = 528 * 1024, WS_ZERO_BYTES = 624 * 1024;
constexpr size_t WS_ROPE = 1 * MiB;
constexpr size_t WS_WIN = 2 * MiB, WS_WQB = 5 * MiB, WS_WKVB = 6 * MiB, WS_WO = 7 * MiB, WS_WUP = 9 * MiB, WS_WDN = 17 * MiB;
constexpr size_t WS_H = 25 * MiB, WS_PROJ = 57 * MiB, WS_Q = 105 * MiB, WS_KN = 129 * MiB, WS_VTM = 145 * MiB, WS_VTS = 161 * MiB, WS_MIX = 185 * MiB;
constexpr size_t WS_U = 57 * MiB;
constexpr size_t WS_X1 = 217 * MiB;
constexpr size_t WS_END = 249 * MiB;
constexpr int LDS_BYTES = 131072 + 256;

__device__ __forceinline__ unsigned pk2(float lo, float hi) { f32x2 v = {lo, hi}; bf2_t r = __builtin_convertvector(v, bf2_t); return __builtin_bit_cast(unsigned, r); }
__device__ __forceinline__ bf16_t f2bf(float f) { return (bf16_t)(pk2(f, 0.f) & 0xffffu); }
__device__ __forceinline__ void st16_wt(void* p, u32x4 v) { asm volatile("global_store_dwordx4 %0, %1, off sc1\n\ts_nop 1" :: "v"(p), "v"(v) : "memory"); }
__device__ __forceinline__ void team_wait(unsigned* cnt) {
    asm volatile("s_waitcnt vmcnt(0)" ::: "memory");
    __syncthreads();
    if (threadIdx.x == 0) {
        __hip_atomic_fetch_add(cnt, 1u, __ATOMIC_RELAXED, __HIP_MEMORY_SCOPE_AGENT);
        unsigned sp = 0;
        while (__hip_atomic_load(cnt, __ATOMIC_RELAXED, __HIP_MEMORY_SCOPE_AGENT) < 4u) { __builtin_amdgcn_s_sleep(1); if (++sp > (1u << 22)) break; }
        __builtin_amdgcn_fence(__ATOMIC_ACQUIRE, "agent");
        asm volatile("s_waitcnt vmcnt(0)" ::: "memory");
    }
    __syncthreads();
}
__device__ __forceinline__ float wave_sum(float v) {
#pragma unroll
    for (int o = 1; o < 64; o <<= 1) v += __shfl_xor(v, o);
    return v;
}

namespace pg8 {
constexpr int BM = 256, BK = 64, HALF = 128, HTB = HALF * BK * 2, STAGE_BYTES = 8 * HTB, NXCD = 8, WGM = 8;
__host__ __device__ __forceinline__ int lds_byte(int r, int c) { const int st = (r >> 4) * 2 + (c >> 5), rr = r & 15, cc = c & 31, ob = rr * 64 + cc * 2; return st * 1024 + (ob ^ (((ob >> 9) & 1) << 5)); }
__host__ __device__ __forceinline__ void stage_rc(int b, int& R, int& C) { const int st = b / 1024, sb = b % 1024, swz = sb ^ (((sb >> 9) & 1) << 5); R = (st >> 1) * 16 + swz / 64; C = (st & 1) * 32 + (swz % 64) / 2; }
__host__ __device__ __forceinline__ int perm32(int rho) { const int n = rho >> 4, i = rho & 15; return 8 * (i >> 2) + 4 * n + (i & 3); }

struct Unit { int pm, pn; };
struct Gemm { const bf16_t* A; const bf16_t* Bt; int M, N, K, lda; };

struct StaticOrder {
    int nM, nN, nwg, G, c;
    __device__ void init(int M, int N, int G_, int c_) { nM = M / BM; nN = N / BM; nwg = nM * nN; G = G_; c = c_; }
    __device__ bool next(int i, Unit& u) const {
        const long L = (long)i * G + c; if (L >= nwg) return false;
        int wgid = (int)L; { const int q = nwg / NXCD, r = nwg % NXCD, xcd = wgid % NXCD, off = wgid / NXCD; wgid = (xcd < r ? xcd * (q + 1) : r * (q + 1) + (xcd - r) * q) + off; }
        const int nig = WGM * nN, gid = wgid / nig, fm = gid * WGM, gsz = (nM - fm) < WGM ? (nM - fm) : WGM;
        u.pm = fm + ((wgid % nig) % gsz); u.pn = (wgid % nig) / gsz; return true;
    }
};

struct ListOrder {
    int pm, n, p0, p1;
    __device__ bool next(int i, Unit& u) const { if (i >= n) return false; u.pm = pm; u.pn = (i == 0) ? p0 : p1; return true; }
};
template <class Epi, bool ALIGN_EPI, class Sched = StaticOrder>
__device__ __forceinline__ void gemm_phase(LAS unsigned char* lds, const Gemm g, const Sched& S, const Epi& E) {
    const int tid = threadIdx.x, wid = __builtin_amdgcn_readfirstlane(tid >> 6), lane = tid & 63, wr = wid >> 2, wc = wid & 3, fr = lane & 15, fq = lane >> 4;
    const int K = g.K, nt = K / BK, lda = g.lda;
    unsigned voffA[2], voffB[2];
#pragma unroll
    for (int i = 0; i < 2; ++i) { int R, C; stage_rc(tid * 16 + i * 8192, R, C); const int Rb = Epi::PERM ? ((R & ~31) + perm32(R & 31)) : R;
        voffA[i] = (unsigned)(R * lda + C) * 2u; voffB[i] = (unsigned)(Rb * K + C) * 2u; }
    const size_t kstep = (size_t)(BK * 2);
    const size_t hstepA = (size_t)HALF * lda * 2, hstepB = (size_t)HALF * K * 2;
    const size_t tstepA = 2 * hstepA, tstepB = 2 * hstepB;
    const unsigned ldsw = (unsigned)wid * 1024u;
    const int aoff = lds_byte(wr * 64 + fr, fq * 8), boff = lds_byte(wc * 32 + fr, fq * 8);
#define PG8_SA(b, h) (((b) * 2 + (h)) * HTB)
#define PG8_SB(b, h) ((4 + (b) * 2 + (h)) * HTB)
#define PG8_STAGE(bufoff, gbase, voff) do { _Pragma("unroll") for (int _i = 0; _i < 2; ++_i) \
        __builtin_amdgcn_global_load_lds((const unsigned*)((const char*)(gbase) + (voff)[_i]), (LAS unsigned*)(lds + (bufoff) + ldsw + _i * 8192), 16, 0, 0); } while (0)
#define PG8_LDA(dst, b, h) do { _Pragma("unroll") for (int m = 0; m < 4; ++m) _Pragma("unroll") for (int k = 0; k < 2; ++k) dst[m][k] = *(const LAS bf16x8*)(lds + PG8_SA(b, h) + aoff + m * 2048 + k * 1024); } while (0)
#define PG8_LDB(dst, b, h) do { _Pragma("unroll") for (int n = 0; n < 2; ++n) _Pragma("unroll") for (int k = 0; k < 2; ++k) dst[n][k] = *(const LAS bf16x8*)(lds + PG8_SB(b, h) + boff + n * 2048 + k * 1024); } while (0)
#define PG8_MMA(ai, bj, At, Bt) do { __builtin_amdgcn_s_setprio(1); _Pragma("unroll") for (int m = 0; m < 4; ++m) _Pragma("unroll") for (int n = 0; n < 2; ++n) _Pragma("unroll") for (int k = 0; k < 2; ++k) \
        acc[ai][bj][m][n] = __builtin_amdgcn_mfma_f32_16x16x32_bf16(Bt[n][k], At[m][k], acc[ai][bj][m][n], 0, 0, 0); __builtin_amdgcn_s_setprio(0); } while (0)
#define PG8_WAIT_V(n) asm volatile("s_waitcnt vmcnt(" #n ")" ::: "memory")
#define PG8_WAIT_L(n) asm volatile("s_waitcnt lgkmcnt(" #n ")" ::: "memory")
#define PG8_BAR __builtin_amdgcn_s_barrier()
#define PG8_SCHED __builtin_amdgcn_sched_barrier(0)
    Unit cur, nxt; int ui = 0;
    if (!S.next(0, cur)) return;
    f32x4 acc[2][2][4][2];
#pragma unroll
    for (int a = 0; a < 2; ++a)
#pragma unroll
        for (int b = 0; b < 2; ++b)
#pragma unroll
            for (int m = 0; m < 4; ++m)
#pragma unroll
                for (int n = 0; n < 2; ++n) acc[a][b][m][n] = (f32x4){0.f, 0.f, 0.f, 0.f};
    bf16x8 At[4][2], B0[2][2], B1[2][2];
    const char* cA = (const char*)g.A + (size_t)cur.pm * tstepA; const char* cB = (const char*)g.Bt + (size_t)cur.pn * tstepB;
    {
        PG8_STAGE(PG8_SB(0, 0), cB, voffB); PG8_STAGE(PG8_SB(0, 1), cB + hstepB, voffB); PG8_STAGE(PG8_SA(0, 0), cA, voffA); PG8_STAGE(PG8_SA(0, 1), cA + hstepA, voffA);
        if (wr == 1) PG8_BAR;
        PG8_WAIT_V(2); PG8_BAR;
        PG8_STAGE(PG8_SB(1, 0), cB + kstep, voffB); PG8_STAGE(PG8_SA(1, 0), cA + kstep, voffA); PG8_STAGE(PG8_SB(1, 1), cB + hstepB + kstep, voffB);
        PG8_WAIT_V(6); PG8_BAR;
    }
    for (;;) {
        const bool has_next = S.next(ui + 1, nxt);
        const char* nA = has_next ? (const char*)g.A + (size_t)nxt.pm * tstepA : cA; const char* nB = has_next ? (const char*)g.Bt + (size_t)nxt.pn * tstepB : cB;
#pragma unroll 1
        for (int t = 0; t < nt; t += 2) {
            const bool last = (t == nt - 2);
            const char* a1 = cA + (size_t)(t + 1) * kstep;
            const char* a2 = last ? nA : cA + (size_t)(t + 2) * kstep; const char* b2 = last ? nB : cB + (size_t)(t + 2) * kstep;
            const char* a3 = a2 + kstep; const char* b3 = b2 + kstep;
            PG8_LDB(B0, 0, 0); PG8_LDB(B1, 0, 1); PG8_SCHED; PG8_LDA(At, 0, 0); PG8_STAGE(PG8_SA(1, 1), a1 + hstepA, voffA);
            PG8_WAIT_V(8); PG8_WAIT_L(0); PG8_BAR; PG8_MMA(0, 0, At, B0); PG8_MMA(0, 1, At, B1); PG8_BAR; PG8_SCHED;
            PG8_LDA(At, 0, 1); PG8_STAGE(PG8_SB(0, 0), b2, voffB); PG8_STAGE(PG8_SB(0, 1), b2 + hstepB, voffB); PG8_STAGE(PG8_SA(0, 0), a2, voffA);
            PG8_WAIT_V(8); PG8_WAIT_L(0); PG8_BAR; PG8_MMA(1, 0, At, B0); PG8_MMA(1, 1, At, B1); PG8_BAR; PG8_SCHED;
            PG8_LDB(B0, 1, 0); PG8_LDB(B1, 1, 1); PG8_SCHED; PG8_LDA(At, 1, 0); PG8_STAGE(PG8_SA(0, 1), a2 + hstepA, voffA);
            PG8_WAIT_V(8); PG8_WAIT_L(0); PG8_BAR; PG8_MMA(0, 0, At, B0); PG8_MMA(0, 1, At, B1); PG8_BAR; PG8_SCHED;
            PG8_LDA(At, 1, 1); PG8_STAGE(PG8_SB(1, 0), b3, voffB); PG8_STAGE(PG8_SB(1, 1), b3 + hstepB, voffB); PG8_STAGE(PG8_SA(1, 0), a3, voffA);
            PG8_WAIT_V(8); PG8_WAIT_L(0); PG8_BAR; PG8_MMA(1, 0, At, B0); PG8_MMA(1, 1, At, B1); PG8_BAR; PG8_SCHED;
        }
        if constexpr (ALIGN_EPI) { if (wr == 0) PG8_BAR; }
        if constexpr (!Epi::AFTER_DRAIN) E(acc, cur, wr, wc, fr, fq);
        if (!has_next) break;
#pragma unroll
        for (int a = 0; a < 2; ++a)
#pragma unroll
            for (int b = 0; b < 2; ++b)
#pragma unroll
                for (int m = 0; m < 4; ++m)
#pragma unroll
                    for (int n = 0; n < 2; ++n) acc[a][b][m][n] = (f32x4){0.f, 0.f, 0.f, 0.f};
        cur = nxt; cA = nA; cB = nB; ++ui;
        if constexpr (ALIGN_EPI) { if (wr == 1) PG8_BAR; }
    }
    PG8_WAIT_V(0);
    if constexpr (!ALIGN_EPI) { if (wr == 0) PG8_BAR; }
    PG8_BAR;
    if constexpr (Epi::AFTER_DRAIN) E.fused(acc, cur, wr, wc, fr, fq);
#undef PG8_SA
#undef PG8_SB
#undef PG8_STAGE
#undef PG8_LDA
#undef PG8_LDB
#undef PG8_MMA
#undef PG8_WAIT_V
#undef PG8_WAIT_L
#undef PG8_BAR
#undef PG8_SCHED
}
}


struct EpiProj {
    static constexpr bool PERM = true, AFTER_DRAIN = false;
    bf16_t* P; float* ssq_q; float* ssq_kv; const float* ropec; const float* ropes; bf16_t* vts;
    __device__ __forceinline__ void operator()(const f32x4 (&acc)[2][2][4][2], const pg8::Unit& u, int wr, int wc, int fr, int fq) const {
        const int row0 = u.pm * 256 + wr * 64 + fr;
#pragma unroll
        for (int bj = 0; bj < 2; ++bj) {
            const int cgp = u.pn * 2 + bj;
            const int col = cgp * 128 + wc * 32 + 8 * fq;
            const bool is_q = cgp < 3, is_kv = (cgp == 3 || cgp == 4), is_kpe = (cgp == 5 && wc == 0);
            const bool is_swaq = (cgp == 5 && wc >= 1) || (cgp >= 6 && cgp <= 8) || (cgp == 9 && wc == 0);
            const bool is_swav = (cgp == 10 && wc >= 1) || (cgp == 11 && wc == 0);
#pragma unroll
            for (int ai = 0; ai < 2; ++ai)
#pragma unroll
                for (int m = 0; m < 4; ++m) {
                    const int row = row0 + ai * 128 + m * 16;
                    f32x4 v0 = acc[ai][bj][m][0], v1 = acc[ai][bj][m][1];
                    if (is_q || is_kv) {
                        float s = (v0[0] * v0[0] + v0[1] * v0[1]) + (v0[2] * v0[2] + v0[3] * v0[3]) + (v1[0] * v1[0] + v1[1] * v1[1]) + (v1[2] * v1[2] + v1[3] * v1[3]);
                        s += __shfl_xor(s, 16); s += __shfl_xor(s, 32);
                        if (fq == 0) unsafeAtomicAdd((is_q ? ssq_q : ssq_kv) + row, s);
                    }
                    if (is_kpe) {
                        f32x4 p0, p1;
#pragma unroll
                        for (int j = 0; j < 4; ++j) { p0[j] = __shfl_xor(v0[j], 32); p1[j] = __shfl_xor(v1[j], 32); }
                        const int pos = row & (SEQ - 1), i0 = (8 * fq) & 15;
                        const f32x4 c0 = *(const f32x4*)(ropec + pos * 16 + i0), c1 = *(const f32x4*)(ropec + pos * 16 + i0 + 4);
                        const f32x4 s0 = *(const f32x4*)(ropes + pos * 16 + i0), s1 = *(const f32x4*)(ropes + pos * 16 + i0 + 4);
                        const float sg = fq < 2 ? -1.f : 1.f;
                        v0 = v0 * c0 + p0 * s0 * sg; v1 = v1 * c1 + p1 * s1 * sg;
                    }
                    if (is_swaq) { v0 = v0 * QSC_SWA; v1 = v1 * QSC_SWA; }
                    u32x4 w; w.x = pk2(v0[0], v0[1]); w.y = pk2(v0[2], v0[3]); w.z = pk2(v1[0], v1[1]); w.w = pk2(v1[2], v1[3]);
                    st16_wt(P + (size_t)row * NPROJ + col, w);
                    if (is_swav) {
                        const int d = col - 1312, kvh = d >> 6, dd = d & 63, b = row >> 11, s = row & (SEQ - 1);
                        bf16_t* base = vts + ((size_t)((b * 2 + kvh) * 64 + dd)) * SEQ + s;
                        base[0 * SEQ] = (bf16_t)(w.x & 0xffffu); base[1 * SEQ] = (bf16_t)(w.x >> 16);
                        base[2 * SEQ] = (bf16_t)(w.y & 0xffffu); base[3 * SEQ] = (bf16_t)(w.y >> 16);
                        base[4 * SEQ] = (bf16_t)(w.z & 0xffffu); base[5 * SEQ] = (bf16_t)(w.z >> 16);
                        base[6 * SEQ] = (bf16_t)(w.w & 0xffffu); base[7 * SEQ] = (bf16_t)(w.w >> 16);
                    }
                }
        }
    }
};
struct EpiQ {
    static constexpr bool PERM = true, AFTER_DRAIN = false;
    bf16_t* Q; const float* ssq_q; const float* ropec; const float* ropes;
    __device__ __forceinline__ void operator()(const f32x4 (&acc)[2][2][4][2], const pg8::Unit& u, int wr, int wc, int fr, int fq) const {
        const int row0 = u.pm * 256 + wr * 64 + fr;
        const int i0 = (8 * fq) & 15; const float sg = fq < 2 ? -1.f : 1.f;
#pragma unroll
        for (int ai = 0; ai < 2; ++ai)
#pragma unroll
            for (int m = 0; m < 4; ++m) {
                const int row = row0 + ai * 128 + m * 16, pos = row & (SEQ - 1);
                const float rs = __builtin_amdgcn_rsqf(__hip_atomic_load(ssq_q + row, __ATOMIC_RELAXED, __HIP_MEMORY_SCOPE_AGENT) * (1.0f / QL) + EPS) * QSC_MLA;
#pragma unroll
                for (int bj = 0; bj < 2; ++bj) {
                    const int G = u.pn * 8 + bj * 4 + wc;
                    f32x4 v0 = acc[ai][bj][m][0] * rs, v1 = acc[ai][bj][m][1] * rs;
                    if ((G % 3) == 2) {
                        f32x4 p0, p1;
#pragma unroll
                        for (int j = 0; j < 4; ++j) { p0[j] = __shfl_xor(v0[j], 32); p1[j] = __shfl_xor(v1[j], 32); }
                        const f32x4 c0 = *(const f32x4*)(ropec + pos * 16 + i0), c1 = *(const f32x4*)(ropec + pos * 16 + i0 + 4);
                        const f32x4 s0 = *(const f32x4*)(ropes + pos * 16 + i0), s1 = *(const f32x4*)(ropes + pos * 16 + i0 + 4);
                        v0 = v0 * c0 + p0 * s0 * sg; v1 = v1 * c1 + p1 * s1 * sg;
                    }
                    *(u32x4*)(Q + (size_t)row * QW + G * 32 + 8 * fq) = (u32x4){pk2(v0[0], v0[1]), pk2(v0[2], v0[3]), pk2(v1[0], v1[1]), pk2(v1[2], v1[3])};
                }
                asm volatile("" ::: "memory");
            }
    }
};
struct EpiKV {
    static constexpr bool PERM = false, AFTER_DRAIN = false;
    bf16_t* KN; bf16_t* VT; const float* ssq_kv;
    __device__ __forceinline__ void operator()(const f32x4 (&acc)[2][2][4][2], const pg8::Unit& u, int wr, int wc, int fr, int fq) const {
        const int row0 = u.pm * 256 + wr * 64 + fr;
#pragma unroll
        for (int ai = 0; ai < 2; ++ai)
#pragma unroll
            for (int m = 0; m < 4; ++m) {
                const int row = row0 + ai * 128 + m * 16, b = row >> 11, s = row & (SEQ - 1);
                const float rs = __builtin_amdgcn_rsqf(__hip_atomic_load(ssq_kv + row, __ATOMIC_RELAXED, __HIP_MEMORY_SCOPE_AGENT) * (1.0f / KVL) + EPS);
#pragma unroll
                for (int bj = 0; bj < 2; ++bj) {
                    const int head = u.pn * 2 + bj;
                    const f32x4 x1 = acc[ai][bj][m][0] * rs, x2 = acc[ai][bj][m][1] * rs;
                    const unsigned a0 = pk2(x1[0], x1[1]), a1 = pk2(x1[2], x1[3]), b0 = pk2(x2[0], x2[1]), b1 = pk2(x2[2], x2[3]);
                    if (wc < 2) {
                        bf16_t* p = KN + (size_t)row * 512 + head * 64 + wc * 32 + 4 * fq;
                        *(u32x2*)p = (u32x2){a0, a1}; *(u32x2*)(p + 16) = (u32x2){b0, b1};
                    } else {
                        bf16_t* base = VT + ((size_t)((b * 8 + head) * 64 + (wc - 2) * 32 + 4 * fq)) * SEQ + s;
                        base[0 * SEQ] = (bf16_t)(a0 & 0xffffu); base[1 * SEQ] = (bf16_t)(a0 >> 16); base[2 * SEQ] = (bf16_t)(a1 & 0xffffu); base[3 * SEQ] = (bf16_t)(a1 >> 16);
                        base[16 * SEQ] = (bf16_t)(b0 & 0xffffu); base[17 * SEQ] = (bf16_t)(b0 >> 16); base[18 * SEQ] = (bf16_t)(b1 & 0xffffu); base[19 * SEQ] = (bf16_t)(b1 >> 16);
                    }
                }
                asm volatile("" ::: "memory");
            }
    }
};
struct EpiRes {
    static constexpr bool PERM = false, AFTER_DRAIN = false;
    const float* base; float* out; const float* gate;
    __device__ __forceinline__ void operator()(const f32x4 (&acc)[2][2][4][2], const pg8::Unit& u, int wr, int wc, int fr, int fq) const {
        const int row0 = u.pm * 256 + wr * 64 + fr, b = u.pm >> 3;
#pragma unroll
        for (int bj = 0; bj < 2; ++bj)
#pragma unroll
            for (int n = 0; n < 2; ++n) {
                const int col = u.pn * 256 + bj * 128 + wc * 32 + n * 16 + 4 * fq;
                const f32x4 gv = *(const f32x4*)(gate + b * 6144 + col);
#pragma unroll
                for (int ai = 0; ai < 2; ++ai)
#pragma unroll
                    for (int m = 0; m < 4; ++m) {
                        const size_t off = (size_t)(row0 + ai * 128 + m * 16) * DM + col;
                        const f32x4 bs = *(const f32x4*)(base + off);
                        *(f32x4*)(out + off) = bs + gv * acc[ai][bj][m][n];
                    }
            }
    }
};
struct EpiUp {
    static constexpr bool PERM = true, AFTER_DRAIN = false;
    bf16_t* U;
    __device__ __forceinline__ void operator()(const f32x4 (&acc)[2][2][4][2], const pg8::Unit& u, int wr, int wc, int fr, int fq) const {
        const int row0 = u.pm * 256 + wr * 64 + fr, col0 = u.pn * 256 + wc * 32 + 8 * fq;
#pragma unroll
        for (int ai = 0; ai < 2; ++ai)
#pragma unroll
            for (int m = 0; m < 4; ++m) {
                bf16_t* rowp = U + (size_t)(row0 + ai * 128 + m * 16) * FF + col0;
#pragma unroll
                for (int bj = 0; bj < 2; ++bj) {
                    f32x4 v0 = acc[ai][bj][m][0], v1 = acc[ai][bj][m][1];
#pragma unroll
                    for (int j = 0; j < 4; ++j) { const float a = fmaxf(v0[j], 0.f), c = fmaxf(v1[j], 0.f); v0[j] = a * a; v1[j] = c * c; }
                    u32x4 w; w.x = pk2(v0[0], v0[1]); w.y = pk2(v0[2], v0[3]); w.z = pk2(v1[0], v1[1]); w.w = pk2(v1[2], v1[3]);
                    st16_wt(rowp + bj * 128, w);
                }
            }
    }
};


struct PanelX {
    float* ssq; unsigned* cnt;
    __device__ __forceinline__ void exchange(const f32x4 (&v)[2][2][4][2], const pg8::Unit& u, int wr, int fr, int fq) const {
        const int row0 = u.pm * 256 + wr * 64 + fr;
#pragma unroll
        for (int ai = 0; ai < 2; ++ai)
#pragma unroll
            for (int m = 0; m < 4; ++m) {
                float s = 0.f;
#pragma unroll
                for (int bj = 0; bj < 2; ++bj)
#pragma unroll
                    for (int n = 0; n < 2; ++n) { const f32x4 x = v[ai][bj][m][n]; s += (x[0] * x[0] + x[1] * x[1]) + (x[2] * x[2] + x[3] * x[3]); }
                s += __shfl_xor(s, 16); s += __shfl_xor(s, 32);
                if (fq == 0) unsafeAtomicAdd(ssq + row0 + ai * 128 + m * 16, s);
            }
        asm volatile("s_waitcnt vmcnt(0)" ::: "memory");
        __syncthreads();
        if (threadIdx.x == 0) {
            unsigned* c = cnt + 64 * u.pm;
            __builtin_amdgcn_fence(__ATOMIC_RELEASE, "agent");
            __hip_atomic_fetch_add(c, 1u, __ATOMIC_RELAXED, __HIP_MEMORY_SCOPE_AGENT);
            unsigned sp = 0;
            while (__hip_atomic_load(c, __ATOMIC_RELAXED, __HIP_MEMORY_SCOPE_AGENT) < 4u) { __builtin_amdgcn_s_sleep(1); if (++sp > (1u << 22)) break; }
            __builtin_amdgcn_fence(__ATOMIC_ACQUIRE, "agent");
        }
        __syncthreads();
    }
    __device__ __forceinline__ float rstd(int row) const { return __builtin_amdgcn_rsqf(__hip_atomic_load(ssq + row, __ATOMIC_RELAXED, __HIP_MEMORY_SCOPE_AGENT) * (1.0f / DM) + EPS); }
};
struct EpiResNorm {
    static constexpr bool PERM = true, AFTER_DRAIN = true;
    const float* base; bf16_t* X1; bf16_t* H; const float* mod; const float* g; PanelX px;
    __device__ __forceinline__ void fused(f32x4 (&acc)[2][2][4][2], const pg8::Unit& u, int wr, int wc, int fr, int fq) const {
        const int row0 = u.pm * 256 + wr * 64 + fr, b = u.pm >> 3, col0 = u.pn * 256 + wc * 32 + 8 * fq;
        const float* mb = mod + b * 6144 + col0;
        {
            f32x4 gv[2][2];
#pragma unroll
            for (int bj = 0; bj < 2; ++bj)
#pragma unroll
                for (int n = 0; n < 2; ++n) gv[bj][n] = *(const f32x4*)(mb + 2 * 1024 + bj * 128 + n * 4);
#pragma unroll
            for (int ai = 0; ai < 2; ++ai)
#pragma unroll
                for (int m = 0; m < 4; ++m) {
                    const size_t off = (size_t)(row0 + ai * 128 + m * 16) * DM + col0;
                    const float* bp = base + off; bf16_t* op = X1 + off;
#pragma unroll
                    for (int bj = 0; bj < 2; ++bj) {
                        const f32x4 v0 = *(const f32x4*)(bp + bj * 128) + gv[bj][0] * acc[ai][bj][m][0], v1 = *(const f32x4*)(bp + bj * 128 + 4) + gv[bj][1] * acc[ai][bj][m][1];
                        acc[ai][bj][m][0] = v0; acc[ai][bj][m][1] = v1;
                        *(u32x4*)(op + bj * 128) = (u32x4){pk2(v0[0], v0[1]), pk2(v0[2], v0[3]), pk2(v1[0], v1[1]), pk2(v1[2], v1[3])};
                    }
                    if (m & 1) asm volatile("" ::: "memory");
                }
        }
        px.exchange(acc, u, wr, fr, fq);
        int row0b = row0; asm volatile("" : "+v"(row0b));
        {
            f32x4 gs[2][2], sh[2][2];
#pragma unroll
            for (int bj = 0; bj < 2; ++bj)
#pragma unroll
                for (int n = 0; n < 2; ++n) {
                    gs[bj][n] = *(const f32x4*)(g + col0 + bj * 128 + n * 4) * (*(const f32x4*)(mb + 4 * 1024 + bj * 128 + n * 4) + 1.0f);
                    sh[bj][n] = *(const f32x4*)(mb + 3 * 1024 + bj * 128 + n * 4);
                }
#pragma unroll
            for (int ai = 0; ai < 2; ++ai)
#pragma unroll
                for (int m = 0; m < 4; ++m) {
                    const int row = row0b + ai * 128 + m * 16;
                    const float rs = px.rstd(row);
                    bf16_t* hp = H + (size_t)row * DM + col0;
#pragma unroll
                    for (int bj = 0; bj < 2; ++bj) {
                        const f32x4 y0 = acc[ai][bj][m][0] * rs * gs[bj][0] + sh[bj][0], y1 = acc[ai][bj][m][1] * rs * gs[bj][1] + sh[bj][1];
                        st16_wt(hp + bj * 128, (u32x4){pk2(y0[0], y0[1]), pk2(y0[2], y0[3]), pk2(y1[0], y1[1]), pk2(y1[2], y1[3])});
                    }
                    if (m & 1) asm volatile("" ::: "memory");
                }
        }
    }
};
struct EpiResFinal {
    static constexpr bool PERM = false, AFTER_DRAIN = true;
    const bf16_t* X1; float* out; const float* mod; const float* fg; PanelX px;
    __device__ __forceinline__ void fused(f32x4 (&acc)[2][2][4][2], const pg8::Unit& u, int wr, int wc, int fr, int fq) const {
        const int row0 = u.pm * 256 + wr * 64 + fr, b = u.pm >> 3, col0 = u.pn * 256 + wc * 32 + 4 * fq;
        const float* mb = mod + b * 6144 + col0;
        {
            f32x4 gv[2][2];
#pragma unroll
            for (int bj = 0; bj < 2; ++bj)
#pragma unroll
                for (int n = 0; n < 2; ++n) gv[bj][n] = *(const f32x4*)(mb + 5 * 1024 + bj * 128 + n * 16);
#pragma unroll
            for (int ai = 0; ai < 2; ++ai)
#pragma unroll
                for (int m = 0; m < 4; ++m) {
                    const bf16_t* bp = X1 + (size_t)(row0 + ai * 128 + m * 16) * DM + col0;
#pragma unroll
                    for (int bj = 0; bj < 2; ++bj)
#pragma unroll
                        for (int n = 0; n < 2; ++n) { const u32x2 w = *(const u32x2*)(bp + bj * 128 + n * 16);
                            const f32x4 xb = (f32x4){__uint_as_float(w.x << 16), __uint_as_float(w.x & 0xffff0000u), __uint_as_float(w.y << 16), __uint_as_float(w.y & 0xffff0000u)};
                            acc[ai][bj][m][n] = xb + gv[bj][n] * acc[ai][bj][m][n]; }
                    asm volatile("" : "+v"(acc[ai][0][m][0]), "+v"(acc[ai][0][m][1]), "+v"(acc[ai][1][m][0]), "+v"(acc[ai][1][m][1]));
                    if (m & 1) asm volatile("" ::: "memory");
                }
        }
        px.exchange(acc, u, wr, fr, fq);
        int row0b = row0; asm volatile("" : "+v"(row0b));
        {
            f32x4 fgv[2][2];
#pragma unroll
            for (int bj = 0; bj < 2; ++bj)
#pragma unroll
                for (int n = 0; n < 2; ++n) fgv[bj][n] = *(const f32x4*)(fg + col0 + bj * 128 + n * 16);
#pragma unroll
            for (int ai = 0; ai < 2; ++ai)
#pragma unroll
                for (int m = 0; m < 4; ++m) {
                    const int row = row0b + ai * 128 + m * 16;
                    const float rs = px.rstd(row);
                    float* op = out + (size_t)row * DM + col0;
#pragma unroll
                    for (int bj = 0; bj < 2; ++bj)
#pragma unroll
                        for (int n = 0; n < 2; ++n) *(f32x4*)(op + bj * 128 + n * 16) = acc[ai][bj][m][n] * rs * fgv[bj][n];
                    if (m & 1) asm volatile("" ::: "memory");
                }
        }
    }
};

constexpr int KSTR = 208, VSTR = 136, VOFF = 64 * KSTR;
template <int QKD, int MODE>
__device__ __forceinline__ void attn_unit(LAS unsigned char* lds, const bf16_t* Q, int ldq, const bf16_t* K1, int ldk1, const bf16_t* K2, int ldk2,
                                          const bf16_t* VT, bf16_t* O, int qpos0, int t_lo, int t_hi, float slope2, float sink2, int tid, int wid, int lane) {
    const int r = lane & 31, hi = lane >> 5;
    const int q0 = qpos0 + 32 * wid;
    constexpr int NKB = QKD / 16;
    bf16x8 qf[NKB];
#pragma unroll
    for (int kb = 0; kb < NKB; ++kb) qf[kb] = *(const bf16x8*)(Q + (size_t)(32 * wid + r) * ldq + 16 * kb + 8 * hi);
    f32x16 o0, o1;
#pragma unroll
    for (int i = 0; i < 16; ++i) { o0[i] = 0.f; o1[i] = 0.f; }
    float mrun = (MODE == 1) ? sink2 : -1e30f;
    float lsum = (MODE == 1) ? (hi == 0 ? 1.f : 0.f) : 0.f;
    const int key1 = tid >> 3, ch1 = tid & 7, key2 = (tid >> 2) & 63, ch2 = tid & 3;
    u32x4 kr, k2r, vr;
    kr = *(const u32x4*)(K1 + (size_t)(64 * t_lo + key1) * ldk1 + ch1 * 8);
    if (QKD == 96) { if (tid < 256) k2r = *(const u32x4*)(K2 + (size_t)(64 * t_lo + key2) * ldk2 + ch2 * 8); }
    vr = *(const u32x4*)(VT + (size_t)key1 * SEQ + 64 * t_lo + ch1 * 8);
    for (int t = t_lo; t <= t_hi; ++t) {
        __syncthreads();
        *(LAS u32x4*)(lds + key1 * KSTR + ch1 * 16) = kr;
        if (QKD == 96) { if (tid < 256) *(LAS u32x4*)(lds + key2 * KSTR + 128 + ch2 * 16) = k2r; }
        *(LAS u32x2*)(lds + VOFF + key1 * VSTR + ch1 * 16) = (u32x2){vr.x, vr.y};
        *(LAS u32x2*)(lds + VOFF + key1 * VSTR + ch1 * 16 + 8) = (u32x2){vr.z, vr.w};
        __syncthreads();
        if (t < t_hi) {
            kr = *(const u32x4*)(K1 + (size_t)(64 * (t + 1) + key1) * ldk1 + ch1 * 8);
            if (QKD == 96) { if (tid < 256) k2r = *(const u32x4*)(K2 + (size_t)(64 * (t + 1) + key2) * ldk2 + ch2 * 8); }
            vr = *(const u32x4*)(VT + (size_t)key1 * SEQ + 64 * (t + 1) + ch1 * 8);
        }
        const int k0 = 64 * t;
        const bool active = (MODE == 0) ? (k0 <= q0 + 31) : ((k0 + 63 >= q0 - 127) && (k0 <= q0 + 31));
        if (active) {
            f32x16 s[2];
#pragma unroll
            for (int sub = 0; sub < 2; ++sub) {
#pragma unroll
                for (int i = 0; i < 16; ++i) s[sub][i] = 0.f;
#pragma unroll
                for (int kb = 0; kb < NKB; ++kb) {
                    const bf16x8 kf = *(const LAS bf16x8*)(lds + (32 * sub + r) * KSTR + (16 * kb + 8 * hi) * 2);
                    s[sub] = __builtin_amdgcn_mfma_f32_32x32x16_bf16(kf, qf[kb], s[sub], 0, 0, 0);
                }
            }
            const int qp = q0 + r;
            if (MODE == 0) {
                if (k0 + 63 > q0) {
#pragma unroll
                    for (int sub = 0; sub < 2; ++sub)
#pragma unroll
                        for (int i = 0; i < 16; ++i) { const int key = k0 + 32 * sub + (i & 3) + 8 * (i >> 2) + 4 * hi; if (key > qp) s[sub][i] = -INFINITY; }
                }
            } else {
#pragma unroll
                for (int sub = 0; sub < 2; ++sub)
#pragma unroll
                    for (int i = 0; i < 16; ++i) { const int key = k0 + 32 * sub + (i & 3) + 8 * (i >> 2) + 4 * hi; const int dist = qp - key;
                        s[sub][i] = (dist < 0 || dist >= 128) ? -INFINITY : (s[sub][i] - slope2 * (float)dist); }
            }
            float mx = -INFINITY;
#pragma unroll
            for (int sub = 0; sub < 2; ++sub)
#pragma unroll
                for (int i = 0; i < 16; ++i) mx = fmaxf(mx, s[sub][i]);
            mx = fmaxf(mx, __shfl_xor(mx, 32));
            const float mn = fmaxf(mrun, mx);
            const float alpha = __builtin_amdgcn_exp2f(mrun - mn);
            mrun = mn;
            float psum = 0.f;
#pragma unroll
            for (int sub = 0; sub < 2; ++sub)
#pragma unroll
                for (int i = 0; i < 16; ++i) { const float p = __builtin_amdgcn_exp2f(s[sub][i] - mn); s[sub][i] = p; psum += p; }
            lsum = lsum * alpha + psum;
            o0 = o0 * alpha; o1 = o1 * alpha;
#pragma unroll
            for (int sub = 0; sub < 2; ++sub)
#pragma unroll
                for (int jb = 0; jb < 2; ++jb) {
                    u32x4 pw;
                    pw.x = pk2(s[sub][8 * jb + 0], s[sub][8 * jb + 1]); pw.y = pk2(s[sub][8 * jb + 2], s[sub][8 * jb + 3]);
                    pw.z = pk2(s[sub][8 * jb + 4], s[sub][8 * jb + 5]); pw.w = pk2(s[sub][8 * jb + 6], s[sub][8 * jb + 7]);
                    const bf16x8 pf = __builtin_bit_cast(bf16x8, pw);
                    const LAS unsigned char* vp = lds + VOFF + r * VSTR + (32 * sub + 16 * jb + 4 * hi) * 2;
                    {
                        const u32x2 a = *(const LAS u32x2*)vp, b = *(const LAS u32x2*)(vp + 16);
                        const bf16x8 vf = __builtin_bit_cast(bf16x8, (u32x4){a.x, a.y, b.x, b.y});
                        o0 = __builtin_amdgcn_mfma_f32_32x32x16_bf16(vf, pf, o0, 0, 0, 0);
                    }
                    {
                        const u32x2 a = *(const LAS u32x2*)(vp + 32 * VSTR), b = *(const LAS u32x2*)(vp + 32 * VSTR + 16);
                        const bf16x8 vf = __builtin_bit_cast(bf16x8, (u32x4){a.x, a.y, b.x, b.y});
                        o1 = __builtin_amdgcn_mfma_f32_32x32x16_bf16(vf, pf, o1, 0, 0, 0);
                    }
                }
        }
    }
    const float ltot = lsum + __shfl_xor(lsum, 32);
    const float inv = 1.0f / ltot;
    bf16_t* op = O + (size_t)(32 * wid + r) * DM + 4 * hi;
#pragma unroll
    for (int g = 0; g < 4; ++g) {
        *(u32x2*)(op + 8 * g) = (u32x2){pk2(o0[4 * g] * inv, o0[4 * g + 1] * inv), pk2(o0[4 * g + 2] * inv, o0[4 * g + 3] * inv)};
        *(u32x2*)(op + 32 + 8 * g) = (u32x2){pk2(o1[4 * g] * inv, o1[4 * g + 1] * inv), pk2(o1[4 * g + 2] * inv, o1[4 * g + 3] * inv)};
    }
}

struct TrDesc { const float* W; bf16_t* WT; const float* ks; int K, N, item; };
__device__ __forceinline__ void tr_load(const TrDesc& d, f32x4 (&v)[8], int lane) {
    const int nblk = d.N / 32, kb = d.item / nblk, nb = d.item % nblk, k0 = 64 * kb, n0 = 32 * nb;
    const int kk0 = lane >> 3, n4 = lane & 7;
#pragma unroll
    for (int i = 0; i < 8; ++i) v[i] = *(const f32x4*)(d.W + (size_t)(k0 + kk0 + 8 * i) * d.N + n0 + 4 * n4);
}
__device__ __forceinline__ void tr_finish(const TrDesc& d, f32x4 (&v)[8], LAS float* scr, int lane) {
    const int nblk = d.N / 32, kb = d.item / nblk, nb = d.item % nblk, k0 = 64 * kb, n0 = 32 * nb;
    const int kk0 = lane >> 3, n4 = lane & 7;
    if (d.ks) {
#pragma unroll
        for (int i = 0; i < 8; ++i) v[i] = v[i] * d.ks[k0 + kk0 + 8 * i];
    }
#pragma unroll
    for (int i = 0; i < 8; ++i) { LAS float* p = scr + (kk0 + 8 * i) * 33 + 4 * n4; p[0] = v[i][0]; p[1] = v[i][1]; p[2] = v[i][2]; p[3] = v[i][3]; }
    asm volatile("s_waitcnt lgkmcnt(0)" ::: "memory");
    const int c = lane & 7;
#pragma unroll
    for (int j = 0; j < 4; ++j) { const int n = (lane >> 3) + 8 * j; const LAS float* s = scr + (8 * c) * 33 + n;
        u32x4 o; o.x = pk2(s[0 * 33], s[1 * 33]); o.y = pk2(s[2 * 33], s[3 * 33]); o.z = pk2(s[4 * 33], s[5 * 33]); o.w = pk2(s[6 * 33], s[7 * 33]);
        *(u32x4*)(d.WT + (size_t)(n0 + n) * d.K + k0 + 8 * c) = o; }
    asm volatile("s_waitcnt lgkmcnt(0)" ::: "memory");
}
struct TrSet { const float *w_in, *w_qb, *w_kvb, *w_o, *w_up, *w_down, *g_qa, *g_kva; bf16_t *win_t, *wqb_t, *wkvb_t, *wo_t, *wup_t, *wdn_t; };
constexpr int I_IN = 16 * 45, I_QB = 6 * 24, I_KVB = 4 * 32, I_O = 16 * 32, I_UP = 16 * 128, I_DN = 64 * 32;
constexpr int NITEMS_EARLY = I_IN + I_QB + I_KVB, NITEMS_LATE = I_O + I_UP + I_DN;
__device__ __forceinline__ TrDesc tr_desc(const TrSet& T, int it) {
    int r = it;
    if (r < I_IN) return TrDesc{T.w_in, T.win_t, nullptr, DM, IN_COLS, r}; r -= I_IN;
    if (r < I_QB) return TrDesc{T.w_qb, T.wqb_t, T.g_qa, QL, QW, r}; r -= I_QB;
    if (r < I_KVB) return TrDesc{T.w_kvb, T.wkvb_t, T.g_kva, KVL, KVW, r}; r -= I_KVB;
    if (r < I_O) return TrDesc{T.w_o, T.wo_t, nullptr, DM, DM, r}; r -= I_O;
    if (r < I_UP) return TrDesc{T.w_up, T.wup_t, nullptr, DM, FF, r}; r -= I_UP;
    return TrDesc{T.w_down, T.wdn_t, nullptr, FF, DM, r};
}
__device__ __forceinline__ void tr_run(const TrSet& T, int first, int last, int w, int nw, LAS float* scr, int lane) {
    int it = first + w;
    if (it >= last) return;
    TrDesc d = tr_desc(T, it); f32x4 v[8]; tr_load(d, v, lane);
    for (;;) {
        const int itn = it + nw;
        if (itn < last) {
            const TrDesc dn = tr_desc(T, itn); f32x4 vn[8]; tr_load(dn, vn, lane);
            tr_finish(d, v, scr, lane);
            d = dn;
#pragma unroll
            for (int i = 0; i < 8; ++i) v[i] = vn[i];
            it = itn;
        } else { tr_finish(d, v, scr, lane); break; }
    }
}
__device__ __forceinline__ void p0_mod_block(const float* c, const float* w_ada, const float* b_ada, float* mod, LAS unsigned char* lds, int blk, int tid) {
    LAS float* sl = (LAS float*)lds;
    LAS float* part = (LAS float*)(lds + 32768);
    for (int i = tid; i < 8 * DM; i += 512) { const float x = c[i]; sl[i] = x / (1.0f + __expf(-x)); }
    __syncthreads();
    const int c4 = tid % 6, r = tid / 6;
    if (r < 85) {
        f32x4 acc[8];
#pragma unroll
        for (int b = 0; b < 8; ++b) acc[b] = (f32x4){0.f, 0.f, 0.f, 0.f};
        const float* wp = w_ada + (size_t)r * 6144 + 24 * blk + 4 * c4;
        f32x4 w[12];
#pragma unroll
        for (int i = 0; i < 12; ++i) w[i] = *(const f32x4*)(wp + (size_t)(85 * i) * 6144);
        f32x4 wt = (f32x4){0.f, 0.f, 0.f, 0.f};
        if (r < 4) wt = *(const f32x4*)(wp + (size_t)1020 * 6144);
#pragma unroll
        for (int i = 0; i < 12; ++i) {
#pragma unroll
            for (int b = 0; b < 8; ++b) acc[b] += w[i] * sl[b * DM + r + 85 * i];
        }
        if (r < 4) {
#pragma unroll
            for (int b = 0; b < 8; ++b) acc[b] += wt * sl[b * DM + r + 1020];
        }
#pragma unroll
        for (int b = 0; b < 8; ++b)
#pragma unroll
            for (int j = 0; j < 4; ++j) part[r * 192 + b * 24 + 4 * c4 + j] = acc[b][j];
    }
    __syncthreads();
    if (tid < 192) {
        float sum = 0.f;
        for (int rr = 0; rr < 85; ++rr) sum += part[rr * 192 + tid];
        const int b = tid / 24, cc = tid % 24;
        mod[b * 6144 + 24 * blk + cc] = sum + b_ada[24 * blk + cc];
    }
    __syncthreads();
}
__device__ __forceinline__ void rows_load4(const float* x, int m, f32x4 (&v)[16], int lane) {
    const f32x4* xr = (const f32x4*)(x + (size_t)m * DM) + 2 * lane;
#pragma unroll
    for (int q = 0; q < 4; ++q)
#pragma unroll
        for (int jj = 0; jj < 2; ++jj) { v[4 * q + 2 * jj] = __builtin_nontemporal_load(xr + 256 * q + 128 * jj); v[4 * q + 2 * jj + 1] = __builtin_nontemporal_load(xr + 256 * q + 128 * jj + 1); }
}
__device__ __forceinline__ void rows_finish4(const f32x4 (&v)[16], bf16_t* orow, const float* g, const float* sc, const float* sh, int lane) {
    float rs[4];
#pragma unroll
    for (int q = 0; q < 4; ++q) { float t = 0.f;
#pragma unroll
        for (int j = 0; j < 4; ++j) { const f32x4 a = v[4 * q + j]; t += (a[0] * a[0] + a[1] * a[1]) + (a[2] * a[2] + a[3] * a[3]); }
        rs[q] = t; }
#pragma unroll
    for (int o = 1; o < 64; o <<= 1) {
#pragma unroll
        for (int q = 0; q < 4; ++q) rs[q] += __shfl_xor(rs[q], o);
    }
#pragma unroll
    for (int q = 0; q < 4; ++q) rs[q] = 1.0f / sqrtf(rs[q] * (1.0f / DM) + EPS);
#pragma unroll
    for (int jj = 0; jj < 2; ++jj) {
        const int ci = 128 * jj + 2 * lane;
        const f32x4 g0 = ((const f32x4*)g)[ci] * (((const f32x4*)sc)[ci] + 1.0f), g1 = ((const f32x4*)g)[ci + 1] * (((const f32x4*)sc)[ci + 1] + 1.0f);
        const f32x4 h0 = ((const f32x4*)sh)[ci], h1 = ((const f32x4*)sh)[ci + 1];
#pragma unroll
        for (int q = 0; q < 4; ++q) {
            const f32x4 y0 = v[4 * q + 2 * jj] * rs[q] * g0 + h0, y1 = v[4 * q + 2 * jj + 1] * rs[q] * g1 + h1;
            st16_wt(orow + (size_t)q * DM + 512 * jj + 8 * lane, (u32x4){pk2(y0[0], y0[1]), pk2(y0[2], y0[3]), pk2(y1[0], y1[1]), pk2(y1[2], y1[3])});
        }
    }
}
#define XB_TMO      128
#define XB_XCNT(j)  (256  + 64 * (j))
#define XB_XSUB(j)  (1280 + 64 * (j))
#define XB_XGEN(j)  (2304 + 64 * (j))
#define XB_TOP      3328
#define XB_TOPGEN   3392
#define XCD_BAR_WORDS 3456
#define XB_SPIN_CAP (1u << 18)
__device__ __forceinline__ unsigned xb_ld(unsigned* p)              { return __hip_atomic_load(p, __ATOMIC_RELAXED, __HIP_MEMORY_SCOPE_AGENT); }
__device__ __forceinline__ unsigned xb_add(unsigned* p, unsigned v) { return __hip_atomic_fetch_add(p, v, __ATOMIC_RELAXED, __HIP_MEMORY_SCOPE_AGENT); }
__device__ __forceinline__ unsigned xb_xcc_id() { return (unsigned)__builtin_amdgcn_s_getreg((3 << 11) | 20) & 0xFu; }
#define XB_SPIN(cond, bar) do { unsigned _sp = 0; while (cond) { __builtin_amdgcn_s_sleep(1); \
    if ((++_sp & 255u) == 0u) { if (xb_ld(&(bar)[XB_TMO])) break; if (_sp > XB_SPIN_CAP) { atomicAdd(&(bar)[XB_TMO], 1u); break; } } } } while (0)
struct XcdBarrier { unsigned* bar; unsigned x; volatile LAS unsigned* st; };
__device__ __forceinline__ XcdBarrier xcd_barrier_post(unsigned* bar, volatile LAS unsigned* st) {
    XcdBarrier b; b.bar = bar; b.x = xb_xcc_id(); b.st = st;
    if (threadIdx.x == 0) (void)xb_add(&bar[XB_XCNT(b.x)], 1u);
    return b;
}
__device__ __forceinline__ void xcd_barrier_complete(unsigned* bar, unsigned x, unsigned& nloc, unsigned& nx) {
    const unsigned G = gridDim.x * gridDim.y * gridDim.z;
    unsigned sum, cnt, mine, sp = 0u;
    for (;;) {
        sum = 0u; cnt = 0u; mine = 0u;
#pragma unroll
        for (unsigned j = 0; j < 16; ++j) { const unsigned c = xb_ld(&bar[XB_XCNT(j)]); sum += c; cnt += (c > 0u) ? 1u : 0u; mine = (j == x) ? c : mine; }
        if (sum == G) break;
        __builtin_amdgcn_s_sleep(1);
        if ((++sp & 255u) == 0u) { if (xb_ld(&bar[XB_TMO])) break; if (sp > XB_SPIN_CAP) { atomicAdd(&bar[XB_TMO], 1u); break; } }
    }
    nloc = mine > 0u ? mine : 1u; nx = cnt > 0u ? cnt : 1u;
}
__device__ __forceinline__ void xcd_barrier(const XcdBarrier& b) {
    asm volatile("s_waitcnt vmcnt(0)" ::: "memory");
    __syncthreads();
    if (threadIdx.x == 0) {
        unsigned* bar = b.bar;
        __builtin_amdgcn_s_waitcnt(0);
        unsigned nloc = b.st[0], nx = b.st[1];
        if (nloc == 0u) { xcd_barrier_complete(bar, b.x, nloc, nx); b.st[0] = nloc; b.st[1] = nx; }
        const unsigned old = xb_add(&bar[XB_XSUB(b.x)], 1u);
        const unsigned gen = old / nloc;
        if (old + 1u == (gen + 1u) * nloc) {
            __builtin_amdgcn_fence(__ATOMIC_RELEASE, "agent");
            asm volatile("s_waitcnt vmcnt(0)" ::: "memory");
            const unsigned og = xb_add(&bar[XB_TOP], 1u);
            const unsigned tg = og / nx;
            if (og + 1u == (tg + 1u) * nx) xb_add(&bar[XB_TOPGEN], 1u);
            else XB_SPIN(xb_ld(&bar[XB_TOPGEN]) == tg, bar);
            __builtin_amdgcn_fence(__ATOMIC_ACQUIRE, "agent");
            xb_add(&bar[XB_XGEN(b.x)], 1u);
            asm volatile("s_waitcnt vmcnt(0)" ::: "memory");
        } else {
            XB_SPIN(xb_ld(&bar[XB_XGEN(b.x)]) == gen, bar);
            __builtin_amdgcn_fence(__ATOMIC_ACQUIRE, "agent");
            asm volatile("s_waitcnt vmcnt(0)" ::: "memory");
        }
    }
    __syncthreads();
}

struct Args { const float* in[16]; float* out; unsigned char* ws; int ph_lo, ph_hi, pad0, pad1; };
constexpr int NPHASE = 10;

__global__ void __launch_bounds__(512, 2) fwd_megakernel(Args args) {
    extern __shared__ __attribute__((aligned(16))) unsigned char lds_raw[];
    LAS unsigned char* lds = (LAS unsigned char*)lds_raw;
    cg::grid_group grid = cg::this_grid();
    const int tid = threadIdx.x, lane = tid & 63, wave = __builtin_amdgcn_readfirstlane(tid >> 6);
    const int G = gridDim.x, bx = blockIdx.x;
    const int vcu = (G % 8 == 0) ? (bx % 8) * (G / 8) + bx / 8 : bx;
    const int gw = vcu * 8 + wave, NGW = G * 8;
    unsigned char* ws = args.ws;
    const float* x = args.in[0]; const float* cvec = args.in[1]; const float* w_ada = args.in[2]; const float* b_ada = args.in[3];
    const float* norm_mix_g = args.in[4]; const float* w_in = args.in[5]; const float* g_qa = args.in[6]; const float* w_qb = args.in[7];
    const float* g_kva = args.in[8]; const float* w_kvb = args.in[9]; const float* sinks = args.in[10]; const float* w_o = args.in[11];
    const float* norm_mlp_g = args.in[12]; const float* w_up = args.in[13]; const float* w_down = args.in[14]; const float* final_g = args.in[15];
    float* out = args.out;
    float* mod = (float*)(ws + WS_MOD); float* ssq_q = (float*)(ws + WS_SSQQ); float* ssq_kv = (float*)(ws + WS_SSQKV);
    float* ropec = (float*)(ws + WS_ROPE); float* ropes = ropec + SEQ * 16;
    bf16_t* win_t = (bf16_t*)(ws + WS_WIN); bf16_t* wqb_t = (bf16_t*)(ws + WS_WQB); bf16_t* wkvb_t = (bf16_t*)(ws + WS_WKVB);
    bf16_t* wo_t = (bf16_t*)(ws + WS_WO); bf16_t* wup_t = (bf16_t*)(ws + WS_WUP); bf16_t* wdn_t = (bf16_t*)(ws + WS_WDN);
    bf16_t* hbuf = (bf16_t*)(ws + WS_H); bf16_t* proj = (bf16_t*)(ws + WS_PROJ); bf16_t* qbuf = (bf16_t*)(ws + WS_Q); bf16_t* knope = (bf16_t*)(ws + WS_KN);
    bf16_t* vtm = (bf16_t*)(ws + WS_VTM); bf16_t* vts = (bf16_t*)(ws + WS_VTS); bf16_t* mix = (bf16_t*)(ws + WS_MIX); bf16_t* ubuf = (bf16_t*)(ws + WS_U); bf16_t* x1b = (bf16_t*)(ws + WS_X1);

    const TrSet TS{w_in, w_qb, w_kvb, w_o, w_up, w_down, g_qa, g_kva, win_t, wqb_t, wkvb_t, wo_t, wup_t, wdn_t};
    const int lo = args.ph_lo, hi = args.ph_hi;
    volatile LAS unsigned* bst = (volatile LAS unsigned*)(lds + 131072);
    if (tid < 2) bst[tid] = 0u;
    __syncthreads();
    XcdBarrier xbar; xbar.bar = (unsigned*)(ws + WS_BAR); xbar.x = 0; xbar.st = bst;
    if (hi - lo > 1) xbar = xcd_barrier_post((unsigned*)(ws + WS_BAR), bst);
    if (lo < 0) grid.sync();
#ifndef PH_MASK
#define PH_MASK 0x3ff
#endif
#define IN(k) (((PH_MASK >> (k)) & 1) && lo <= (k) && (k) < hi)
#define GSYNC() xcd_barrier(xbar)
#define SEAM2(k, k2) do { if (IN(k) && IN(k2)) GSYNC(); } while (0)
#define SEAM(k) SEAM2(k, (k) + 1)
#ifndef REPMASK
#define REPMASK 0
#endif
#ifndef REPN
#define REPN 3
#endif
#ifndef XSYNC
#define XSYNC 0
#endif
#ifndef TPROBE
#define TPROBE -1
#endif
#define STAMP(j) do { if (TPROBE >= 0 && bx == 0 && wave == 0) { if ((j) == TPROBE) tp0 = __builtin_amdgcn_s_memrealtime(); if ((j) == TPROBE + 1) tp1 = __builtin_amdgcn_s_memrealtime(); } } while (0)
#define REP(k) for (int rep_ = 0; rep_ < (((REPMASK >> (k)) & 1) ? REPN : 1); ++rep_)

    unsigned long long tp0 = 0, tp1 = 0;
    STAMP(0);
    const int pm_t = 8 * (bx & 7) + ((bx >> 3) & 7), mj = bx >> 6, bt = pm_t >> 3;
    const int rm0 = 256 * pm_t + 64 * mj + 8 * wave;
    if (IN(0)) {
        LAS float* scr = (LAS float*)(lds + wave * 16384);
        p0_mod_block(cvec, w_ada, b_ada, mod, lds, bx, tid);
        tr_run(TS, 0, NITEMS_EARLY, gw, NGW, scr, lane);
        const int gt = vcu * 512 + tid, NGT = G * 512;
        for (int i = gt; i < (NPROJ - IN_COLS) * DM / 8; i += NGT) ((u32x4*)(win_t + (size_t)IN_COLS * DM))[i] = (u32x4){0u, 0u, 0u, 0u};
        for (int i = gt; i < SEQ * 16; i += NGT) {
            const int pos = i >> 4, fi = i & 15;
            double f = (fi & 3) == 0 ? 1.0 : ((fi & 3) == 1 ? 0.5623413251903491 : ((fi & 3) == 2 ? 0.31622776601683794 : 0.1778279410038923));
            const int dec = fi >> 2; f *= (dec == 0 ? 1.0 : (dec == 1 ? 0.1 : (dec == 2 ? 0.01 : 0.001)));
            const float ang32 = (float)pos * (float)f;
            const double rev = (double)ang32 * 0.15915494309189535;
            const float fr = (float)(rev - __builtin_rint(rev));
            ropec[i] = __builtin_amdgcn_cosf(fr); ropes[i] = __builtin_amdgcn_sinf(fr);
        }
    }
    f32x4 rv[16], rvn[16];
    rows_load4(x, rm0, rv, lane); rows_load4(x, rm0 + 4, rvn, lane);
    SEAM(0);
    STAMP(1);
    for (int xs_ = 0; xs_ < XSYNC; ++xs_) GSYNC();
    if (IN(1)) {
        unsigned* tc = (unsigned*)(ws + WS_CNT) + 64 * pm_t;
        {
            rows_finish4(rv, hbuf + (size_t)rm0 * DM, norm_mix_g, mod + bt * 6144 + 1024, mod + bt * 6144, lane);
            rows_finish4(rvn, hbuf + (size_t)(rm0 + 4) * DM, norm_mix_g, mod + bt * 6144 + 1024, mod + bt * 6144, lane);
        }
        team_wait(tc + 4 * 64 * 64);
#pragma unroll 1
        for (int rnd = 0; rnd < 2; ++rnd) {
            if (rnd == 0 || mj < 2) {
                pg8::Gemm g{hbuf, win_t, MT, NPROJ, DM, DM}; const pg8::ListOrder S{pm_t, 1, rnd == 0 ? mj : 4 + mj, 0};
                EpiProj E{proj, ssq_q, ssq_kv, ropec, ropes, vts};
                pg8::gemm_phase<EpiProj, true, pg8::ListOrder>(lds, g, S, E);
            }
            if (rnd == 0) team_wait(tc + 5 * 64 * 64);
        }
        { pg8::Gemm g{proj, wqb_t, MT, QW, QL, NPROJ}; const pg8::ListOrder S{pm_t, mj == 2 ? 2 : (mj == 3 ? 1 : 0), mj == 2 ? 0 : 2, 1};
          EpiQ E{qbuf, ssq_q, ropec, ropes}; pg8::gemm_phase<EpiQ, true, pg8::ListOrder>(lds, g, S, E); }
        { pg8::Gemm g{proj + QL, wkvb_t, MT, KVW, KVL, NPROJ}; const pg8::ListOrder S{pm_t, mj == 3 ? 2 : (mj == 2 ? 0 : 1), mj == 3 ? 2 : mj, 3};
          EpiKV E{knope, vtm, ssq_kv}; pg8::gemm_phase<EpiKV, true, pg8::ListOrder>(lds, g, S, E); }
        if (mj < 3) {
            LAS float* scr = (LAS float*)(lds + wave * 16384);
            const int f0 = NITEMS_EARLY + 72 * pm_t + 24 * mj;
            tr_run(TS, f0, f0 + 24, wave, 8, scr, lane);
        }
    }
    STAMP(2); STAMP(3);
    SEAM2(1, 4);
    STAMP(4);
    REP(4) { if (rep_) GSYNC();
    if (IN(4)) {
        if (wave >= 4) __builtin_amdgcn_s_setprio(1);
        for (int it = vcu; it < 768; it += G) {
            if (it < 256) {
                const int b = it >> 5, h = (it >> 2) & 7, pp = it & 3;
#pragma unroll 1
                for (int k = 0; k < 2; ++k) {
                    const int qb = k == 0 ? 7 - pp : pp;
                    const size_t row0 = (size_t)b * SEQ + qb * 256;
                    attn_unit<96, 0>(lds, qbuf + row0 * QW + h * 96, QW, knope + (size_t)b * SEQ * 512 + h * 64, 512, proj + (size_t)b * SEQ * NPROJ + 640, NPROJ,
                                     vtm + (size_t)(b * 8 + h) * 64 * SEQ, mix + row0 * DM + h * 64, qb * 256, 0, 4 * qb + 3, 0.f, 0.f, tid, wave, lane);
                }
            } else {
                const int id = it - 256, b = id >> 6, hq = (id >> 3) & 7, qb = id & 7, kvh = hq >> 2;
                const size_t row0 = (size_t)b * SEQ + qb * 256;
                const float slope2 = exp2f(-(float)(hq + 1)) * LOG2E, sink2 = sinks[hq] * LOG2E;
                attn_unit<64, 1>(lds, proj + row0 * NPROJ + 672 + hq * 64, NPROJ, proj + (size_t)b * SEQ * NPROJ + 1184 + kvh * 64, NPROJ, nullptr, 0,
                                 vts + (size_t)(b * 2 + kvh) * 64 * SEQ, mix + row0 * DM + 512 + hq * 64, qb * 256, qb == 0 ? 0 : 4 * qb - 2, 4 * qb + 3, slope2, sink2, tid, wave, lane);
            }
        }
        __builtin_amdgcn_s_setprio(0);
        __syncthreads();
    }
    }
    SEAM(4);
    STAMP(5);
    if (IN(5)) {
        pg8::Gemm g{mix, wo_t, MT, DM, DM, DM}; pg8::StaticOrder S; S.init(MT, DM, G, bx);
        EpiResNorm E{x, x1b, hbuf, mod, norm_mlp_g, PanelX{(float*)(ws + WS_SSQX1), (unsigned*)(ws + WS_CNT)}};
        pg8::gemm_phase<EpiResNorm, false>(lds, g, S, E);
    }
    if (IN(5) && IN(7)) { pg8::StaticOrder S; S.init(MT, DM, G, bx); pg8::Unit u; S.next(0, u); team_wait((unsigned*)(ws + WS_CNT) + 2 * 64 * 64 + 64 * u.pm); }
    STAMP(6);
    REP(7) { if (rep_) GSYNC();
    if (IN(7)) {
        pg8::Gemm g{hbuf, wup_t, MT, FF, DM, DM}; pg8::StaticOrder S; S.init(MT, FF, G, bx);
        EpiUp E{ubuf};
        pg8::gemm_phase<EpiUp, true>(lds, g, S, E);
    }
    }
    if (IN(7) && IN(8)) { pg8::StaticOrder S; S.init(MT, DM, G, bx); pg8::Unit u; S.next(0, u); team_wait((unsigned*)(ws + WS_CNT) + 3 * 64 * 64 + 64 * u.pm); }
    STAMP(7);
    if (IN(8)) {
        pg8::Gemm g{ubuf, wdn_t, MT, DM, FF, FF}; pg8::StaticOrder S; S.init(MT, DM, G, bx);
        EpiResFinal E{x1b, out, mod, final_g, PanelX{(float*)(ws + WS_SSQX2), (unsigned*)(ws + WS_CNT) + 64 * 64}};
        pg8::gemm_phase<EpiResFinal, false>(lds, g, S, E);
    }
    STAMP(8);
    if (TPROBE >= 0 && bx == 0 && wave == 0) { const unsigned long long tgt = __builtin_amdgcn_s_memrealtime() + 4ull * (tp1 - tp0); while (__builtin_amdgcn_s_memrealtime() < tgt) __builtin_amdgcn_s_sleep(8); }
#undef IN
#undef SEAM
}

extern "C" void kernel_launch(void* const* d_in, const int* in_sizes, int n_in, void* d_out, int out_size, void* d_ws, size_t ws_size, hipStream_t stream) {
    static int grid = 0;
    if (grid == 0) {
        if (n_in != 16 || out_size != MT * DM || ws_size < WS_END) { fprintf(stderr, "kernel_launch: unexpected shapes (n_in %d out %d ws %zu)\n", n_in, out_size, ws_size); grid = -1; return; }
        int dev = 0, cus = 0, per_cu = 0;
        hipGetDevice(&dev);
        hipDeviceGetAttribute(&cus, hipDeviceAttributeMultiprocessorCount, dev);
        if (hipFuncSetAttribute((const void*)fwd_megakernel, hipFuncAttributeMaxDynamicSharedMemorySize, LDS_BYTES) != hipSuccess) { fprintf(stderr, "kernel_launch: hipFuncSetAttribute failed\n"); }
        if (hipOccupancyMaxActiveBlocksPerMultiprocessor(&per_cu, (const void*)fwd_megakernel, 512, LDS_BYTES) != hipSuccess || per_cu < 1) { fprintf(stderr, "kernel_launch: occupancy query says %d\n", per_cu); per_cu = 1; }
        (void)hipGetLastError();
        grid = cus * per_cu;
        if (grid != 256) { fprintf(stderr, "kernel_launch: this kernel needs exactly 256 co-resident workgroups (one per CU), got %d\n", grid); grid = -1; return; }
    }
    if (grid < 0) return;
    hipMemsetAsync((char*)d_ws, 0, WS_ZERO_BYTES, stream);
    Args a{};
    for (int i = 0; i < 16; ++i) a.in[i] = (const float*)d_in[i];
    a.out = (float*)d_out; a.ws = (unsigned char*)d_ws;
#if MK_PER_PHASE
    for (int p = 0; p < NPHASE; ++p) {
        a.ph_lo = p; a.ph_hi = p + 1;
        hipLaunchKernelGGL(fwd_megakernel, dim3(grid), dim3(512), LDS_BYTES, stream, a);
    }
#else
    a.ph_lo = 0; a.ph_hi = NPHASE;
    void* kargs[] = {&a};
    hipError_t e = hipLaunchCooperativeKernel((const void*)fwd_megakernel, dim3(grid), dim3(512), kargs, LDS_BYTES, stream);
    if (e != hipSuccess) fprintf(stderr, "cooperative launch failed: %s (grid %d)\n", hipGetErrorString(e), grid);
#endif
}
```

```cpp
#include <hip/hip_runtime.h>
#include <hip/hip_cooperative_groups.h>
#include <cstdio>
#include <cstdint>
namespace cg = cooperative_groups;

#define LAS __attribute__((address_space(3)))
typedef unsigned short bf16_t;
typedef short bf16x8 __attribute__((ext_vector_type(8)));
typedef short s16x4 __attribute__((ext_vector_type(4)));
typedef float f32x4 __attribute__((ext_vector_type(4)));
typedef float f32x2 __attribute__((ext_vector_type(2)));
typedef float f32x16 __attribute__((ext_vector_type(16)));
typedef unsigned u32x4 __attribute__((ext_vector_type(4)));
typedef unsigned u32x2 __attribute__((ext_vector_type(2)));
typedef __bf16 bf2_t __attribute__((ext_vector_type(2)));

#ifndef MK_PER_PHASE
#define MK_PER_PHASE 0
#endif

constexpr int NB = 8, SEQ = 2048, DM = 1024, MT = NB * SEQ, FF = 4096;
constexpr int NPROJ = 1536, IN_COLS = 1440;
constexpr int QL = 384, KVL = 256;
constexpr int QW = 768, KVW = 1024;
constexpr float EPS = 1e-6f;
constexpr float LOG2E = 1.4426950408889634f;
constexpr float QSC_MLA = 0.10206207261596575f * LOG2E;
constexpr float QSC_SWA = 0.125f * LOG2E;

constexpr size_t MiB = 1u << 20;
constexpr size_t WS_MOD = 0, WS_SSQQ = 256 * 1024, WS_SSQKV = 320 * 1024, WS_BAR = 384 * 1024, WS_SSQX1 = 400 * 1024, WS_SSQX2 = 464 * 1024, WS_CNT = 528 * 1024, WS_ZERO_BYTES = 624 * 1024;
constexpr size_t WS_ROPE = 1 * MiB;
constexpr size_t WS_WIN = 2 * MiB, WS_WQB = 5 * MiB, WS_WKVB = 6 * MiB, WS_WO = 7 * MiB, WS_WUP = 9 * MiB, WS_WDN = 17 * MiB;
constexpr size_t WS_H = 25 * MiB, WS_PROJ = 57 * MiB, WS_Q = 105 * MiB, WS_KN = 129 * MiB, WS_VTM = 145 * MiB, WS_VTS = 161 * MiB, WS_MIX = 185 * MiB;
constexpr size_t WS_U = 57 * MiB;
constexpr size_t WS_X1 = 217 * MiB;
constexpr size_t WS_END = 249 * MiB;
constexpr int LDS_BYTES = 131072 + 256;

__device__ __forceinline__ unsigned pk2(float lo, float hi) { f32x2 v = {lo, hi}; bf2_t r = __builtin_convertvector(v, bf2_t); return __builtin_bit_cast(unsigned, r); }
__device__ __forceinline__ bf16_t f2bf(float f) { return (bf16_t)(pk2(f, 0.f) & 0xffffu); }
__device__ __forceinline__ void st16_wt(void* p, u32x4 v) { asm volatile("global_store_dwordx4 %0, %1, off sc1\n\ts_nop 1" :: "v"(p), "v"(v) : "memory"); }
__device__ __forceinline__ void team_wait(unsigned* cnt) {
    asm volatile("s_waitcnt vmcnt(0)" ::: "memory");
    __syncthreads();
    if (threadIdx.x == 0) {
        __hip_atomic_fetch_add(cnt, 1u, __ATOMIC_RELAXED, __HIP_MEMORY_SCOPE_AGENT);
        unsigned sp = 0;
        while (__hip_atomic_load(cnt, __ATOMIC_RELAXED, __HIP_MEMORY_SCOPE_AGENT) < 4u) { __builtin_amdgcn_s_sleep(1); if (++sp > (1u << 22)) break; }
        __builtin_amdgcn_fence(__ATOMIC_ACQUIRE, "agent");
        asm volatile("s_waitcnt vmcnt(0)" ::: "memory");
    }
    __syncthreads();
}
__device__ __forceinline__ float wave_sum(float v) {
#pragma unroll
    for (int o = 1; o < 64; o <<= 1) v += __shfl_xor(v, o);
    return v;
}

namespace pg8 {
constexpr int BM = 256, BK = 64, HALF = 128, HTB = HALF * BK * 2, STAGE_BYTES = 8 * HTB, NXCD = 8, WGM = 8;
__host__ __device__ __forceinline__ int lds_byte(int r, int c) { const int st = (r >> 4) * 2 + (c >> 5), rr = r & 15, cc = c & 31, ob = rr * 64 + cc * 2; return st * 1024 + (ob ^ (((ob >> 9) & 1) << 5)); }
__host__ __device__ __forceinline__ void stage_rc(int b, int& R, int& C) { const int st = b / 1024, sb = b % 1024, swz = sb ^ (((sb >> 9) & 1) << 5); R = (st >> 1) * 16 + swz / 64; C = (st & 1) * 32 + (swz % 64) / 2; }
__host__ __device__ __forceinline__ int perm32(int rho) { const int n = rho >> 4, i = rho & 15; return 8 * (i >> 2) + 4 * n + (i & 3); }

struct Unit { int pm, pn; };
struct Gemm { const bf16_t* A; const bf16_t* Bt; int M, N, K, lda; };

struct StaticOrder {
    int nM, nN, nwg, G, c;
    __device__ void init(int M, int N, int G_, int c_) { nM = M / BM; nN = N / BM; nwg = nM * nN; G = G_; c = c_; }
    __device__ bool next(int i, Unit& u) const {
        const long L = (long)i * G + c; if (L >= nwg) return false;
        int wgid = (int)L; { const int q = nwg / NXCD, r = nwg % NXCD, xcd = wgid % NXCD, off = wgid / NXCD; wgid = (xcd < r ? xcd * (q + 1) : r * (q + 1) + (xcd - r) * q) + off; }
        const int nig = WGM * nN, gid = wgid / nig, fm = gid * WGM, gsz = (nM - fm) < WGM ? (nM - fm) : WGM;
        u.pm = fm + ((wgid % nig) % gsz); u.pn = (wgid % nig) / gsz; return true;
    }
};

struct ListOrder {
    int pm, n, p0, p1;
    __device__ bool next(int i, Unit& u) const { if (i >= n) return false; u.pm = pm; u.pn = (i == 0) ? p0 : p1; return true; }
};
template <class Epi, bool ALIGN_EPI, class Sched = StaticOrder>
__device__ __forceinline__ void gemm_phase(LAS unsigned char* lds, const Gemm g, const Sched& S, const Epi& E) {
    const int tid = threadIdx.x, wid = __builtin_amdgcn_readfirstlane(tid >> 6), lane = tid & 63, wr = wid >> 2, wc = wid & 3, fr = lane & 15, fq = lane >> 4;
    const int K = g.K, nt = K / BK, lda = g.lda;
    unsigned voffA[2], voffB[2];
#pragma unroll
    for (int i = 0; i < 2; ++i) { int R, C; stage_rc(tid * 16 + i * 8192, R, C); const int Rb = Epi::PERM ? ((R & ~31) + perm32(R & 31)) : R;
        voffA[i] = (unsigned)(R * lda + C) * 2u; voffB[i] = (unsigned)(Rb * K + C) * 2u; }
    const size_t kstep = (size_t)(BK * 2);
    const size_t hstepA = (size_t)HALF * lda * 2, hstepB = (size_t)HALF * K * 2;
    const size_t tstepA = 2 * hstepA, tstepB = 2 * hstepB;
    const unsigned ldsw = (unsigned)wid * 1024u;
    const int aoff = lds_byte(wr * 64 + fr, fq * 8), boff = lds_byte(wc * 32 + fr, fq * 8);
#define PG8_SA(b, h) (((b) * 2 + (h)) * HTB)
#define PG8_SB(b, h) ((4 + (b) * 2 + (h)) * HTB)
#define PG8_STAGE(bufoff, gbase, voff) do { _Pragma("unroll") for (int _i = 0; _i < 2; ++_i) \
        __builtin_amdgcn_global_load_lds((const unsigned*)((const char*)(gbase) + (voff)[_i]), (LAS unsigned*)(lds + (bufoff) + ldsw + _i * 8192), 16, 0, 0); } while (0)
#define PG8_LDA(dst, b, h) do { _Pragma("unroll") for (int m = 0; m < 4; ++m) _Pragma("unroll") for (int k = 0; k < 2; ++k) dst[m][k] = *(const LAS bf16x8*)(lds + PG8_SA(b, h) + aoff + m * 2048 + k * 1024); } while (0)
#define PG8_LDB(dst, b, h) do { _Pragma("unroll") for (int n = 0; n < 2; ++n) _Pragma("unroll") for (int k = 0; k < 2; ++k) dst[n][k] = *(const LAS bf16x8*)(lds + PG8_SB(b, h) + boff + n * 2048 + k * 1024); } while (0)
#define PG8_MMA(ai, bj, At, Bt) do { __builtin_amdgcn_s_setprio(1); _Pragma("unroll") for (int m = 0; m < 4; ++m) _Pragma("unroll") for (int n = 0; n < 2; ++n) _Pragma("unroll") for (int k = 0; k < 2; ++k) \
        acc[ai][bj][m][n] = __builtin_amdgcn_mfma_f32_16x16x32_bf16(Bt[n][k], At[m][k], acc[ai][bj][m][n], 0, 0, 0); __builtin_amdgcn_s_setprio(0); } while (0)
#define PG8_WAIT_V(n) asm volatile("s_waitcnt vmcnt(" #n ")" ::: "memory")
#define PG8_WAIT_L(n) asm volatile("s_waitcnt lgkmcnt(" #n ")" ::: "memory")
#define PG8_BAR __builtin_amdgcn_s_barrier()
#define PG8_SCHED __builtin_amdgcn_sched_barrier(0)
    Unit cur, nxt; int ui = 0;
    if (!S.next(0, cur)) return;
    f32x4 acc[2][2][4][2];
#pragma unroll
    for (int a = 0; a < 2; ++a)
#pragma unroll
        for (int b = 0; b < 2; ++b)
#pragma unroll
            for (int m = 0; m < 4; ++m)
#pragma unroll
                for (int n = 0; n < 2; ++n) acc[a][b][m][n] = (f32x4){0.f, 0.f, 0.f, 0.f};
    bf16x8 At[4][2], B0[2][2], B1[2][2];
    const char* cA = (const char*)g.A + (size_t)cur.pm * tstepA; const char* cB = (const char*)g.Bt + (size_t)cur.pn * tstepB;
    {
        PG8_STAGE(PG8_SB(0, 0), cB, voffB); PG8_STAGE(PG8_SB(0, 1), cB + hstepB, voffB); PG8_STAGE(PG8_SA(0, 0), cA, voffA); PG8_STAGE(PG8_SA(0, 1), cA + hstepA, voffA);
        if (wr == 1) PG8_BAR;
        PG8_WAIT_V(2); PG8_BAR;
        PG8_STAGE(PG8_SB(1, 0), cB + kstep, voffB); PG8_STAGE(PG8_SA(1, 0), cA + kstep, voffA); PG8_STAGE(PG8_SB(1, 1), cB + hstepB + kstep, voffB);
        PG8_WAIT_V(6); PG8_BAR;
    }
    for (;;) {
        const bool has_next = S.next(ui + 1, nxt);
        const char* nA = has_next ? (const char*)g.A + (size_t)nxt.pm * tstepA : cA; const char* nB = has_next ? (const char*)g.Bt + (size_t)nxt.pn * tstepB : cB;
#pragma unroll 1
        for (int t = 0; t < nt; t += 2) {
            const bool last = (t == nt - 2);
            const char* a1 = cA + (size_t)(t + 1) * kstep;
            const char* a2 = last ? nA : cA + (size_t)(t + 2) * kstep; const char* b2 = last ? nB : cB + (size_t)(t + 2) * kstep;
            const char* a3 = a2 + kstep; const char* b3 = b2 + kstep;
            PG8_LDB(B0, 0, 0); PG8_LDB(B1, 0, 1); PG8_SCHED; PG8_LDA(At, 0, 0); PG8_STAGE(PG8_SA(1, 1), a1 + hstepA, voffA);
            PG8_WAIT_V(8); PG8_WAIT_L(0); PG8_BAR; PG8_MMA(0, 0, At, B0); PG8_MMA(0, 1, At, B1); PG8_BAR; PG8_SCHED;
            PG8_LDA(At, 0, 1); PG8_STAGE(PG8_SB(0, 0), b2, voffB); PG8_STAGE(PG8_SB(0, 1), b2 + hstepB, voffB); PG8_STAGE(PG8_SA(0, 0), a2, voffA);
            PG8_WAIT_V(8); PG8_WAIT_L(0); PG8_BAR; PG8_MMA(1, 0, At, B0); PG8_MMA(1, 1, At, B1); PG8_BAR; PG8_SCHED;
            PG8_LDB(B0, 1, 0); PG8_LDB(B1, 1, 1); PG8_SCHED; PG8_LDA(At, 1, 0); PG8_STAGE(PG8_SA(0, 1), a2 + hstepA, voffA);
            PG8_WAIT_V(8); PG8_WAIT_L(0); PG8_BAR; PG8_MMA(0, 0, At, B0); PG8_MMA(0, 1, At, B1); PG8_BAR; PG8_SCHED;
            PG8_LDA(At, 1, 1); PG8_STAGE(PG8_SB(1, 0), b3, voffB); PG8_STAGE(PG8_SB(1, 1), b3 + hstepB, voffB); PG8_STAGE(PG8_SA(1, 0), a3, voffA);
            PG8_WAIT_V(8); PG8_WAIT_L(0); PG8_BAR; PG8_MMA(1, 0, At, B0); PG8_MMA(1, 1, At, B1); PG8_BAR; PG8_SCHED;
        }
        if constexpr (ALIGN_EPI) { if (wr == 0) PG8_BAR; }
        if constexpr (!Epi::AFTER_DRAIN) E(acc, cur, wr, wc, fr, fq);
        if (!has_next) break;
#pragma unroll
        for (int a = 0; a < 2; ++a)
#pragma unroll
            for (int b = 0; b < 2; ++b)
#pragma unroll
                for (int m = 0; m < 4; ++m)
#pragma unroll
                    for (int n = 0; n < 2; ++n) acc[a][b][m][n] = (f32x4){0.f, 0.f, 0.f, 0.f};
        cur = nxt; cA = nA; cB = nB; ++ui;
        if constexpr (ALIGN_EPI) { if (wr == 1) PG8_BAR; }
    }
    PG8_WAIT_V(0);
    if constexpr (!ALIGN_EPI) { if (wr == 0) PG8_BAR; }
    PG8_BAR;
    if constexpr (Epi::AFTER_DRAIN) E.fused(acc, cur, wr, wc, fr, fq);
#undef PG8_SA
#undef PG8_SB
#undef PG8_STAGE
#undef PG8_LDA
#undef PG8_LDB
#undef PG8_MMA
#undef PG8_WAIT_V
#undef PG8_WAIT_L
#undef PG8_BAR
#undef PG8_SCHED
}
}


struct EpiProj {
    static constexpr bool PERM = true, AFTER_DRAIN = false;
    bf16_t* P; float* ssq_q; float* ssq_kv; const float* ropec; const float* ropes; bf16_t* vts;
    __device__ __forceinline__ void operator()(const f32x4 (&acc)[2][2][4][2], const pg8::Unit& u, int wr, int wc, int fr, int fq) const {
        const int row0 = u.pm * 256 + wr * 64 + fr;
#pragma unroll
        for (int bj = 0; bj < 2; ++bj) {
            const int cgp = u.pn * 2 + bj;
            const int col = cgp * 128 + wc * 32 + 8 * fq;
            const bool is_q = cgp < 3, is_kv = (cgp == 3 || cgp == 4), is_kpe = (cgp == 5 && wc == 0);
            const bool is_swaq = (cgp == 5 && wc >= 1) || (cgp >= 6 && cgp <= 8) || (cgp == 9 && wc == 0);
            const bool is_swav = (cgp == 10 && wc >= 1) || (cgp == 11 && wc == 0);
#pragma unroll
            for (int ai = 0; ai < 2; ++ai)
#pragma unroll
                for (int m = 0; m < 4; ++m) {
                    const int row = row0 + ai * 128 + m * 16;
                    f32x4 v0 = acc[ai][bj][m][0], v1 = acc[ai][bj][m][1];
                    if (is_q || is_kv) {
                        float s = (v0[0] * v0[0] + v0[1] * v0[1]) + (v0[2] * v0[2] + v0[3] * v0[3]) + (v1[0] * v1[0] + v1[1] * v1[1]) + (v1[2] * v1[2] + v1[3] * v1[3]);
                        s += __shfl_xor(s, 16); s += __shfl_xor(s, 32);
                        if (fq == 0) unsafeAtomicAdd((is_q ? ssq_q : ssq_kv) + row, s);
                    }
                    if (is_kpe) {
                        f32x4 p0, p1;
#pragma unroll
                        for (int j = 0; j < 4; ++j) { p0[j] = __shfl_xor(v0[j], 32); p1[j] = __shfl_xor(v1[j], 32); }
                        const int pos = row & (SEQ - 1), i0 = (8 * fq) & 15;
                        const f32x4 c0 = *(const f32x4*)(ropec + pos * 16 + i0), c1 = *(const f32x4*)(ropec + pos * 16 + i0 + 4);
                        const f32x4 s0 = *(const f32x4*)(ropes + pos * 16 + i0), s1 = *(const f32x4*)(ropes + pos * 16 + i0 + 4);
                        const float sg = fq < 2 ? -1.f : 1.f;
                        v0 = v0 * c0 + p0 * s0 * sg; v1 = v1 * c1 + p1 * s1 * sg;
                    }
                    if (is_swaq) { v0 = v0 * QSC_SWA; v1 = v1 * QSC_SWA; }
                    u32x4 w; w.x = pk2(v0[0], v0[1]); w.y = pk2(v0[2], v0[3]); w.z = pk2(v1[0], v1[1]); w.w = pk2(v1[2], v1[3]);
                    st16_wt(P + (size_t)row * NPROJ + col, w);
                    if (is_swav) {
                        const int d = col - 1312, kvh = d >> 6, dd = d & 63, b = row >> 11, s = row & (SEQ - 1);
                        bf16_t* base = vts + ((size_t)((b * 2 + kvh) * 64 + dd)) * SEQ + s;
                        base[0 * SEQ] = (bf16_t)(w.x & 0xffffu); base[1 * SEQ] = (bf16_t)(w.x >> 16);
                        base[2 * SEQ] = (bf16_t)(w.y & 0xffffu); base[3 * SEQ] = (bf16_t)(w.y >> 16);
                        base[4 * SEQ] = (bf16_t)(w.z & 0xffffu); base[5 * SEQ] = (bf16_t)(w.z >> 16);
                        base[6 * SEQ] = (bf16_t)(w.w & 0xffffu); base[7 * SEQ] = (bf16_t)(w.w >> 16);
                    }
                }
        }
    }
};
struct EpiQ {
    static constexpr bool PERM = true, AFTER_DRAIN = false;
    bf16_t* Q; const float* ssq_q; const float* ropec; const float* ropes;
    __device__ __forceinline__ void operator()(const f32x4 (&acc)[2][2][4][2], const pg8::Unit& u, int wr, int wc, int fr, int fq) const {
        const int row0 = u.pm * 256 + wr * 64 + fr;
        const int i0 = (8 * fq) & 15; const float sg = fq < 2 ? -1.f : 1.f;
#pragma unroll
        for (int ai = 0; ai < 2; ++ai)
#pragma unroll
            for (int m = 0; m < 4; ++m) {
                const int row = row0 + ai * 128 + m * 16, pos = row & (SEQ - 1);
                const float rs = __builtin_amdgcn_rsqf(__hip_atomic_load(ssq_q + row, __ATOMIC_RELAXED, __HIP_MEMORY_SCOPE_AGENT) * (1.0f / QL) + EPS) * QSC_MLA;
#pragma unroll
                for (int bj = 0; bj < 2; ++bj) {
                    const int G = u.pn * 8 + bj * 4 + wc;
                    f32x4 v0 = acc[ai][bj][m][0] * rs, v1 = acc[ai][bj][m][1] * rs;
                    if ((G % 3) == 2) {
                        f32x4 p0, p1;
#pragma unroll
                        for (int j = 0; j < 4; ++j) { p0[j] = __shfl_xor(v0[j], 32); p1[j] = __shfl_xor(v1[j], 32); }
                        const f32x4 c0 = *(const f32x4*)(ropec + pos * 16 + i0), c1 = *(const f32x4*)(ropec + pos * 16 + i0 + 4);
                        const f32x4 s0 = *(const f32x4*)(ropes + pos * 16 + i0), s1 = *(const f32x4*)(ropes + pos * 16 + i0 + 4);
                        v0 = v0 * c0 + p0 * s0 * sg; v1 = v1 * c1 + p1 * s1 * sg;
                    }
                    *(u32x4*)(Q + (size_t)row * QW + G * 32 + 8 * fq) = (u32x4){pk2(v0[0], v0[1]), pk2(v0[2], v0[3]), pk2(v1[0], v1[1]), pk2(v1[2], v1[3])};
                }
                asm volatile("" ::: "memory");
            }
    }
};
struct EpiKV {
    static constexpr bool PERM = false, AFTER_DRAIN = false;
    bf16_t* KN; bf16_t* VT; const float* ssq_kv;
    __device__ __forceinline__ void operator()(const f32x4 (&acc)[2][2][4][2], const pg8::Unit& u, int wr, int wc, int fr, int fq) const {
        const int row0 = u.pm * 256 + wr * 64 + fr;
#pragma unroll
        for (int ai = 0; ai < 2; ++ai)
#pragma unroll
            for (int m = 0; m < 4; ++m) {
                const int row = row0 + ai * 128 + m * 16, b = row >> 11, s = row & (SEQ - 1);
                const float rs = __builtin_amdgcn_rsqf(__hip_atomic_load(ssq_kv + row, __ATOMIC_RELAXED, __HIP_MEMORY_SCOPE_AGENT) * (1.0f / KVL) + EPS);
#pragma unroll
                for (int bj = 0; bj < 2; ++bj) {
                    const int head = u.pn * 2 + bj;
                    const f32x4 x1 = acc[ai][bj][m][0] * rs, x2 = acc[ai][bj][m][1] * rs;
                    const unsigned a0 = pk2(x1[0], x1[1]), a1 = pk2(x1[2], x1[3]), b0 = pk2(x2[0], x2[1]), b1 = pk2(x2[2], x2[3]);
                    if (wc < 2) {
                        bf16_t* p = KN + (size_t)row * 512 + head * 64 + wc * 32 + 4 * fq;
                        *(u32x2*)p = (u32x2){a0, a1}; *(u32x2*)(p + 16) = (u32x2){b0, b1};
                    } else {
                        bf16_t* base = VT + ((size_t)((b * 8 + head) * 64 + (wc - 2) * 32 + 4 * fq)) * SEQ + s;
                        base[0 * SEQ] = (bf16_t)(a0 & 0xffffu); base[1 * SEQ] = (bf16_t)(a0 >> 16); base[2 * SEQ] = (bf16_t)(a1 & 0xffffu); base[3 * SEQ] = (bf16_t)(a1 >> 16);
                        base[16 * SEQ] = (bf16_t)(b0 & 0xffffu); base[17 * SEQ] = (bf16_t)(b0 >> 16); base[18 * SEQ] = (bf16_t)(b1 & 0xffffu); base[19 * SEQ] = (bf16_t)(b1 >> 16);
                    }
                }
                asm volatile("" ::: "memory");
            }
    }
};
struct EpiRes {
    static constexpr bool PERM = false, AFTER_DRAIN = false;
    const float* base; float* out; const float* gate;
    __device__ __forceinline__ void operator()(const f32x4 (&acc)[2][2][4][2], const pg8::Unit& u, int wr, int wc, int fr, int fq) const {
        const int row0 = u.pm * 256 + wr * 64 + fr, b = u.pm >> 3;
#pragma unroll
        for (int bj = 0; bj < 2; ++bj)
#pragma unroll
            for (int n = 0; n < 2; ++n) {
                const int col = u.pn * 256 + bj * 128 + wc * 32 + n * 16 + 4 * fq;
                const f32x4 gv = *(const f32x4*)(gate + b * 6144 + col);
#pragma unroll
                for (int ai = 0; ai < 2; ++ai)
#pragma unroll
                    for (int m = 0; m < 4; ++m) {
                        const size_t off = (size_t)(row0 + ai * 128 + m * 16) * DM + col;
                        const f32x4 bs = *(const f32x4*)(base + off);
                        *(f32x4*)(out + off) = bs + gv * acc[ai][bj][m][n];
                    }
            }
    }
};
struct EpiUp {
    static constexpr bool PERM = true, AFTER_DRAIN = false;
    bf16_t* U;
    __device__ __forceinline__ void operator()(const f32x4 (&acc)[2][2][4][2], const pg8::Unit& u, int wr, int wc, int fr, int fq) const {
        const int row0 = u.pm * 256 + wr * 64 + fr, col0 = u.pn * 256 + wc * 32 + 8 * fq;
#pragma unroll
        for (int ai = 0; ai < 2; ++ai)
#pragma unroll
            for (int m = 0; m < 4; ++m) {
                bf16_t* rowp = U + (size_t)(row0 + ai * 128 + m * 16) * FF + col0;
#pragma unroll
                for (int bj = 0; bj < 2; ++bj) {
                    f32x4 v0 = acc[ai][bj][m][0], v1 = acc[ai][bj][m][1];
#pragma unroll
                    for (int j = 0; j < 4; ++j) { const float a = fmaxf(v0[j], 0.f), c = fmaxf(v1[j], 0.f); v0[j] = a * a; v1[j] = c * c; }
                    u32x4 w; w.x = pk2(v0[0], v0[1]); w.y = pk2(v0[2], v0[3]); w.z = pk2(v1[0], v1[1]); w.w = pk2(v1[2], v1[3]);
                    st16_wt(rowp + bj * 128, w);
                }
            }
    }
};


struct PanelX {
    float* ssq; unsigned* cnt;
    __device__ __forceinline__ void exchange(const f32x4 (&v)[2][2][4][2], const pg8::Unit& u, int wr, int fr, int fq) const {
        const int row0 = u.pm * 256 + wr * 64 + fr;
#pragma unroll
        for (int ai = 0; ai < 2; ++ai)
#pragma unroll
            for (int m = 0; m < 4; ++m) {
                float s = 0.f;
#pragma unroll
                for (int bj = 0; bj < 2; ++bj)
#pragma unroll
                    for (int n = 0; n < 2; ++n) { const f32x4 x = v[ai][bj][m][n]; s += (x[0] * x[0] + x[1] * x[1]) + (x[2] * x[2] + x[3] * x[3]); }
                s += __shfl_xor(s, 16); s += __shfl_xor(s, 32);
                if (fq == 0) unsafeAtomicAdd(ssq + row0 + ai * 128 + m * 16, s);
            }
        asm volatile("s_waitcnt vmcnt(0)" ::: "memory");
        __syncthreads();
        if (threadIdx.x == 0) {
            unsigned* c = cnt + 64 * u.pm;
            __builtin_amdgcn_fence(__ATOMIC_RELEASE, "agent");
            __hip_atomic_fetch_add(c, 1u, __ATOMIC_RELAXED, __HIP_MEMORY_SCOPE_AGENT);
            unsigned sp = 0;
            while (__hip_atomic_load(c, __ATOMIC_RELAXED, __HIP_MEMORY_SCOPE_AGENT) < 4u) { __builtin_amdgcn_s_sleep(1); if (++sp > (1u << 22)) break; }
            __builtin_amdgcn_fence(__ATOMIC_ACQUIRE, "agent");
        }
        __syncthreads();
    }
    __device__ __forceinline__ float rstd(int row) const { return __builtin_amdgcn_rsqf(__hip_atomic_load(ssq + row, __ATOMIC_RELAXED, __HIP_MEMORY_SCOPE_AGENT) * (1.0f / DM) + EPS); }
};
struct EpiResNorm {
    static constexpr bool PERM = true, AFTER_DRAIN = true;
    const float* base; bf16_t* X1; bf16_t* H; const float* mod; const float* g; PanelX px;
    __device__ __forceinline__ void fused(f32x4 (&acc)[2][2][4][2], const pg8::Unit& u, int wr, int wc, int fr, int fq) const {
        const int row0 = u.pm * 256 + wr * 64 + fr, b = u.pm >> 3, col0 = u.pn * 256 + wc * 32 + 8 * fq;
        const float* mb = mod + b * 6144 + col0;
        {
            f32x4 gv[2][2];
#pragma unroll
            for (int bj = 0; bj < 2; ++bj)
#pragma unroll
                for (int n = 0; n < 2; ++n) gv[bj][n] = *(const f32x4*)(mb + 2 * 1024 + bj * 128 + n * 4);
#pragma unroll
            for (int ai = 0; ai < 2; ++ai)
#pragma unroll
                for (int m = 0; m < 4; ++m) {
                    const size_t off = (size_t)(row0 + ai * 128 + m * 16) * DM + col0;
                    const float* bp = base + off; bf16_t* op = X1 + off;
#pragma unroll
                    for (int bj = 0; bj < 2; ++bj) {
                        const f32x4 v0 = __builtin_nontemporal_load((const f32x4*)(bp + bj * 128)) + gv[bj][0] * acc[ai][bj][m][0], v1 = __builtin_nontemporal_load((const f32x4*)(bp + bj * 128 + 4)) + gv[bj][1] * acc[ai][bj][m][1];
                        acc[ai][bj][m][0] = v0; acc[ai][bj][m][1] = v1;
                        *(u32x4*)(op + bj * 128) = (u32x4){pk2(v0[0], v0[1]), pk2(v0[2], v0[3]), pk2(v1[0], v1[1]), pk2(v1[2], v1[3])};
                    }
                    if (m & 1) asm volatile("" ::: "memory");
                }
        }
        px.exchange(acc, u, wr, fr, fq);
        int row0b = row0; asm volatile("" : "+v"(row0b));
        {
            f32x4 gs[2][2], sh[2][2];
#pragma unroll
            for (int bj = 0; bj < 2; ++bj)
#pragma unroll
                for (int n = 0; n < 2; ++n) {
                    gs[bj][n] = *(const f32x4*)(g + col0 + bj * 128 + n * 4) * (*(const f32x4*)(mb + 4 * 1024 + bj * 128 + n * 4) + 1.0f);
                    sh[bj][n] = *(const f32x4*)(mb + 3 * 1024 + bj * 128 + n * 4);
                }
#pragma unroll
            for (int ai = 0; ai < 2; ++ai)
#pragma unroll
                for (int m = 0; m < 4; ++m) {
                    const int row = row0b + ai * 128 + m * 16;
                    const float rs = px.rstd(row);
                    bf16_t* hp = H + (size_t)row * DM + col0;
#pragma unroll
                    for (int bj = 0; bj < 2; ++bj) {
                        const f32x4 y0 = acc[ai][bj][m][0] * rs * gs[bj][0] + sh[bj][0], y1 = acc[ai][bj][m][1] * rs * gs[bj][1] + sh[bj][1];
                        st16_wt(hp + bj * 128, (u32x4){pk2(y0[0], y0[1]), pk2(y0[2], y0[3]), pk2(y1[0], y1[1]), pk2(y1[2], y1[3])});
                    }
                    if (m & 1) asm volatile("" ::: "memory");
                }
        }
    }
};
struct EpiResFinal {
    static constexpr bool PERM = false, AFTER_DRAIN = true;
    const bf16_t* X1; float* out; const float* mod; const float* fg; PanelX px;
    __device__ __forceinline__ void fused(f32x4 (&acc)[2][2][4][2], const pg8::Unit& u, int wr, int wc, int fr, int fq) const {
        const int row0 = u.pm * 256 + wr * 64 + fr, b = u.pm >> 3, col0 = u.pn * 256 + wc * 32 + 4 * fq;
        const float* mb = mod + b * 6144 + col0;
        {
            f32x4 gv[2][2];
#pragma unroll
            for (int bj = 0; bj < 2; ++bj)
#pragma unroll
                for (int n = 0; n < 2; ++n) gv[bj][n] = *(const f32x4*)(mb + 5 * 1024 + bj * 128 + n * 16);
#pragma unroll
            for (int ai = 0; ai < 2; ++ai)
#pragma unroll
                for (int m = 0; m < 4; ++m) {
                    const bf16_t* bp = X1 + (size_t)(row0 + ai * 128 + m * 16) * DM + col0;
#pragma unroll
                    for (int bj = 0; bj < 2; ++bj)
#pragma unroll
                        for (int n = 0; n < 2; ++n) { const u32x2 w = __builtin_nontemporal_load((const u32x2*)(bp + bj * 128 + n * 16));
                            const f32x4 xb = (f32x4){__uint_as_float(w.x << 16), __uint_as_float(w.x & 0xffff0000u), __uint_as_float(w.y << 16), __uint_as_float(w.y & 0xffff0000u)};
                            acc[ai][bj][m][n] = xb + gv[bj][n] * acc[ai][bj][m][n]; }
                    asm volatile("" : "+v"(acc[ai][0][m][0]), "+v"(acc[ai][0][m][1]), "+v"(acc[ai][1][m][0]), "+v"(acc[ai][1][m][1]));
                    if (m & 1) asm volatile("" ::: "memory");
                }
        }
        px.exchange(acc, u, wr, fr, fq);
        int row0b = row0; asm volatile("" : "+v"(row0b));
        {
            f32x4 fgv[2][2];
#pragma unroll
            for (int bj = 0; bj < 2; ++bj)
#pragma unroll
                for (int n = 0; n < 2; ++n) fgv[bj][n] = *(const f32x4*)(fg + col0 + bj * 128 + n * 16);
#pragma unroll
            for (int ai = 0; ai < 2; ++ai)
#pragma unroll
                for (int m = 0; m < 4; ++m) {
                    const int row = row0b + ai * 128 + m * 16;
                    const float rs = px.rstd(row);
                    float* op = out + (size_t)row * DM + col0;
#pragma unroll
                    for (int bj = 0; bj < 2; ++bj)
#pragma unroll
                        for (int n = 0; n < 2; ++n) *(f32x4*)(op + bj * 128 + n * 16) = acc[ai][bj][m][n] * rs * fgv[bj][n];
                    if (m & 1) asm volatile("" ::: "memory");
                }
        }
    }
};

constexpr int KSTR = 208, VSTR = 136, VOFF = 64 * KSTR;
template <int QKD, int MODE>
__device__ __forceinline__ void attn_unit(LAS unsigned char* lds, const bf16_t* Q, int ldq, const bf16_t* K1, int ldk1, const bf16_t* K2, int ldk2,
                                          const bf16_t* VT, bf16_t* O, int qpos0, int t_lo, int t_hi, float slope2, float sink2, int tid, int wid, int lane) {
    const int r = lane & 31, hi = lane >> 5;
    const int q0 = qpos0 + 32 * wid;
    constexpr int NKB = QKD / 16;
    bf16x8 qf[NKB];
#pragma unroll
    for (int kb = 0; kb < NKB; ++kb) qf[kb] = *(const bf16x8*)(Q + (size_t)(32 * wid + r) * ldq + 16 * kb + 8 * hi);
    f32x16 o0, o1;
#pragma unroll
    for (int i = 0; i < 16; ++i) { o0[i] = 0.f; o1[i] = 0.f; }
    float mrun = (MODE == 1) ? sink2 : -1e30f;
    float lsum = (MODE == 1) ? (hi == 0 ? 1.f : 0.f) : 0.f;
    const int key1 = tid >> 3, ch1 = tid & 7, key2 = (tid >> 2) & 63, ch2 = tid & 3;
    u32x4 kr, k2r, vr;
    kr = *(const u32x4*)(K1 + (size_t)(64 * t_lo + key1) * ldk1 + ch1 * 8);
    if (QKD == 96) { if (tid < 256) k2r = *(const u32x4*)(K2 + (size_t)(64 * t_lo + key2) * ldk2 + ch2 * 8); }
    vr = *(const u32x4*)(VT + (size_t)key1 * SEQ + 64 * t_lo + ch1 * 8);
    for (int t = t_lo; t <= t_hi; ++t) {
        __syncthreads();
        *(LAS u32x4*)(lds + key1 * KSTR + ch1 * 16) = kr;
        if (QKD == 96) { if (tid < 256) *(LAS u32x4*)(lds + key2 * KSTR + 128 + ch2 * 16) = k2r; }
        *(LAS u32x2*)(lds + VOFF + key1 * VSTR + ch1 * 16) = (u32x2){vr.x, vr.y};
        *(LAS u32x2*)(lds + VOFF + key1 * VSTR + ch1 * 16 + 8) = (u32x2){vr.z, vr.w};
        __syncthreads();
        if (t < t_hi) {
            kr = *(const u32x4*)(K1 + (size_t)(64 * (t + 1) + key1) * ldk1 + ch1 * 8);
            if (QKD == 96) { if (tid < 256) k2r = *(const u32x4*)(K2 + (size_t)(64 * (t + 1) + key2) * ldk2 + ch2 * 8); }
            vr = *(const u32x4*)(VT + (size_t)key1 * SEQ + 64 * (t + 1) + ch1 * 8);
        }
        const int k0 = 64 * t;
        const bool active = (MODE == 0) ? (k0 <= q0 + 31) : ((k0 + 63 >= q0 - 127) && (k0 <= q0 + 31));
        if (active) {
            f32x16 s[2];
#pragma unroll
            for (int sub = 0; sub < 2; ++sub) {
#pragma unroll
                for (int i = 0; i < 16; ++i) s[sub][i] = 0.f;
#pragma unroll
                for (int kb = 0; kb < NKB; ++kb) {
                    const bf16x8 kf = *(const LAS bf16x8*)(lds + (32 * sub + r) * KSTR + (16 * kb + 8 * hi) * 2);
                    s[sub] = __builtin_amdgcn_mfma_f32_32x32x16_bf16(kf, qf[kb], s[sub], 0, 0, 0);
                }
            }
            const int qp = q0 + r;
            if (MODE == 0) {
                if (k0 + 63 > q0) {
#pragma unroll
                    for (int sub = 0; sub < 2; ++sub)
#pragma unroll
                        for (int i = 0; i < 16; ++i) { const int key = k0 + 32 * sub + (i & 3) + 8 * (i >> 2) + 4 * hi; if (key > qp) s[sub][i] = -INFINITY; }
                }
            } else {
#pragma unroll
                for (int sub = 0; sub < 2; ++sub)
#pragma unroll
                    for (int i = 0; i < 16; ++i) { const int key = k0 + 32 * sub + (i & 3) + 8 * (i >> 2) + 4 * hi; const int dist = qp - key;
                        s[sub][i] = (dist < 0 || dist >= 128) ? -INFINITY : (s[sub][i] - slope2 * (float)dist); }
            }
            float mx = -INFINITY;
#pragma unroll
            for (int sub = 0; sub < 2; ++sub)
#pragma unroll
                for (int i = 0; i < 16; ++i) mx = fmaxf(mx, s[sub][i]);
            mx = fmaxf(mx, __shfl_xor(mx, 32));
            const float mn = fmaxf(mrun, mx);
            const float alpha = __builtin_amdgcn_exp2f(mrun - mn);
            mrun = mn;
            float psum = 0.f;
#pragma unroll
            for (int sub = 0; sub < 2; ++sub)
#pragma unroll
                for (int i = 0; i < 16; ++i) { const float p = __builtin_amdgcn_exp2f(s[sub][i] - mn); s[sub][i] = p; psum += p; }
            lsum = lsum * alpha + psum;
            o0 = o0 * alpha; o1 = o1 * alpha;
#pragma unroll
            for (int sub = 0; sub < 2; ++sub)
#pragma unroll
                for (int jb = 0; jb < 2; ++jb) {
                    u32x4 pw;
                    pw.x = pk2(s[sub][8 * jb + 0], s[sub][8 * jb + 1]); pw.y = pk2(s[sub][8 * jb + 2], s[sub][8 * jb + 3]);
                    pw.z = pk2(s[sub][8 * jb + 4], s[sub][8 * jb + 5]); pw.w = pk2(s[sub][8 * jb + 6], s[sub][8 * jb + 7]);
                    const bf16x8 pf = __builtin_bit_cast(bf16x8, pw);
                    const LAS unsigned char* vp = lds + VOFF + r * VSTR + (32 * sub + 16 * jb + 4 * hi) * 2;
                    {
                        const u32x2 a = *(const LAS u32x2*)vp, b = *(const LAS u32x2*)(vp + 16);
                        const bf16x8 vf = __builtin_bit_cast(bf16x8, (u32x4){a.x, a.y, b.x, b.y});
                        o0 = __builtin_amdgcn_mfma_f32_32x32x16_bf16(vf, pf, o0, 0, 0, 0);
                    }
                    {
                        const u32x2 a = *(const LAS u32x2*)(vp + 32 * VSTR), b = *(const LAS u32x2*)(vp + 32 * VSTR + 16);
                        const bf16x8 vf = __builtin_bit_cast(bf16x8, (u32x4){a.x, a.y, b.x, b.y});
                        o1 = __builtin_amdgcn_mfma_f32_32x32x16_bf16(vf, pf, o1, 0, 0, 0);
                    }
                }
        }
    }
    const float ltot = lsum + __shfl_xor(lsum, 32);
    const float inv = 1.0f / ltot;
    bf16_t* op = O + (size_t)(32 * wid + r) * DM + 4 * hi;
#pragma unroll
    for (int g = 0; g < 4; ++g) {
        *(u32x2*)(op + 8 * g) = (u32x2){pk2(o0[4 * g] * inv, o0[4 * g + 1] * inv), pk2(o0[4 * g + 2] * inv, o0[4 * g + 3] * inv)};
        *(u32x2*)(op + 32 + 8 * g) = (u32x2){pk2(o1[4 * g] * inv, o1[4 * g + 1] * inv), pk2(o1[4 * g + 2] * inv, o1[4 * g + 3] * inv)};
    }
}

struct TrDesc { const float* W; bf16_t* WT; const float* ks; int K, N, item; };
__device__ __forceinline__ void tr_load(const TrDesc& d, f32x4 (&v)[8], int lane) {
    const int nblk = d.N / 32, kb = d.item / nblk, nb = d.item % nblk, k0 = 64 * kb, n0 = 32 * nb;
    const int kk0 = lane >> 3, n4 = lane & 7;
#pragma unroll
    for (int i = 0; i < 8; ++i) v[i] = __builtin_nontemporal_load((const f32x4*)(d.W + (size_t)(k0 + kk0 + 8 * i) * d.N + n0 + 4 * n4));
}
__device__ __forceinline__ void tr_finish(const TrDesc& d, f32x4 (&v)[8], LAS float* scr, int lane) {
    const int nblk = d.N / 32, kb = d.item / nblk, nb = d.item % nblk, k0 = 64 * kb, n0 = 32 * nb;
    const int kk0 = lane >> 3, n4 = lane & 7;
    if (d.ks) {
#pragma unroll
        for (int i = 0; i < 8; ++i) v[i] = v[i] * d.ks[k0 + kk0 + 8 * i];
    }
#pragma unroll
    for (int i = 0; i < 8; ++i) { LAS float* p = scr + (kk0 + 8 * i) * 33 + 4 * n4; p[0] = v[i][0]; p[1] = v[i][1]; p[2] = v[i][2]; p[3] = v[i][3]; }
    asm volatile("s_waitcnt lgkmcnt(0)" ::: "memory");
    const int c = lane & 7;
#pragma unroll
    for (int j = 0; j < 4; ++j) { const int n = (lane >> 3) + 8 * j; const LAS float* s = scr + (8 * c) * 33 + n;
        u32x4 o; o.x = pk2(s[0 * 33], s[1 * 33]); o.y = pk2(s[2 * 33], s[3 * 33]); o.z = pk2(s[4 * 33], s[5 * 33]); o.w = pk2(s[6 * 33], s[7 * 33]);
        *(u32x4*)(d.WT + (size_t)(n0 + n) * d.K + k0 + 8 * c) = o; }
    asm volatile("s_waitcnt lgkmcnt(0)" ::: "memory");
}
struct TrSet { const float *w_in, *w_qb, *w_kvb, *w_o, *w_up, *w_down, *g_qa, *g_kva; bf16_t *win_t, *wqb_t, *wkvb_t, *wo_t, *wup_t, *wdn_t; };
constexpr int I_IN = 16 * 45, I_QB = 6 * 24, I_KVB = 4 * 32, I_O = 16 * 32, I_UP = 16 * 128, I_DN = 64 * 32;
constexpr int NITEMS_EARLY = I_IN + I_QB + I_KVB, NITEMS_LATE = I_O + I_UP + I_DN;
__device__ __forceinline__ TrDesc tr_desc(const TrSet& T, int it) {
    int r = it;
    if (r < I_IN) return TrDesc{T.w_in, T.win_t, nullptr, DM, IN_COLS, r}; r -= I_IN;
    if (r < I_QB) return TrDesc{T.w_qb, T.wqb_t, T.g_qa, QL, QW, r}; r -= I_QB;
    if (r < I_KVB) return TrDesc{T.w_kvb, T.wkvb_t, T.g_kva, KVL, KVW, r}; r -= I_KVB;
    if (r < I_O) return TrDesc{T.w_o, T.wo_t, nullptr, DM, DM, r}; r -= I_O;
    if (r < I_UP) return TrDesc{T.w_up, T.wup_t, nullptr, DM, FF, r}; r -= I_UP;
    return TrDesc{T.w_down, T.wdn_t, nullptr, FF, DM, r};
}
__device__ __forceinline__ void tr_run(const TrSet& T, int first, int last, int w, int nw, LAS float* scr, int lane) {
    int it = first + w;
    if (it >= last) return;
    TrDesc d = tr_desc(T, it); f32x4 v[8]; tr_load(d, v, lane);
    for (;;) {
        const int itn = it + nw;
        if (itn < last) {
            const TrDesc dn = tr_desc(T, itn); f32x4 vn[8]; tr_load(dn, vn, lane);
            tr_finish(d, v, scr, lane);
            d = dn;
#pragma unroll
            for (int i = 0; i < 8; ++i) v[i] = vn[i];
            it = itn;
        } else { tr_finish(d, v, scr, lane); break; }
    }
}
__device__ __forceinline__ void p0_mod_block(const float* c, const float* w_ada, const float* b_ada, float* mod, LAS unsigned char* lds, int blk, int tid) {
    LAS float* sl = (LAS float*)lds;
    LAS float* part = (LAS float*)(lds + 32768);
    for (int i = tid; i < 8 * DM; i += 512) { const float x = c[i]; sl[i] = x / (1.0f + __expf(-x)); }
    __syncthreads();
    const int c4 = tid % 6, r = tid / 6;
    if (r < 85) {
        f32x4 acc[8];
#pragma unroll
        for (int b = 0; b < 8; ++b) acc[b] = (f32x4){0.f, 0.f, 0.f, 0.f};
        const float* wp = w_ada + (size_t)r * 6144 + 24 * blk + 4 * c4;
        f32x4 w[12];
#pragma unroll
        for (int i = 0; i < 12; ++i) w[i] = __builtin_nontemporal_load((const f32x4*)(wp + (size_t)(85 * i) * 6144));
        f32x4 wt = (f32x4){0.f, 0.f, 0.f, 0.f};
        if (r < 4) wt = __builtin_nontemporal_load((const f32x4*)(wp + (size_t)1020 * 6144));
#pragma unroll
        for (int i = 0; i < 12; ++i) {
#pragma unroll
            for (int b = 0; b < 8; ++b) acc[b] += w[i] * sl[b * DM + r + 85 * i];
        }
        if (r < 4) {
#pragma unroll
            for (int b = 0; b < 8; ++b) acc[b] += wt * sl[b * DM + r + 1020];
        }
#pragma unroll
        for (int b = 0; b < 8; ++b)
#pragma unroll
            for (int j = 0; j < 4; ++j) part[r * 192 + b * 24 + 4 * c4 + j] = acc[b][j];
    }
    __syncthreads();
    if (tid < 192) {
        float sum = 0.f;
        for (int rr = 0; rr < 85; ++rr) sum += part[rr * 192 + tid];
        const int b = tid / 24, cc = tid % 24;
        mod[b * 6144 + 24 * blk + cc] = sum + b_ada[24 * blk + cc];
    }
    __syncthreads();
}
__device__ __forceinline__ void rows_load4(const float* x, int m, f32x4 (&v)[16], int lane) {
    const f32x4* xr = (const f32x4*)(x + (size_t)m * DM) + 2 * lane;
#pragma unroll
    for (int q = 0; q < 4; ++q)
#pragma unroll
        for (int jj = 0; jj < 2; ++jj) { v[4 * q + 2 * jj] = __builtin_nontemporal_load(xr + 256 * q + 128 * jj); v[4 * q + 2 * jj + 1] = __builtin_nontemporal_load(xr + 256 * q + 128 * jj + 1); }
}
__device__ __forceinline__ void rows_finish4(const f32x4 (&v)[16], bf16_t* orow, const float* g, const float* sc, const float* sh, int lane) {
    float rs[4];
#pragma unroll
    for (int q = 0; q < 4; ++q) { float t = 0.f;
#pragma unroll
        for (int j = 0; j < 4; ++j) { const f32x4 a = v[4 * q + j]; t += (a[0] * a[0] + a[1] * a[1]) + (a[2] * a[2] + a[3] * a[3]); }
        rs[q] = t; }
#pragma unroll
    for (int o = 1; o < 64; o <<= 1) {
#pragma unroll
        for (int q = 0; q < 4; ++q) rs[q] += __shfl_xor(rs[q], o);
    }
#pragma unroll
    for (int q = 0; q < 4; ++q) rs[q] = 1.0f / sqrtf(rs[q] * (1.0f / DM) + EPS);
#pragma unroll
    for (int jj = 0; jj < 2; ++jj) {
        const int ci = 128 * jj + 2 * lane;
        const f32x4 g0 = ((const f32x4*)g)[ci] * (((const f32x4*)sc)[ci] + 1.0f), g1 = ((const f32x4*)g)[ci + 1] * (((const f32x4*)sc)[ci + 1] + 1.0f);
        const f32x4 h0 = ((const f32x4*)sh)[ci], h1 = ((const f32x4*)sh)[ci + 1];
#pragma unroll
        for (int q = 0; q < 4; ++q) {
            const f32x4 y0 = v[4 * q + 2 * jj] * rs[q] * g0 + h0, y1 = v[4 * q + 2 * jj + 1] * rs[q] * g1 + h1;
            st16_wt(orow + (size_t)q * DM + 512 * jj + 8 * lane, (u32x4){pk2(y0[0], y0[1]), pk2(y0[2], y0[3]), pk2(y1[0], y1[1]), pk2(y1[2], y1[3])});
        }
    }
}
#define XB_TMO      128
#define XB_XCNT(j)  (256  + 64 * (j))
#define XB_XSUB(j)  (1280 + 64 * (j))
#define XB_XGEN(j)  (2304 + 64 * (j))
#define XB_TOP      3328
#define XB_TOPGEN   3392
#define XCD_BAR_WORDS 3456
#define XB_SPIN_CAP (1u << 18)
__device__ __forceinline__ unsigned xb_ld(unsigned* p)              { return __hip_atomic_load(p, __ATOMIC_RELAXED, __HIP_MEMORY_SCOPE_AGENT); }
__device__ __forceinline__ unsigned xb_add(unsigned* p, unsigned v) { return __hip_atomic_fetch_add(p, v, __ATOMIC_RELAXED, __HIP_MEMORY_SCOPE_AGENT); }
__device__ __forceinline__ unsigned xb_xcc_id() { return (unsigned)__builtin_amdgcn_s_getreg((3 << 11) | 20) & 0xFu; }
#define XB_SPIN(cond, bar) do { unsigned _sp = 0; while (cond) { __builtin_amdgcn_s_sleep(1); \
    if ((++_sp & 255u) == 0u) { if (xb_ld(&(bar)[XB_TMO])) break; if (_sp > XB_SPIN_CAP) { atomicAdd(&(bar)[XB_TMO], 1u); break; } } } } while (0)
struct XcdBarrier { unsigned* bar; unsigned x; volatile LAS unsigned* st; };
__device__ __forceinline__ XcdBarrier xcd_barrier_post(unsigned* bar, volatile LAS unsigned* st) {
    XcdBarrier b; b.bar = bar; b.x = xb_xcc_id(); b.st = st;
    if (threadIdx.x == 0) (void)xb_add(&bar[XB_XCNT(b.x)], 1u);
    return b;
}
__device__ __forceinline__ void xcd_barrier_complete(unsigned* bar, unsigned x, unsigned& nloc, unsigned& nx) {
    const unsigned G = gridDim.x * gridDim.y * gridDim.z;
    unsigned sum, cnt, mine, sp = 0u;
    for (;;) {
        sum = 0u; cnt = 0u; mine = 0u;
#pragma unroll
        for (unsigned j = 0; j < 16; ++j) { const unsigned c = xb_ld(&bar[XB_XCNT(j)]); sum += c; cnt += (c > 0u) ? 1u : 0u; mine = (j == x) ? c : mine; }
        if (sum == G) break;
        __builtin_amdgcn_s_sleep(1);
        if ((++sp & 255u) == 0u) { if (xb_ld(&bar[XB_TMO])) break; if (sp > XB_SPIN_CAP) { atomicAdd(&bar[XB_TMO], 1u); break; } }
    }
    nloc = mine > 0u ? mine : 1u; nx = cnt > 0u ? cnt : 1u;
}
__device__ __forceinline__ void xcd_barrier(const XcdBarrier& b) {
    asm volatile("s_waitcnt vmcnt(0)" ::: "memory");
    __syncthreads();
    if (threadIdx.x == 0) {
        unsigned* bar = b.bar;
        __builtin_amdgcn_s_waitcnt(0);
        unsigned nloc = b.st[0], nx = b.st[1];
        if (nloc == 0u) { xcd_barrier_complete(bar, b.x, nloc, nx); b.st[0] = nloc; b.st[1] = nx; }
        const unsigned old = xb_add(&bar[XB_XSUB(b.x)], 1u);
        const unsigned gen = old / nloc;
        if (old + 1u == (gen + 1u) * nloc) {
            __builtin_amdgcn_fence(__ATOMIC_RELEASE, "agent");
            asm volatile("s_waitcnt vmcnt(0)" ::: "memory");
            const unsigned og = xb_add(&bar[XB_TOP], 1u);
            const unsigned tg = og / nx;
            if (og + 1u == (tg + 1u) * nx) xb_add(&bar[XB_TOPGEN], 1u);
            else XB_SPIN(xb_ld(&bar[XB_TOPGEN]) == tg, bar);
            __builtin_amdgcn_fence(__ATOMIC_ACQUIRE, "agent");
            xb_add(&bar[XB_XGEN(b.x)], 1u);
            asm volatile("s_waitcnt vmcnt(0)" ::: "memory");
        } else {
            XB_SPIN(xb_ld(&bar[XB_XGEN(b.x)]) == gen, bar);
            __builtin_amdgcn_fence(__ATOMIC_ACQUIRE, "agent");
            asm volatile("s_waitcnt vmcnt(0)" ::: "memory");
        }
    }
    __syncthreads();
}

struct Args { const float* in[16]; float* out; unsigned char* ws; int ph_lo, ph_hi, pad0, pad1; };
constexpr int NPHASE = 10;

__global__ void __launch_bounds__(512, 2) fwd_megakernel(Args args) {
    extern __shared__ __attribute__((aligned(16))) unsigned char lds_raw[];
    LAS unsigned char* lds = (LAS unsigned char*)lds_raw;
    cg::grid_group grid = cg::this_grid();
    const int tid = threadIdx.x, lane = tid & 63, wave = __builtin_amdgcn_readfirstlane(tid >> 6);
    const int G = gridDim.x, bx = blockIdx.x;
    const int vcu = (G % 8 == 0) ? (bx % 8) * (G / 8) + bx / 8 : bx;
    const int gw = vcu * 8 + wave, NGW = G * 8;
    unsigned char* ws = args.ws;
    const float* x = args.in[0]; const float* cvec = args.in[1]; const float* w_ada = args.in[2]; const float* b_ada = args.in[3];
    const float* norm_mix_g = args.in[4]; const float* w_in = args.in[5]; const float* g_qa = args.in[6]; const float* w_qb = args.in[7];
    const float* g_kva = args.in[8]; const float* w_kvb = args.in[9]; const float* sinks = args.in[10]; const float* w_o = args.in[11];
    const float* norm_mlp_g = args.in[12]; const float* w_up = args.in[13]; const float* w_down = args.in[14]; const float* final_g = args.in[15];
    float* out = args.out;
    float* mod = (float*)(ws + WS_MOD); float* ssq_q = (float*)(ws + WS_SSQQ); float* ssq_kv = (float*)(ws + WS_SSQKV);
    float* ropec = (float*)(ws + WS_ROPE); float* ropes = ropec + SEQ * 16;
    bf16_t* win_t = (bf16_t*)(ws + WS_WIN); bf16_t* wqb_t = (bf16_t*)(ws + WS_WQB); bf16_t* wkvb_t = (bf16_t*)(ws + WS_WKVB);
    bf16_t* wo_t = (bf16_t*)(ws + WS_WO); bf16_t* wup_t = (bf16_t*)(ws + WS_WUP); bf16_t* wdn_t = (bf16_t*)(ws + WS_WDN);
    bf16_t* hbuf = (bf16_t*)(ws + WS_H); bf16_t* proj = (bf16_t*)(ws + WS_PROJ); bf16_t* qbuf = (bf16_t*)(ws + WS_Q); bf16_t* knope = (bf16_t*)(ws + WS_KN);
    bf16_t* vtm = (bf16_t*)(ws + WS_VTM); bf16_t* vts = (bf16_t*)(ws + WS_VTS); bf16_t* mix = (bf16_t*)(ws + WS_MIX); bf16_t* ubuf = (bf16_t*)(ws + WS_U); bf16_t* x1b = (bf16_t*)(ws + WS_X1);

    const TrSet TS{w_in, w_qb, w_kvb, w_o, w_up, w_down, g_qa, g_kva, win_t, wqb_t, wkvb_t, wo_t, wup_t, wdn_t};
    const int lo = args.ph_lo, hi = args.ph_hi;
    volatile LAS unsigned* bst = (volatile LAS unsigned*)(lds + 131072);
    if (tid < 2) bst[tid] = 0u;
    __syncthreads();
    XcdBarrier xbar; xbar.bar = (unsigned*)(ws + WS_BAR); xbar.x = 0; xbar.st = bst;
    if (hi - lo > 1) xbar = xcd_barrier_post((unsigned*)(ws + WS_BAR), bst);
    if (lo < 0) grid.sync();
#ifndef PH_MASK
#define PH_MASK 0x3ff
#endif
#define IN(k) (((PH_MASK >> (k)) & 1) && lo <= (k) && (k) < hi)
#define GSYNC() xcd_barrier(xbar)
#define SEAM2(k, k2) do { if (IN(k) && IN(k2)) GSYNC(); } while (0)
#define SEAM(k) SEAM2(k, (k) + 1)
#ifndef REPMASK
#define REPMASK 0
#endif
#ifndef REPN
#define REPN 3
#endif
#ifndef XSYNC
#define XSYNC 0
#endif
#ifndef TPROBE
#define TPROBE -1
#endif
#define STAMP(j) do { if (TPROBE >= 0 && bx == 0 && wave == 0) { if ((j) == TPROBE) tp0 = __builtin_amdgcn_s_memrealtime(); if ((j) == TPROBE + 1) tp1 = __builtin_amdgcn_s_memrealtime(); } } while (0)
#define REP(k) for (int rep_ = 0; rep_ < (((REPMASK >> (k)) & 1) ? REPN : 1); ++rep_)

    unsigned long long tp0 = 0, tp1 = 0;
    STAMP(0);
    const int pm_t = 8 * (bx & 7) + ((bx >> 3) & 7), mj = bx >> 6, bt = pm_t >> 3;
    const int rm0 = 256 * pm_t + 64 * mj + 8 * wave;
    if (IN(0)) {
        LAS float* scr = (LAS float*)(lds + wave * 16384);
        p0_mod_block(cvec, w_ada, b_ada, mod, lds, bx, tid);
        tr_run(TS, 0, NITEMS_EARLY, gw, NGW, scr, lane);
        const int gt = vcu * 512 + tid, NGT = G * 512;
        for (int i = gt; i < (NPROJ - IN_COLS) * DM / 8; i += NGT) ((u32x4*)(win_t + (size_t)IN_COLS * DM))[i] = (u32x4){0u, 0u, 0u, 0u};
        for (int i = gt; i < SEQ * 16; i += NGT) {
            const int pos = i >> 4, fi = i & 15;
            double f = (fi & 3) == 0 ? 1.0 : ((fi & 3) == 1 ? 0.5623413251903491 : ((fi & 3) == 2 ? 0.31622776601683794 : 0.1778279410038923));
            const int dec = fi >> 2; f *= (dec == 0 ? 1.0 : (dec == 1 ? 0.1 : (dec == 2 ? 0.01 : 0.001)));
            const float ang32 = (float)pos * (float)f;
            const double rev = (double)ang32 * 0.15915494309189535;
            const float fr = (float)(rev - __builtin_rint(rev));
            ropec[i] = __builtin_amdgcn_cosf(fr); ropes[i] = __builtin_amdgcn_sinf(fr);
        }
    }
    f32x4 rv[16], rvn[16];
    rows_load4(x, rm0, rv, lane); rows_load4(x, rm0 + 4, rvn, lane);
    SEAM(0);
    STAMP(1);
    for (int xs_ = 0; xs_ < XSYNC; ++xs_) GSYNC();
    if (IN(1)) {
        unsigned* tc = (unsigned*)(ws + WS_CNT) + 64 * pm_t;
        {
            rows_finish4(rv, hbuf + (size_t)rm0 * DM, norm_mix_g, mod + bt * 6144 + 1024, mod + bt * 6144, lane);
            rows_finish4(rvn, hbuf + (size_t)(rm0 + 4) * DM, norm_mix_g, mod + bt * 6144 + 1024, mod + bt * 6144, lane);
        }
        team_wait(tc + 4 * 64 * 64);
#pragma unroll 1
        for (int rnd = 0; rnd < 2; ++rnd) {
            if (rnd == 0 || mj < 2) {
                pg8::Gemm g{hbuf, win_t, MT, NPROJ, DM, DM}; const pg8::ListOrder S{pm_t, 1, rnd == 0 ? mj : 4 + mj, 0};
                EpiProj E{proj, ssq_q, ssq_kv, ropec, ropes, vts};
                pg8::gemm_phase<EpiProj, true, pg8::ListOrder>(lds, g, S, E);
            }
            if (rnd == 0) team_wait(tc + 5 * 64 * 64);
        }
        { pg8::Gemm g{proj, wqb_t, MT, QW, QL, NPROJ}; const pg8::ListOrder S{pm_t, mj == 2 ? 2 : (mj == 3 ? 1 : 0), mj == 2 ? 0 : 2, 1};
          EpiQ E{qbuf, ssq_q, ropec, ropes}; pg8::gemm_phase<EpiQ, true, pg8::ListOrder>(lds, g, S, E); }
        { pg8::Gemm g{proj + QL, wkvb_t, MT, KVW, KVL, NPROJ}; const pg8::ListOrder S{pm_t, mj == 3 ? 2 : (mj == 2 ? 0 : 1), mj == 3 ? 2 : mj, 3};
          EpiKV E{knope, vtm, ssq_kv}; pg8::gemm_phase<EpiKV, true, pg8::ListOrder>(lds, g, S, E); }
        if (mj < 3) {
            LAS float* scr = (LAS float*)(lds + wave * 16384);
            const int f0 = NITEMS_EARLY + 72 * pm_t + 24 * mj;
            tr_run(TS, f0, f0 + 24, wave, 8, scr, lane);
        }
    }
    STAMP(2); STAMP(3);
    SEAM2(1, 4);
    STAMP(4);
    REP(4) { if (rep_) GSYNC();
    if (IN(4)) {
        if (wave >= 4) __builtin_amdgcn_s_setprio(1);
        for (int it = vcu; it < 768; it += G) {
            if (it < 256) {
                const int b = it >> 5, h = (it >> 2) & 7, pp = it & 3;
#pragma unroll 1
                for (int k = 0; k < 2; ++k) {
                    const int qb = k == 0 ? 7 - pp : pp;
                    const size_t row0 = (size_t)b * SEQ + qb * 256;
                    attn_unit<96, 0>(lds, qbuf + row0 * QW + h * 96, QW, knope + (size_t)b * SEQ * 512 + h * 64, 512, proj + (size_t)b * SEQ * NPROJ + 640, NPROJ,
                                     vtm + (size_t)(b * 8 + h) * 64 * SEQ, mix + row0 * DM + h * 64, qb * 256, 0, 4 * qb + 3, 0.f, 0.f, tid, wave, lane);
                }
            } else {
                const int id = it - 256, b = id >> 6, hq = (id >> 3) & 7, qb = id & 7, kvh = hq >> 2;
                const size_t row0 = (size_t)b * SEQ + qb * 256;
                const float slope2 = exp2f(-(float)(hq + 1)) * LOG2E, sink2 = sinks[hq] * LOG2E;
                attn_unit<64, 1>(lds, proj + row0 * NPROJ + 672 + hq * 64, NPROJ, proj + (size_t)b * SEQ * NPROJ + 1184 + kvh * 64, NPROJ, nullptr, 0,
                                 vts + (size_t)(b * 2 + kvh) * 64 * SEQ, mix + row0 * DM + 512 + hq * 64, qb * 256, qb == 0 ? 0 : 4 * qb - 2, 4 * qb + 3, slope2, sink2, tid, wave, lane);
            }
        }
        __builtin_amdgcn_s_setprio(0);
        __syncthreads();
    }
    }
    SEAM(4);
    STAMP(5);
    if (IN(5)) {
        pg8::Gemm g{mix, wo_t, MT, DM, DM, DM}; pg8::StaticOrder S; S.init(MT, DM, G, bx);
        EpiResNorm E{x, x1b, hbuf, mod, norm_mlp_g, PanelX{(float*)(ws + WS_SSQX1), (unsigned*)(ws + WS_CNT)}};
        pg8::gemm_phase<EpiResNorm, false>(lds, g, S, E);
    }
    if (IN(5) && IN(7)) { pg8::StaticOrder S; S.init(MT, DM, G, bx); pg8::Unit u; S.next(0, u); team_wait((unsigned*)(ws + WS_CNT) + 2 * 64 * 64 + 64 * u.pm); }
    STAMP(6);
    REP(7) { if (rep_) GSYNC();
    if (IN(7)) {
        pg8::Gemm g{hbuf, wup_t, MT, FF, DM, DM}; pg8::StaticOrder S; S.init(MT, FF, G, bx);
        EpiUp E{ubuf};
        pg8::gemm_phase<EpiUp, true>(lds, g, S, E);
    }
    }
    if (IN(7) && IN(8)) { pg8::StaticOrder S; S.init(MT, DM, G, bx); pg8::Unit u; S.next(0, u); team_wait((unsigned*)(ws + WS_CNT) + 3 * 64 * 64 + 64 * u.pm); }
    STAMP(7);
    if (IN(8)) {
        pg8::Gemm g{ubuf, wdn_t, MT, DM, FF, FF}; pg8::StaticOrder S; S.init(MT, DM, G, bx);
        EpiResFinal E{x1b, out, mod, final_g, PanelX{(float*)(ws + WS_SSQX2), (unsigned*)(ws + WS_CNT) + 64 * 64}};
        pg8::gemm_phase<EpiResFinal, false>(lds, g, S, E);
    }
    STAMP(8);
    if (TPROBE >= 0 && bx == 0 && wave == 0) { const unsigned long long tgt = __builtin_amdgcn_s_memrealtime() + 4ull * (tp1 - tp0); while (__builtin_amdgcn_s_memrealtime() < tgt) __builtin_amdgcn_s_sleep(8); }
#undef IN
#undef SEAM
}

extern "C" void kernel_launch(void* const* d_in, const int* in_sizes, int n_in, void* d_out, int out_size, void* d_ws, size_t ws_size, hipStream_t stream) {
    static int grid = 0;
    if (grid == 0) {
        if (n_in != 16 || out_size != MT * DM || ws_size < WS_END) { fprintf(stderr, "kernel_launch: unexpected shapes (n_in %d out %d ws %zu)\n", n_in, out_size, ws_size); grid = -1; return; }
        int dev = 0, cus = 0, per_cu = 0;
        hipGetDevice(&dev);
        hipDeviceGetAttribute(&cus, hipDeviceAttributeMultiprocessorCount, dev);
        if (hipFuncSetAttribute((const void*)fwd_megakernel, hipFuncAttributeMaxDynamicSharedMemorySize, LDS_BYTES) != hipSuccess) { fprintf(stderr, "kernel_launch: hipFuncSetAttribute failed\n"); }
        if (hipOccupancyMaxActiveBlocksPerMultiprocessor(&per_cu, (const void*)fwd_megakernel, 512, LDS_BYTES) != hipSuccess || per_cu < 1) { fprintf(stderr, "kernel_launch: occupancy query says %d\n", per_cu); per_cu = 1; }
        (void)hipGetLastError();
        grid = cus * per_cu;
        if (grid != 256) { fprintf(stderr, "kernel_launch: this kernel needs exactly 256 co-resident workgroups (one per CU), got %d\n", grid); grid = -1; return; }
    }
    if (grid < 0) return;
    hipMemsetAsync((char*)d_ws, 0, WS_ZERO_BYTES, stream);
    Args a{};
    for (int i = 0; i < 16; ++i) a.in[i] = (const float*)d_in[i];
    a.out = (float*)d_out; a.ws = (unsigned char*)d_ws;
#if MK_PER_PHASE
    for (int p = 0; p < NPHASE; ++p) {
        a.ph_lo = p; a.ph_hi = p + 1;
        hipLaunchKernelGGL(fwd_megakernel, dim3(grid), dim3(512), LDS_BYTES, stream, a);
    }
#else
    a.ph_lo = 0; a.ph_hi = NPHASE;
    void* kargs[] = {&a};
    hipError_t e = hipLaunchCooperativeKernel((const void*)fwd_megakernel, dim3(grid), dim3(512), kargs, LDS_BYTES, stream);
    if (e != hipSuccess) fprintf(stderr, "cooperative launch failed: %s (grid %d)\n", hipGetErrorString(e), grid);
#endif
}
```

```cpp
#include <hip/hip_runtime.h>
#include <hip/hip_cooperative_groups.h>
#include <cstdio>
#include <cstdint>
namespace cg = cooperative_groups;

#define LAS __attribute__((address_space(3)))
typedef unsigned short bf16_t;
typedef short bf16x8 __attribute__((ext_vector_type(8)));
typedef short s16x4 __attribute__((ext_vector_type(4)));
typedef float f32x4 __attribute__((ext_vector_type(4)));
typedef float f32x2 __attribute__((ext_vector_type(2)));
typedef float f32x16 __attribute__((ext_vector_type(16)));
typedef unsigned u32x4 __attribute__((ext_vector_type(4)));
typedef unsigned u32x2 __attribute__((ext_vector_type(2)));
typedef __bf16 bf2_t __attribute__((ext_vector_type(2)));

#ifndef MK_PER_PHASE
#define MK_PER_PHASE 0
#endif

constexpr int NB = 8, SEQ = 2048, DM = 1024, MT = NB * SEQ, FF = 4096;
constexpr int NPROJ = 1536, IN_COLS = 1440;
constexpr int QL = 384, KVL = 256;
constexpr int QW = 768, KVW = 1024;
constexpr float EPS = 1e-6f;
constexpr float LOG2E = 1.4426950408889634f;
constexpr float QSC_MLA = 0.10206207261596575f * LOG2E;
constexpr float QSC_SWA = 0.125f * LOG2E;

constexpr size_t MiB = 1u << 20;
constexpr size_t WS_MOD = 0, WS_SSQQ = 256 * 1024, WS_SSQKV = 320 * 1024, WS_BAR = 384 * 1024, WS_SSQX1 = 400 * 1024, WS_SSQX2 = 464 * 1024, WS_CNT = 528 * 1024, WS_ZERO_BYTES = 624 * 1024;
constexpr size_t WS_ROPE = 1 * MiB;
constexpr size_t WS_WIN = 2 * MiB, WS_WQB = 5 * MiB, WS_WKVB = 6 * MiB, WS_WO = 7 * MiB, WS_WUP = 9 * MiB, WS_WDN = 17 * MiB;
constexpr size_t WS_H = 25 * MiB, WS_PROJ = 57 * MiB, WS_Q = 105 * MiB, WS_KN = 129 * MiB, WS_VTM = 145 * MiB, WS_VTS = 161 * MiB, WS_MIX = 185 * MiB;
constexpr size_t WS_U = 57 * MiB;
constexpr size_t WS_X1 = 217 * MiB;
constexpr size_t WS_END = 249 * MiB;
constexpr int LDS_BYTES = 131072 + 256;

__device__ __forceinline__ unsigned pk2(float lo, float hi) { f32x2 v = {lo, hi}; bf2_t r = __builtin_convertvector(v, bf2_t); return __builtin_bit_cast(unsigned, r); }
__device__ __forceinline__ bf16_t f2bf(float f) { return (bf16_t)(pk2(f, 0.f) & 0xffffu); }
__device__ __forceinline__ void st16_wt(void* p, u32x4 v) { asm volatile("global_store_dwordx4 %0, %1, off sc1\n\ts_nop 1" :: "v"(p), "v"(v) : "memory"); }
__device__ __forceinline__ void team_wait(unsigned* cnt) {
    asm volatile("s_waitcnt vmcnt(0)" ::: "memory");
    __syncthreads();
    if (threadIdx.x == 0) {
        __hip_atomic_fetch_add(cnt, 1u, __ATOMIC_RELAXED, __HIP_MEMORY_SCOPE_AGENT);
        unsigned sp = 0;
        while (__hip_atomic_load(cnt, __ATOMIC_RELAXED, __HIP_MEMORY_SCOPE_AGENT) < 4u) { __builtin_amdgcn_s_sleep(1); if (++sp > (1u << 22)) break; }
        __builtin_amdgcn_fence(__ATOMIC_ACQUIRE, "agent");
        asm volatile("s_waitcnt vmcnt(0)" ::: "memory");
    }
    __syncthreads();
}
__device__ __forceinline__ float wave_sum(float v) {
#pragma unroll
    for (int o = 1; o < 64; o <<= 1) v += __shfl_xor(v, o);
    return v;
}

namespace pg8 {
constexpr int BM = 256, BK = 64, HALF = 128, HTB = HALF * BK * 2, STAGE_BYTES = 8 * HTB, NXCD = 8, WGM = 8;
__host__ __device__ __forceinline__ int lds_byte(int r, int c) { const int st = (r >> 4) * 2 + (c >> 5), rr = r & 15, cc = c & 31, ob = rr * 64 + cc * 2; return st * 1024 + (ob ^ (((ob >> 9) & 1) << 5)); }
__host__ __device__ __forceinline__ void stage_rc(int b, int& R, int& C) { const int st = b / 1024, sb = b % 1024, swz = sb ^ (((sb >> 9) & 1) << 5); R = (st >> 1) * 16 + swz / 64; C = (st & 1) * 32 + (swz % 64) / 2; }
__host__ __device__ __forceinline__ int perm32(int rho) { const int n = rho >> 4, i = rho & 15; return 8 * (i >> 2) + 4 * n + (i & 3); }

struct Unit { int pm, pn; };
struct Gemm { const bf16_t* A; const bf16_t* Bt; int M, N, K, lda; };

struct StaticOrder {
    int nM, nN, nwg, G, c;
    __device__ void init(int M, int N, int G_, int c_) { nM = M / BM; nN = N / BM; nwg = nM * nN; G = G_; c = c_; }
    __device__ bool next(int i, Unit& u) const {
        const long L = (long)i * G + c; if (L >= nwg) return false;
        int wgid = (int)L; { const int q = nwg / NXCD, r = nwg % NXCD, xcd = wgid % NXCD, off = wgid / NXCD; wgid = (xcd < r ? xcd * (q + 1) : r * (q + 1) + (xcd - r) * q) + off; }
        const int nig = WGM * nN, gid = wgid / nig, fm = gid * WGM, gsz = (nM - fm) < WGM ? (nM - fm) : WGM;
        u.pm = fm + ((wgid % nig) % gsz); u.pn = (wgid % nig) / gsz; return true;
    }
};

struct ListOrder {
    int pm, n, p0, p1;
    __device__ bool next(int i, Unit& u) const { if (i >= n) return false; u.pm = pm; u.pn = (i == 0) ? p0 : p1; return true; }
};
template <class Epi, bool ALIGN_EPI, class Sched = StaticOrder>
__device__ __forceinline__ void gemm_phase(LAS unsigned char* lds, const Gemm g, const Sched& S, const Epi& E) {
    const int tid = threadIdx.x, wid = __builtin_amdgcn_readfirstlane(tid >> 6), lane = tid & 63, wr = wid >> 2, wc = wid & 3, fr = lane & 15, fq = lane >> 4;
    const int K = g.K, nt = K / BK, lda = g.lda;
    unsigned voffA[2], voffB[2];
#pragma unroll
    for (int i = 0; i < 2; ++i) { int R, C; stage_rc(tid * 16 + i * 8192, R, C); const int Rb = Epi::PERM ? ((R & ~31) + perm32(R & 31)) : R;
        voffA[i] = (unsigned)(R * lda + C) * 2u; voffB[i] = (unsigned)(Rb * K + C) * 2u; }
    const size_t kstep = (size_t)(BK * 2);
    const size_t hstepA = (size_t)HALF * lda * 2, hstepB = (size_t)HALF * K * 2;
    const size_t tstepA = 2 * hstepA, tstepB = 2 * hstepB;
    const unsigned ldsw = (unsigned)wid * 1024u;
    const int aoff = lds_byte(wr * 64 + fr, fq * 8), boff = lds_byte(wc * 32 + fr, fq * 8);
#define PG8_SA(b, h) (((b) * 2 + (h)) * HTB)
#define PG8_SB(b, h) ((4 + (b) * 2 + (h)) * HTB)
#define PG8_STAGE(bufoff, gbase, voff) do { _Pragma("unroll") for (int _i = 0; _i < 2; ++_i) \
        __builtin_amdgcn_global_load_lds((const unsigned*)((const char*)(gbase) + (voff)[_i]), (LAS unsigned*)(lds + (bufoff) + ldsw + _i * 8192), 16, 0, 0); } while (0)
#define PG8_LDA(dst, b, h) do { _Pragma("unroll") for (int m = 0; m < 4; ++m) _Pragma("unroll") for (int k = 0; k < 2; ++k) dst[m][k] = *(const LAS bf16x8*)(lds + PG8_SA(b, h) + aoff + m * 2048 + k * 1024); } while (0)
#define PG8_LDB(dst, b, h) do { _Pragma("unroll") for (int n = 0; n < 2; ++n) _Pragma("unroll") for (int k = 0; k < 2; ++k) dst[n][k] = *(const LAS bf16x8*)(lds + PG8_SB(b, h) + boff + n * 2048 + k * 1024); } while (0)
#define PG8_MMA(ai, bj, At, Bt) do { __builtin_amdgcn_s_setprio(1); _Pragma("unroll") for (int m = 0; m < 4; ++m) _Pragma("unroll") for (int n = 0; n < 2; ++n) _Pragma("unroll") for (int k = 0; k < 2; ++k) \
        acc[ai][bj][m][n] = __builtin_amdgcn_mfma_f32_16x16x32_bf16(Bt[n][k], At[m][k], acc[ai][bj][m][n], 0, 0, 0); __builtin_amdgcn_s_setprio(0); } while (0)
#define PG8_WAIT_V(n) asm volatile("s_waitcnt vmcnt(" #n ")" ::: "memory")
#define PG8_WAIT_L(n) asm volatile("s_waitcnt lgkmcnt(" #n ")" ::: "memory")
#define PG8_BAR __builtin_amdgcn_s_barrier()
#define PG8_SCHED __builtin_amdgcn_sched_barrier(0)
    Unit cur, nxt; int ui = 0;
    if (!S.next(0, cur)) return;
    f32x4 acc[2][2][4][2];
#pragma unroll
    for (int a = 0; a < 2; ++a)
#pragma unroll
        for (int b = 0; b < 2; ++b)
#pragma unroll
            for (int m = 0; m < 4; ++m)
#pragma unroll
                for (int n = 0; n < 2; ++n) acc[a][b][m][n] = (f32x4){0.f, 0.f, 0.f, 0.f};
    bf16x8 At[4][2], B0[2][2], B1[2][2];
    const char* cA = (const char*)g.A + (size_t)cur.pm * tstepA; const char* cB = (const char*)g.Bt + (size_t)cur.pn * tstepB;
    {
        PG8_STAGE(PG8_SB(0, 0), cB, voffB); PG8_STAGE(PG8_SB(0, 1), cB + hstepB, voffB); PG8_STAGE(PG8_SA(0, 0), cA, voffA); PG8_STAGE(PG8_SA(0, 1), cA + hstepA, voffA);
        if (wr == 1) PG8_BAR;
        PG8_WAIT_V(2); PG8_BAR;
        PG8_STAGE(PG8_SB(1, 0), cB + kstep, voffB); PG8_STAGE(PG8_SA(1, 0), cA + kstep, voffA); PG8_STAGE(PG8_SB(1, 1), cB + hstepB + kstep, voffB);
        PG8_WAIT_V(6); PG8_BAR;
    }
    for (;;) {
        const bool has_next = S.next(ui + 1, nxt);
        const char* nA = has_next ? (const char*)g.A + (size_t)nxt.pm * tstepA : cA; const char* nB = has_next ? (const char*)g.Bt + (size_t)nxt.pn * tstepB : cB;
#pragma unroll 1
        for (int t = 0; t < nt; t += 2) {
            const bool last = (t == nt - 2);
            const char* a1 = cA + (size_t)(t + 1) * kstep;
            const char* a2 = last ? nA : cA + (size_t)(t + 2) * kstep; const char* b2 = last ? nB : cB + (size_t)(t + 2) * kstep;
            const char* a3 = a2 + kstep; const char* b3 = b2 + kstep;
            PG8_LDB(B0, 0, 0); PG8_LDB(B1, 0, 1); PG8_SCHED; PG8_LDA(At, 0, 0); PG8_STAGE(PG8_SA(1, 1), a1 + hstepA, voffA);
            PG8_WAIT_V(8); PG8_WAIT_L(0); PG8_BAR; PG8_MMA(0, 0, At, B0); PG8_MMA(0, 1, At, B1); PG8_BAR; PG8_SCHED;
            PG8_LDA(At, 0, 1); PG8_STAGE(PG8_SB(0, 0), b2, voffB); PG8_STAGE(PG8_SB(0, 1), b2 + hstepB, voffB); PG8_STAGE(PG8_SA(0, 0), a2, voffA);
            PG8_WAIT_V(8); PG8_WAIT_L(0); PG8_BAR; PG8_MMA(1, 0, At, B0); PG8_MMA(1, 1, At, B1); PG8_BAR; PG8_SCHED;
            PG8_LDB(B0, 1, 0); PG8_LDB(B1, 1, 1); PG8_SCHED; PG8_LDA(At, 1, 0); PG8_STAGE(PG8_SA(0, 1), a2 + hstepA, voffA);
            PG8_WAIT_V(8); PG8_WAIT_L(0); PG8_BAR; PG8_MMA(0, 0, At, B0); PG8_MMA(0, 1, At, B1); PG8_BAR; PG8_SCHED;
            PG8_LDA(At, 1, 1); PG8_STAGE(PG8_SB(1, 0), b3, voffB); PG8_STAGE(PG8_SB(1, 1), b3 + hstepB, voffB); PG8_STAGE(PG8_SA(1, 0), a3, voffA);
            PG8_WAIT_V(8); PG8_WAIT_L(0); PG8_BAR; PG8_MMA(1, 0, At, B0); PG8_MMA(1, 1, At, B1); PG8_BAR; PG8_SCHED;
        }
        if constexpr (ALIGN_EPI) { if (wr == 0) PG8_BAR; }
        if constexpr (!Epi::AFTER_DRAIN) E(acc, cur, wr, wc, fr, fq);
        if (!has_next) break;
#pragma unroll
        for (int a = 0; a < 2; ++a)
#pragma unroll
            for (int b = 0; b < 2; ++b)
#pragma unroll
                for (int m = 0; m < 4; ++m)
#pragma unroll
                    for (int n = 0; n < 2; ++n) acc[a][b][m][n] = (f32x4){0.f, 0.f, 0.f, 0.f};
        cur = nxt; cA = nA; cB = nB; ++ui;
        if constexpr (ALIGN_EPI) { if (wr == 1) PG8_BAR; }
    }
    PG8_WAIT_V(0);
    if constexpr (!ALIGN_EPI) { if (wr == 0) PG8_BAR; }
    PG8_BAR;
    if constexpr (Epi::AFTER_DRAIN) E.fused(acc, cur, wr, wc, fr, fq);
#undef PG8_SA
#undef PG8_SB
#undef PG8_STAGE
#undef PG8_LDA
#undef PG8_LDB
#undef PG8_MMA
#undef PG8_WAIT_V
#undef PG8_WAIT_L
#undef PG8_BAR
#undef PG8_SCHED
}
}


struct EpiProj {
    static constexpr bool PERM = true, AFTER_DRAIN = false;
    bf16_t* P; float* ssq_q; float* ssq_kv; const float* ropec; const float* ropes; bf16_t* vts;
    __device__ __forceinline__ void operator()(const f32x4 (&acc)[2][2][4][2], const pg8::Unit& u, int wr, int wc, int fr, int fq) const {
        const int row0 = u.pm * 256 + wr * 64 + fr;
#pragma unroll
        for (int bj = 0; bj < 2; ++bj) {
            const int cgp = u.pn * 2 + bj;
            const int col = cgp * 128 + wc * 32 + 8 * fq;
            const bool is_q = cgp < 3, is_kv = (cgp == 3 || cgp == 4), is_kpe = (cgp == 5 && wc == 0);
            const bool is_swaq = (cgp == 5 && wc >= 1) || (cgp >= 6 && cgp <= 8) || (cgp == 9 && wc == 0);
            const bool is_swav = (cgp == 10 && wc >= 1) || (cgp == 11 && wc == 0);
#pragma unroll
            for (int ai = 0; ai < 2; ++ai)
#pragma unroll
                for (int m = 0; m < 4; ++m) {
                    const int row = row0 + ai * 128 + m * 16;
                    f32x4 v0 = acc[ai][bj][m][0], v1 = acc[ai][bj][m][1];
                    if (is_q || is_kv) {
                        float s = (v0[0] * v0[0] + v0[1] * v0[1]) + (v0[2] * v0[2] + v0[3] * v0[3]) + (v1[0] * v1[0] + v1[1] * v1[1]) + (v1[2] * v1[2] + v1[3] * v1[3]);
                        s += __shfl_xor(s, 16); s += __shfl_xor(s, 32);
                        if (fq == 0) unsafeAtomicAdd((is_q ? ssq_q : ssq_kv) + row, s);
                    }
                    if (is_kpe) {
                        f32x4 p0, p1;
#pragma unroll
                        for (int j = 0; j < 4; ++j) { p0[j] = __shfl_xor(v0[j], 32); p1[j] = __shfl_xor(v1[j], 32); }
                        const int pos = row & (SEQ - 1), i0 = (8 * fq) & 15;
                        const f32x4 c0 = *(const f32x4*)(ropec + pos * 16 + i0), c1 = *(const f32x4*)(ropec + pos * 16 + i0 + 4);
                        const f32x4 s0 = *(const f32x4*)(ropes + pos * 16 + i0), s1 = *(const f32x4*)(ropes + pos * 16 + i0 + 4);
                        const float sg = fq < 2 ? -1.f : 1.f;
                        v0 = v0 * c0 + p0 * s0 * sg; v1 = v1 * c1 + p1 * s1 * sg;
                    }
                    if (is_swaq) { v0 = v0 * QSC_SWA; v1 = v1 * QSC_SWA; }
                    u32x4 w; w.x = pk2(v0[0], v0[1]); w.y = pk2(v0[2], v0[3]); w.z = pk2(v1[0], v1[1]); w.w = pk2(v1[2], v1[3]);
                    st16_wt(P + (size_t)row * NPROJ + col, w);
                    if (is_swav) {
                        const int d = col - 1312, kvh = d >> 6, dd = d & 63, b = row >> 11, s = row & (SEQ - 1);
                        bf16_t* base = vts + ((size_t)((b * 2 + kvh) * 64 + dd)) * SEQ + s;
                        base[0 * SEQ] = (bf16_t)(w.x & 0xffffu); base[1 * SEQ] = (bf16_t)(w.x >> 16);
                        base[2 * SEQ] = (bf16_t)(w.y & 0xffffu); base[3 * SEQ] = (bf16_t)(w.y >> 16);
                        base[4 * SEQ] = (bf16_t)(w.z & 0xffffu); base[5 * SEQ] = (bf16_t)(w.z >> 16);
                        base[6 * SEQ] = (bf16_t)(w.w & 0xffffu); base[7 * SEQ] = (bf16_t)(w.w >> 16);
                    }
                }
        }
    }
};
struct EpiQ {
    static constexpr bool PERM = true, AFTER_DRAIN = false;
    bf16_t* Q; const float* ssq_q; const float* ropec; const float* ropes;
    __device__ __forceinline__ void operator()(const f32x4 (&acc)[2][2][4][2], const pg8::Unit& u, int wr, int wc, int fr, int fq) const {
        const int row0 = u.pm * 256 + wr * 64 + fr;
        const int i0 = (8 * fq) & 15; const float sg = fq < 2 ? -1.f : 1.f;
#pragma unroll
        for (int ai = 0; ai < 2; ++ai)
#pragma unroll
            for (int m = 0; m < 4; ++m) {
                const int row = row0 + ai * 128 + m * 16, pos = row & (SEQ - 1);
                const float rs = __builtin_amdgcn_rsqf(__hip_atomic_load(ssq_q + row, __ATOMIC_RELAXED, __HIP_MEMORY_SCOPE_AGENT) * (1.0f / QL) + EPS) * QSC_MLA;
#pragma unroll
                for (int bj = 0; bj < 2; ++bj) {
                    const int G = u.pn * 8 + bj * 4 + wc;
                    f32x4 v0 = acc[ai][bj][m][0] * rs, v1 = acc[ai][bj][m][1] * rs;
                    if ((G % 3) == 2) {
                        f32x4 p0, p1;
#pragma unroll
                        for (int j = 0; j < 4; ++j) { p0[j] = __shfl_xor(v0[j], 32); p1[j] = __shfl_xor(v1[j], 32); }
                        const f32x4 c0 = *(const f32x4*)(ropec + pos * 16 + i0), c1 = *(const f32x4*)(ropec + pos * 16 + i0 + 4);
                        const f32x4 s0 = *(const f32x4*)(ropes + pos * 16 + i0), s1 = *(const f32x4*)(ropes + pos * 16 + i0 + 4);
                        v0 = v0 * c0 + p0 * s0 * sg; v1 = v1 * c1 + p1 * s1 * sg;
                    }
                    *(u32x4*)(Q + (size_t)row * QW + G * 32 + 8 * fq) = (u32x4){pk2(v0[0], v0[1]), pk2(v0[2], v0[3]), pk2(v1[0], v1[1]), pk2(v1[2], v1[3])};
                }
                asm volatile("" ::: "memory");
            }
    }
};
struct EpiKV {
    static constexpr bool PERM = false, AFTER_DRAIN = false;
    bf16_t* KN; bf16_t* VT; const float* ssq_kv;
    __device__ __forceinline__ void operator()(const f32x4 (&acc)[2][2][4][2], const pg8::Unit& u, int wr, int wc, int fr, int fq) const {
        const int row0 = u.pm * 256 + wr * 64 + fr;
#pragma unroll
        for (int ai = 0; ai < 2; ++ai)
#pragma unroll
            for (int m = 0; m < 4; ++m) {
                const int row = row0 + ai * 128 + m * 16, b = row >> 11, s = row & (SEQ - 1);
                const float rs = __builtin_amdgcn_rsqf(__hip_atomic_load(ssq_kv + row, __ATOMIC_RELAXED, __HIP_MEMORY_SCOPE_AGENT) * (1.0f / KVL) + EPS);
#pragma unroll
                for (int bj = 0; bj < 2; ++bj) {
                    const int head = u.pn * 2 + bj;
                    const f32x4 x1 = acc[ai][bj][m][0] * rs, x2 = acc[ai][bj][m][1] * rs;
                    const unsigned a0 = pk2(x1[0], x1[1]), a1 = pk2(x1[2], x1[3]), b0 = pk2(x2[0], x2[1]), b1 = pk2(x2[2], x2[3]);
                    if (wc < 2) {
                        bf16_t* p = KN + (size_t)row * 512 + head * 64 + wc * 32 + 4 * fq;
                        *(u32x2*)p = (u32x2){a0, a1}; *(u32x2*)(p + 16) = (u32x2){b0, b1};
                    } else {
                        bf16_t* base = VT + ((size_t)((b * 8 + head) * 64 + (wc - 2) * 32 + 4 * fq)) * SEQ + s;
                        base[0 * SEQ] = (bf16_t)(a0 & 0xffffu); base[1 * SEQ] = (bf16_t)(a0 >> 16); base[2 * SEQ] = (bf16_t)(a1 & 0xffffu); base[3 * SEQ] = (bf16_t)(a1 >> 16);
                        base[16 * SEQ] = (bf16_t)(b0 & 0xffffu); base[17 * SEQ] = (bf16_t)(b0 >> 16); base[18 * SEQ] = (bf16_t)(b1 & 0xffffu); base[19 * SEQ] = (bf16_t)(b1 >> 16);
                    }
                }
                asm volatile("" ::: "memory");
            }
    }
};
struct EpiRes {
    static constexpr bool PERM = false, AFTER_DRAIN = false;
    const float* base; float* out; const float* gate;
    __device__ __forceinline__ void operator()(const f32x4 (&acc)[2][2][4][2], const pg8::Unit& u, int wr, int wc, int fr, int fq) const {
        const int row0 = u.pm * 256 + wr * 64 + fr, b = u.pm >> 3;
#pragma unroll
        for (int bj = 0; bj < 2; ++bj)
#pragma unroll
            for (int n = 0; n < 2; ++n) {
                const int col = u.pn * 256 + bj * 128 + wc * 32 + n * 16 + 4 * fq;
                const f32x4 gv = *(const f32x4*)(gate + b * 6144 + col);
#pragma unroll
                for (int ai = 0; ai < 2; ++ai)
#pragma unroll
                    for (int m = 0; m < 4; ++m) {
                        const size_t off = (size_t)(row0 + ai * 128 + m * 16) * DM + col;
                        const f32x4 bs = *(const f32x4*)(base + off);
                        *(f32x4*)(out + off) = bs + gv * acc[ai][bj][m][n];
                    }
            }
    }
};
struct EpiUp {
    static constexpr bool PERM = true, AFTER_DRAIN = false;
    bf16_t* U;
    __device__ __forceinline__ void operator()(const f32x4 (&acc)[2][2][4][2], const pg8::Unit& u, int wr, int wc, int fr, int fq) const {
        const int row0 = u.pm * 256 + wr * 64 + fr, col0 = u.pn * 256 + wc * 32 + 8 * fq;
#pragma unroll
        for (int ai = 0; ai < 2; ++ai)
#pragma unroll
            for (int m = 0; m < 4; ++m) {
                bf16_t* rowp = U + (size_t)(row0 + ai * 128 + m * 16) * FF + col0;
#pragma unroll
                for (int bj = 0; bj < 2; ++bj) {
                    f32x4 v0 = acc[ai][bj][m][0], v1 = acc[ai][bj][m][1];
#pragma unroll
                    for (int j = 0; j < 4; ++j) { const float a = fmaxf(v0[j], 0.f), c = fmaxf(v1[j], 0.f); v0[j] = a * a; v1[j] = c * c; }
                    u32x4 w; w.x = pk2(v0[0], v0[1]); w.y = pk2(v0[2], v0[3]); w.z = pk2(v1[0], v1[1]); w.w = pk2(v1[2], v1[3]);
                    st16_wt(rowp + bj * 128, w);
                }
            }
    }
};


struct PanelX {
    float* ssq; unsigned* cnt;
    __device__ __forceinline__ void exchange(const f32x4 (&v)[2][2][4][2], const pg8::Unit& u, int wr, int fr, int fq) const {
        const int row0 = u.pm * 256 + wr * 64 + fr;
#pragma unroll
        for (int ai = 0; ai < 2; ++ai)
#pragma unroll
            for (int m = 0; m < 4; ++m) {
                float s = 0.f;
#pragma unroll
                for (int bj = 0; bj < 2; ++bj)
#pragma unroll
                    for (int n = 0; n < 2; ++n) { const f32x4 x = v[ai][bj][m][n]; s += (x[0] * x[0] + x[1] * x[1]) + (x[2] * x[2] + x[3] * x[3]); }
                s += __shfl_xor(s, 16); s += __shfl_xor(s, 32);
                if (fq == 0) unsafeAtomicAdd(ssq + row0 + ai * 128 + m * 16, s);
            }
        asm volatile("s_waitcnt vmcnt(0)" ::: "memory");
        __syncthreads();
        if (threadIdx.x == 0) {
            unsigned* c = cnt + 64 * u.pm;
            __builtin_amdgcn_fence(__ATOMIC_RELEASE, "agent");
            __hip_atomic_fetch_add(c, 1u, __ATOMIC_RELAXED, __HIP_MEMORY_SCOPE_AGENT);
            unsigned sp = 0;
            while (__hip_atomic_load(c, __ATOMIC_RELAXED, __HIP_MEMORY_SCOPE_AGENT) < 4u) { __builtin_amdgcn_s_sleep(1); if (++sp > (1u << 22)) break; }
            __builtin_amdgcn_fence(__ATOMIC_ACQUIRE, "agent");
        }
        __syncthreads();
    }
    __device__ __forceinline__ float rstd(int row) const { return __builtin_amdgcn_rsqf(__hip_atomic_load(ssq + row, __ATOMIC_RELAXED, __HIP_MEMORY_SCOPE_AGENT) * (1.0f / DM) + EPS); }
};
struct EpiResNorm {
    static constexpr bool PERM = true, AFTER_DRAIN = true;
    const float* base; bf16_t* X1; bf16_t* H; const float* mod; const float* g; PanelX px;
    __device__ __forceinline__ void fused(f32x4 (&acc)[2][2][4][2], const pg8::Unit& u, int wr, int wc, int fr, int fq) const {
        const int row0 = u.pm * 256 + wr * 64 + fr, b = u.pm >> 3, col0 = u.pn * 256 + wc * 32 + 8 * fq;
        const float* mb = mod + b * 6144 + col0;
        {
            f32x4 gv[2][2];
#pragma unroll
            for (int bj = 0; bj < 2; ++bj)
#pragma unroll
                for (int n = 0; n < 2; ++n) gv[bj][n] = *(const f32x4*)(mb + 2 * 1024 + bj * 128 + n * 4);
#pragma unroll
            for (int ai = 0; ai < 2; ++ai)
#pragma unroll
                for (int m = 0; m < 4; ++m) {
                    const size_t off = (size_t)(row0 + ai * 128 + m * 16) * DM + col0;
                    const float* bp = base + off; bf16_t* op = X1 + off;
#pragma unroll
                    for (int bj = 0; bj < 2; ++bj) {
                        const f32x4 v0 = __builtin_nontemporal_load((const f32x4*)(bp + bj * 128)) + gv[bj][0] * acc[ai][bj][m][0], v1 = __builtin_nontemporal_load((const f32x4*)(bp + bj * 128 + 4)) + gv[bj][1] * acc[ai][bj][m][1];
                        acc[ai][bj][m][0] = v0; acc[ai][bj][m][1] = v1;
                        *(u32x4*)(op + bj * 128) = (u32x4){pk2(v0[0], v0[1]), pk2(v0[2], v0[3]), pk2(v1[0], v1[1]), pk2(v1[2], v1[3])};
                    }
                    if (m & 1) asm volatile("" ::: "memory");
                }
        }
        px.exchange(acc, u, wr, fr, fq);
        int row0b = row0; asm volatile("" : "+v"(row0b));
        {
            f32x4 gs[2][2], sh[2][2];
#pragma unroll
            for (int bj = 0; bj < 2; ++bj)
#pragma unroll
                for (int n = 0; n < 2; ++n) {
                    gs[bj][n] = *(const f32x4*)(g + col0 + bj * 128 + n * 4) * (*(const f32x4*)(mb + 4 * 1024 + bj * 128 + n * 4) + 1.0f);
                    sh[bj][n] = *(const f32x4*)(mb + 3 * 1024 + bj * 128 + n * 4);
                }
#pragma unroll
            for (int ai = 0; ai < 2; ++ai)
#pragma unroll
                for (int m = 0; m < 4; ++m) {
                    const int row = row0b + ai * 128 + m * 16;
                    const float rs = px.rstd(row);
                    bf16_t* hp = H + (size_t)row * DM + col0;
#pragma unroll
                    for (int bj = 0; bj < 2; ++bj) {
                        const f32x4 y0 = acc[ai][bj][m][0] * rs * gs[bj][0] + sh[bj][0], y1 = acc[ai][bj][m][1] * rs * gs[bj][1] + sh[bj][1];
                        st16_wt(hp + bj * 128, (u32x4){pk2(y0[0], y0[1]), pk2(y0[2], y0[3]), pk2(y1[0], y1[1]), pk2(y1[2], y1[3])});
                    }
                    if (m & 1) asm volatile("" ::: "memory");
                }
        }
    }
};
struct EpiResFinal {
    static constexpr bool PERM = false, AFTER_DRAIN = true;
    const bf16_t* X1; float* out; const float* mod; const float* fg; PanelX px;
    __device__ __forceinline__ void fused(f32x4 (&acc)[2][2][4][2], const pg8::Unit& u, int wr, int wc, int fr, int fq) const {
        const int row0 = u.pm * 256 + wr * 64 + fr, b = u.pm >> 3, col0 = u.pn * 256 + wc * 32 + 4 * fq;
        const float* mb = mod + b * 6144 + col0;
        {
            f32x4 gv[2][2];
#pragma unroll
            for (int bj = 0; bj < 2; ++bj)
#pragma unroll
                for (int n = 0; n < 2; ++n) gv[bj][n] = *(const f32x4*)(mb + 5 * 1024 + bj * 128 + n * 16);
#pragma unroll
            for (int ai = 0; ai < 2; ++ai)
#pragma unroll
                for (int m = 0; m < 4; ++m) {
                    const bf16_t* bp = X1 + (size_t)(row0 + ai * 128 + m * 16) * DM + col0;
#pragma unroll
                    for (int bj = 0; bj < 2; ++bj)
#pragma unroll
                        for (int n = 0; n < 2; ++n) { const u32x2 w = __builtin_nontemporal_load((const u32x2*)(bp + bj * 128 + n * 16));
                            const f32x4 xb = (f32x4){__uint_as_float(w.x << 16), __uint_as_float(w.x & 0xffff0000u), __uint_as_float(w.y << 16), __uint_as_float(w.y & 0xffff0000u)};
                            acc[ai][bj][m][n] = xb + gv[bj][n] * acc[ai][bj][m][n]; }
                    asm volatile("" : "+v"(acc[ai][0][m][0]), "+v"(acc[ai][0][m][1]), "+v"(acc[ai][1][m][0]), "+v"(acc[ai][1][m][1]));
                    if (m & 1) asm volatile("" ::: "memory");
                }
        }
        px.exchange(acc, u, wr, fr, fq);
        int row0b = row0; asm volatile("" : "+v"(row0b));
        {
            f32x4 fgv[2][2];
#pragma unroll
            for (int bj = 0; bj < 2; ++bj)
#pragma unroll
                for (int n = 0; n < 2; ++n) fgv[bj][n] = *(const f32x4*)(fg + col0 + bj * 128 + n * 16);
#pragma unroll
            for (int ai = 0; ai < 2; ++ai)
#pragma unroll
                for (int m = 0; m < 4; ++m) {
                    const int row = row0b + ai * 128 + m * 16;
                    const float rs = px.rstd(row);
                    float* op = out + (size_t)row * DM + col0;
#pragma unroll
                    for (int bj = 0; bj < 2; ++bj)
#pragma unroll
                        for (int n = 0; n < 2; ++n) *(f32x4*)(op + bj * 128 + n * 16) = acc[ai][bj][m][n] * rs * fgv[bj][n];
                    if (m & 1) asm volatile("" ::: "memory");
                }
        }
    }
};

constexpr int KSTR = 208, VSTR = 136, VOFF = 64 * KSTR;
template <int QKD, int MODE>
__device__ __forceinline__ void attn_unit(LAS unsigned char* lds, const bf16_t* Q, int ldq, const bf16_t* K1, int ldk1, const bf16_t* K2, int ldk2,
                                          const bf16_t* VT, bf16_t* O, int qpos0, int t_lo, int t_hi, float slope2, float sink2, int tid, int wid, int lane) {
    const int r = lane & 31, hi = lane >> 5;
    const int q0 = qpos0 + 32 * wid;
    constexpr int NKB = QKD / 16;
    bf16x8 qf[NKB];
#pragma unroll
    for (int kb = 0; kb < NKB; ++kb) qf[kb] = *(const bf16x8*)(Q + (size_t)(32 * wid + r) * ldq + 16 * kb + 8 * hi);
    f32x16 o0, o1;
#pragma unroll
    for (int i = 0; i < 16; ++i) { o0[i] = 0.f; o1[i] = 0.f; }
    float mrun = (MODE == 1) ? sink2 : -1e30f;
    float lsum = (MODE == 1) ? (hi == 0 ? 1.f : 0.f) : 0.f;
    const int key1 = tid >> 3, ch1 = tid & 7, key2 = (tid >> 2) & 63, ch2 = tid & 3;
    u32x4 kr, k2r, vr;
    kr = *(const u32x4*)(K1 + (size_t)(64 * t_lo + key1) * ldk1 + ch1 * 8);
    if (QKD == 96) { if (tid < 256) k2r = *(const u32x4*)(K2 + (size_t)(64 * t_lo + key2) * ldk2 + ch2 * 8); }
    vr = *(const u32x4*)(VT + (size_t)key1 * SEQ + 64 * t_lo + ch1 * 8);
    for (int t = t_lo; t <= t_hi; ++t) {
        __syncthreads();
        *(LAS u32x4*)(lds + key1 * KSTR + ch1 * 16) = kr;
        if (QKD == 96) { if (tid < 256) *(LAS u32x4*)(lds + key2 * KSTR + 128 + ch2 * 16) = k2r; }
        *(LAS u32x2*)(lds + VOFF + key1 * VSTR + ch1 * 16) = (u32x2){vr.x, vr.y};
        *(LAS u32x2*)(lds + VOFF + key1 * VSTR + ch1 * 16 + 8) = (u32x2){vr.z, vr.w};
        __syncthreads();
        if (t < t_hi) {
            kr = *(const u32x4*)(K1 + (size_t)(64 * (t + 1) + key1) * ldk1 + ch1 * 8);
            if (QKD == 96) { if (tid < 256) k2r = *(const u32x4*)(K2 + (size_t)(64 * (t + 1) + key2) * ldk2 + ch2 * 8); }
            vr = *(const u32x4*)(VT + (size_t)key1 * SEQ + 64 * (t + 1) + ch1 * 8);
        }
        const int k0 = 64 * t;
        const bool active = (MODE == 0) ? (k0 <= q0 + 31) : ((k0 + 63 >= q0 - 127) && (k0 <= q0 + 31));
        if (active) {
            f32x16 s[2];
#pragma unroll
            for (int sub = 0; sub < 2; ++sub) {
#pragma unroll
                for (int i = 0; i < 16; ++i) s[sub][i] = 0.f;
#pragma unroll
                for (int kb = 0; kb < NKB; ++kb) {
                    const bf16x8 kf = *(const LAS bf16x8*)(lds + (32 * sub + r) * KSTR + (16 * kb + 8 * hi) * 2);
                    s[sub] = __builtin_amdgcn_mfma_f32_32x32x16_bf16(kf, qf[kb], s[sub], 0, 0, 0);
                }
            }
            const int qp = q0 + r;
            if (MODE == 0) {
                if (k0 + 63 > q0) {
#pragma unroll
                    for (int sub = 0; sub < 2; ++sub)
#pragma unroll
                        for (int i = 0; i < 16; ++i) { const int key = k0 + 32 * sub + (i & 3) + 8 * (i >> 2) + 4 * hi; if (key > qp) s[sub][i] = -INFINITY; }
                }
            } else {
#pragma unroll
                for (int sub = 0; sub < 2; ++sub)
#pragma unroll
                    for (int i = 0; i < 16; ++i) { const int key = k0 + 32 * sub + (i & 3) + 8 * (i >> 2) + 4 * hi; const int dist = qp - key;
                        s[sub][i] = (dist < 0 || dist >= 128) ? -INFINITY : (s[sub][i] - slope2 * (float)dist); }
            }
            float mx = -INFINITY;
#pragma unroll
            for (int sub = 0; sub < 2; ++sub)
#pragma unroll
                for (int i = 0; i < 16; ++i) mx = fmaxf(mx, s[sub][i]);
            mx = fmaxf(mx, __shfl_xor(mx, 32));
            const float mn = fmaxf(mrun, mx);
            const float alpha = __builtin_amdgcn_exp2f(mrun - mn);
            mrun = mn;
            float psum = 0.f;
#pragma unroll
            for (int sub = 0; sub < 2; ++sub)
#pragma unroll
                for (int i = 0; i < 16; ++i) { const float p = __builtin_amdgcn_exp2f(s[sub][i] - mn); s[sub][i] = p; psum += p; }
            lsum = lsum * alpha + psum;
            o0 = o0 * alpha; o1 = o1 * alpha;
#pragma unroll
            for (int sub = 0; sub < 2; ++sub)
#pragma unroll
                for (int jb = 0; jb < 2; ++jb) {
                    u32x4 pw;
                    pw.x = pk2(s[sub][8 * jb + 0], s[sub][8 * jb + 1]); pw.y = pk2(s[sub][8 * jb + 2], s[sub][8 * jb + 3]);
                    pw.z = pk2(s[sub][8 * jb + 4], s[sub][8 * jb + 5]); pw.w = pk2(s[sub][8 * jb + 6], s[sub][8 * jb + 7]);
                    const bf16x8 pf = __builtin_bit_cast(bf16x8, pw);
                    const LAS unsigned char* vp = lds + VOFF + r * VSTR + (32 * sub + 16 * jb + 4 * hi) * 2;
                    {
                        const u32x2 a = *(const LAS u32x2*)vp, b = *(const LAS u32x2*)(vp + 16);
                        const bf16x8 vf = __builtin_bit_cast(bf16x8, (u32x4){a.x, a.y, b.x, b.y});
                        o0 = __builtin_amdgcn_mfma_f32_32x32x16_bf16(vf, pf, o0, 0, 0, 0);
                    }
                    {
                        const u32x2 a = *(const LAS u32x2*)(vp + 32 * VSTR), b = *(const LAS u32x2*)(vp + 32 * VSTR + 16);
                        const bf16x8 vf = __builtin_bit_cast(bf16x8, (u32x4){a.x, a.y, b.x, b.y});
                        o1 = __builtin_amdgcn_mfma_f32_32x32x16_bf16(vf, pf, o1, 0, 0, 0);
                    }
                }
        }
    }
    const float ltot = lsum + __shfl_xor(lsum, 32);
    const float inv = 1.0f / ltot;
    bf16_t* op = O + (size_t)(32 * wid + r) * DM + 4 * hi;
#pragma unroll
    for (int g = 0; g < 4; ++g) {
        *(u32x2*)(op + 8 * g) = (u32x2){pk2(o0[4 * g] * inv, o0[4 * g + 1] * inv), pk2(o0[4 * g + 2] * inv, o0[4 * g + 3] * inv)};
        *(u32x2*)(op + 32 + 8 * g) = (u32x2){pk2(o1[4 * g] * inv, o1[4 * g + 1] * inv), pk2(o1[4 * g + 2] * inv, o1[4 * g + 3] * inv)};
    }
}

struct TrDesc { const float* W; bf16_t* WT; const float* ks; int K, N, item; };
__device__ __forceinline__ void tr_load(const TrDesc& d, f32x4 (&v)[8], int lane) {
    const int nblk = d.N / 32, kb = d.item / nblk, nb = d.item % nblk, k0 = 64 * kb, n0 = 32 * nb;
    const int kk0 = lane >> 3, n4 = lane & 7;
#pragma unroll
    for (int i = 0; i < 8; ++i) v[i] = __builtin_nontemporal_load((const f32x4*)(d.W + (size_t)(k0 + kk0 + 8 * i) * d.N + n0 + 4 * n4));
}
__device__ __forceinline__ void tr_finish(const TrDesc& d, f32x4 (&v)[8], LAS float* scr, int lane) {
    const int nblk = d.N / 32, kb = d.item / nblk, nb = d.item % nblk, k0 = 64 * kb, n0 = 32 * nb;
    const int kk0 = lane >> 3, n4 = lane & 7;
    if (d.ks) {
#pragma unroll
        for (int i = 0; i < 8; ++i) v[i] = v[i] * d.ks[k0 + kk0 + 8 * i];
    }
#pragma unroll
    for (int i = 0; i < 8; ++i) { LAS float* p = scr + (kk0 + 8 * i) * 33 + 4 * n4; p[0] = v[i][0]; p[1] = v[i][1]; p[2] = v[i][2]; p[3] = v[i][3]; }
    asm volatile("s_waitcnt lgkmcnt(0)" ::: "memory");
    const int c = lane & 7;
#pragma unroll
    for (int j = 0; j < 4; ++j) { const int n = (lane >> 3) + 8 * j; const LAS float* s = scr + (8 * c) * 33 + n;
        u32x4 o; o.x = pk2(s[0 * 33], s[1 * 33]); o.y = pk2(s[2 * 33], s[3 * 33]); o.z = pk2(s[4 * 33], s[5 * 33]); o.w = pk2(s[6 * 33], s[7 * 33]);
        *(u32x4*)(d.WT + (size_t)(n0 + n) * d.K + k0 + 8 * c) = o; }
    asm volatile("s_waitcnt lgkmcnt(0)" ::: "memory");
}
struct TrSet { const float *w_in, *w_qb, *w_kvb, *w_o, *w_up, *w_down, *g_qa, *g_kva; bf16_t *win_t, *wqb_t, *wkvb_t, *wo_t, *wup_t, *wdn_t; };
constexpr int I_IN = 16 * 45, I_QB = 6 * 24, I_KVB = 4 * 32, I_O = 16 * 32, I_UP = 16 * 128, I_DN = 64 * 32;
constexpr int NITEMS_EARLY = I_IN + I_QB + I_KVB, NITEMS_LATE = I_O + I_UP + I_DN;
__device__ __forceinline__ TrDesc tr_desc(const TrSet& T, int it) {
    int r = it;
    if (r < I_IN) return TrDesc{T.w_in, T.win_t, nullptr, DM, IN_COLS, r}; r -= I_IN;
    if (r < I_QB) return TrDesc{T.w_qb, T.wqb_t, T.g_qa, QL, QW, r}; r -= I_QB;
    if (r < I_KVB) return TrDesc{T.w_kvb, T.wkvb_t, T.g_kva, KVL, KVW, r}; r -= I_KVB;
    if (r < I_O) return TrDesc{T.w_o, T.wo_t, nullptr, DM, DM, r}; r -= I_O;
    if (r < I_UP) return TrDesc{T.w_up, T.wup_t, nullptr, DM, FF, r}; r -= I_UP;
    return TrDesc{T.w_down, T.wdn_t, nullptr, FF, DM, r};
}
__device__ __forceinline__ void tr_run(const TrSet& T, int first, int last, int w, int nw, LAS float* scr, int lane) {
    int it = first + w;
    if (it >= last) return;
    TrDesc d = tr_desc(T, it); f32x4 v[8]; tr_load(d, v, lane);
    for (;;) {
        const int itn = it + nw;
        if (itn < last) {
            const TrDesc dn = tr_desc(T, itn); f32x4 vn[8]; tr_load(dn, vn, lane);
            tr_finish(d, v, scr, lane);
            d = dn;
#pragma unroll
            for (int i = 0; i < 8; ++i) v[i] = vn[i];
            it = itn;
        } else { tr_finish(d, v, scr, lane); break; }
    }
}
__device__ __forceinline__ void p0_mod_block(const float* c, const float* w_ada, const float* b_ada, float* mod, LAS unsigned char* lds, int blk, int tid) {
    LAS float* sl = (LAS float*)lds;
    LAS float* part = (LAS float*)(lds + 32768);
    for (int i = tid; i < 8 * DM; i += 512) { const float x = c[i]; sl[i] = x / (1.0f + __expf(-x)); }
    __syncthreads();
    const int c4 = tid % 6, r = tid / 6;
    if (r < 85) {
        f32x4 acc[8];
#pragma unroll
        for (int b = 0; b < 8; ++b) acc[b] = (f32x4){0.f, 0.f, 0.f, 0.f};
        const float* wp = w_ada + (size_t)r * 6144 + 24 * blk + 4 * c4;
        f32x4 w[12];
#pragma unroll
        for (int i = 0; i < 12; ++i) w[i] = __builtin_nontemporal_load((const f32x4*)(wp + (size_t)(85 * i) * 6144));
        f32x4 wt = (f32x4){0.f, 0.f, 0.f, 0.f};
        if (r < 4) wt = __builtin_nontemporal_load((const f32x4*)(wp + (size_t)1020 * 6144));
#pragma unroll
        for (int i = 0; i < 12; ++i) {
#pragma unroll
            for (int b = 0; b < 8; ++b) acc[b] += w[i] * sl[b * DM + r + 85 * i];
        }
        if (r < 4) {
#pragma unroll
            for (int b = 0; b < 8; ++b) acc[b] += wt * sl[b * DM + r + 1020];
        }
#pragma unroll
        for (int b = 0; b < 8; ++b)
#pragma unroll
            for (int j = 0; j < 4; ++j) part[r * 192 + b * 24 + 4 * c4 + j] = acc[b][j];
    }
    __syncthreads();
    if (tid < 192) {
        float sum = 0.f;
        for (int rr = 0; rr < 85; ++rr) sum += part[rr * 192 + tid];
        const int b = tid / 24, cc = tid % 24;
        mod[b * 6144 + 24 * blk + cc] = sum + b_ada[24 * blk + cc];
    }
    __syncthreads();
}
__device__ __forceinline__ void rows_load4(const float* x, int m, f32x4 (&v)[16], int lane) {
    const f32x4* xr = (const f32x4*)(x + (size_t)m * DM) + 2 * lane;
#pragma unroll
    for (int q = 0; q < 4; ++q)
#pragma unroll
        for (int jj = 0; jj < 2; ++jj) { v[4 * q + 2 * jj] = __builtin_nontemporal_load(xr + 256 * q + 128 * jj); v[4 * q + 2 * jj + 1] = __builtin_nontemporal_load(xr + 256 * q + 128 * jj + 1); }
}
__device__ __forceinline__ void rows_finish4(const f32x4 (&v)[16], bf16_t* orow, const float* g, const float* sc, const float* sh, int lane) {
    float rs[4];
#pragma unroll
    for (int q = 0; q < 4; ++q) { float t = 0.f;
#pragma unroll
        for (int j = 0; j < 4; ++j) { const f32x4 a = v[4 * q + j]; t += (a[0] * a[0] + a[1] * a[1]) + (a[2] * a[2] + a[3] * a[3]); }
        rs[q] = t; }
#pragma unroll
    for (int o = 1; o < 64; o <<= 1) {
#pragma unroll
        for (int q = 0; q < 4; ++q) rs[q] += __shfl_xor(rs[q], o);
    }
#pragma unroll
    for (int q = 0; q < 4; ++q) rs[q] = 1.0f / sqrtf(rs[q] * (1.0f / DM) + EPS);
#pragma unroll
    for (int jj = 0; jj < 2; ++jj) {
        const int ci = 128 * jj + 2 * lane;
        const f32x4 g0 = ((const f32x4*)g)[ci] * (((const f32x4*)sc)[ci] + 1.0f), g1 = ((const f32x4*)g)[ci + 1] * (((const f32x4*)sc)[ci + 1] + 1.0f);
        const f32x4 h0 = ((const f32x4*)sh)[ci], h1 = ((const f32x4*)sh)[ci + 1];
#pragma unroll
        for (int q = 0; q < 4; ++q) {
            const f32x4 y0 = v[4 * q + 2 * jj] * rs[q] * g0 + h0, y1 = v[4 * q + 2 * jj + 1] * rs[q] * g1 + h1;
            st16_wt(orow + (size_t)q * DM + 512 * jj + 8 * lane, (u32x4){pk2(y0[0], y0[1]), pk2(y0[2], y0[3]), pk2(y1[0], y1[1]), pk2(y1[2], y1[3])});
        }
    }
}
#define XB_TMO      128
#define XB_XCNT(j)  (256  + 64 * (j))
#define XB_XSUB(j)  (1280 + 64 * (j))
#define XB_XGEN(j)  (2304 + 64 * (j))
#define XB_TOP      3328
#define XB_TOPGEN   3392
#define XCD_BAR_WORDS 3456
#define XB_SPIN_CAP (1u << 18)
__device__ __forceinline__ unsigned xb_ld(unsigned* p)              { return __hip_atomic_load(p, __ATOMIC_RELAXED, __HIP_MEMORY_SCOPE_AGENT); }
__device__ __forceinline__ unsigned xb_add(unsigned* p, unsigned v) { return __hip_atomic_fetch_add(p, v, __ATOMIC_RELAXED, __HIP_MEMORY_SCOPE_AGENT); }
__device__ __forceinline__ unsigned xb_xcc_id() { return (unsigned)__builtin_amdgcn_s_getreg((3 << 11) | 20) & 0xFu; }
#define XB_SPIN(cond, bar) do { unsigned _sp = 0; while (cond) { __builtin_amdgcn_s_sleep(1); \
    if ((++_sp & 255u) == 0u) { if (xb_ld(&(bar)[XB_TMO])) break; if (_sp > XB_SPIN_CAP) { atomicAdd(&(bar)[XB_TMO], 1u); break; } } } } while (0)
struct XcdBarrier { unsigned* bar; unsigned x; volatile LAS unsigned* st; };
__device__ __forceinline__ XcdBarrier xcd_barrier_post(unsigned* bar, volatile LAS unsigned* st) {
    XcdBarrier b; b.bar = bar; b.x = xb_xcc_id(); b.st = st;
    if (threadIdx.x == 0) (void)xb_add(&bar[XB_XCNT(b.x)], 1u);
    return b;
}
__device__ __forceinline__ void xcd_barrier_complete(unsigned* bar, unsigned x, unsigned& nloc, unsigned& nx) {
    const unsigned G = gridDim.x * gridDim.y * gridDim.z;
    unsigned sum, cnt, mine, sp = 0u;
    for (;;) {
        sum = 0u; cnt = 0u; mine = 0u;
#pragma unroll
        for (unsigned j = 0; j < 16; ++j) { const unsigned c = xb_ld(&bar[XB_XCNT(j)]); sum += c; cnt += (c > 0u) ? 1u : 0u; mine = (j == x) ? c : mine; }
        if (sum == G) break;
        __builtin_amdgcn_s_sleep(1);
        if ((++sp & 255u) == 0u) { if (xb_ld(&bar[XB_TMO])) break; if (sp > XB_SPIN_CAP) { atomicAdd(&bar[XB_TMO], 1u); break; } }
    }
    nloc = mine > 0u ? mine : 1u; nx = cnt > 0u ? cnt : 1u;
}
__device__ __forceinline__ void xcd_barrier(const XcdBarrier& b) {
    asm volatile("s_waitcnt vmcnt(0)" ::: "memory");
    __syncthreads();
    if (threadIdx.x == 0) {
        unsigned* bar = b.bar;
        __builtin_amdgcn_s_waitcnt(0);
        unsigned nloc = b.st[0], nx = b.st[1];
        if (nloc == 0u) { xcd_barrier_complete(bar, b.x, nloc, nx); b.st[0] = nloc; b.st[1] = nx; }
        const unsigned old = xb_add(&bar[XB_XSUB(b.x)], 1u);
        const unsigned gen = old / nloc;
        if (old + 1u == (gen + 1u) * nloc) {
            __builtin_amdgcn_fence(__ATOMIC_RELEASE, "agent");
            asm volatile("s_waitcnt vmcnt(0)" ::: "memory");
            const unsigned og = xb_add(&bar[XB_TOP], 1u);
            const unsigned tg = og / nx;
            if (og + 1u == (tg + 1u) * nx) xb_add(&bar[XB_TOPGEN], 1u);
            else XB_SPIN(xb_ld(&bar[XB_TOPGEN]) == tg, bar);
            __builtin_amdgcn_fence(__ATOMIC_ACQUIRE, "agent");
            xb_add(&bar[XB_XGEN(b.x)], 1u);
            asm volatile("s_waitcnt vmcnt(0)" ::: "memory");
        } else {
            XB_SPIN(xb_ld(&bar[XB_XGEN(b.x)]) == gen, bar);
            __builtin_amdgcn_fence(__ATOMIC_ACQUIRE, "agent");
            asm volatile("s_waitcnt vmcnt(0)" ::: "memory");
        }
    }
    __syncthreads();
}

struct Args { const float* in[16]; float* out; unsigned char* ws; int ph_lo, ph_hi, pad0, pad1; };
constexpr int NPHASE = 10;

__global__ void __launch_bounds__(512, 2) fwd_megakernel(Args args) {
    extern __shared__ __attribute__((aligned(16))) unsigned char lds_raw[];
    LAS unsigned char* lds = (LAS unsigned char*)lds_raw;
    cg::grid_group grid = cg::this_grid();
    const int tid = threadIdx.x, lane = tid & 63, wave = __builtin_amdgcn_readfirstlane(tid >> 6);
    const int G = gridDim.x, bx = blockIdx.x;
    const int vcu = (G % 8 == 0) ? (bx % 8) * (G / 8) + bx / 8 : bx;
    const int gw = vcu * 8 + wave, NGW = G * 8;
    unsigned char* ws = args.ws;
    const float* x = args.in[0]; const float* cvec = args.in[1]; const float* w_ada = args.in[2]; const float* b_ada = args.in[3];
    const float* norm_mix_g = args.in[4]; const float* w_in = args.in[5]; const float* g_qa = args.in[6]; const float* w_qb = args.in[7];
    const float* g_kva = args.in[8]; const float* w_kvb = args.in[9]; const float* sinks = args.in[10]; const float* w_o = args.in[11];
    const float* norm_mlp_g = args.in[12]; const float* w_up = args.in[13]; const float* w_down = args.in[14]; const float* final_g = args.in[15];
    float* out = args.out;
    float* mod = (float*)(ws + WS_MOD); float* ssq_q = (float*)(ws + WS_SSQQ); float* ssq_kv = (float*)(ws + WS_SSQKV);
    float* ropec = (float*)(ws + WS_ROPE); float* ropes = ropec + SEQ * 16;
    bf16_t* win_t = (bf16_t*)(ws + WS_WIN); bf16_t* wqb_t = (bf16_t*)(ws + WS_WQB); bf16_t* wkvb_t = (bf16_t*)(ws + WS_WKVB);
    bf16_t* wo_t = (bf16_t*)(ws + WS_WO); bf16_t* wup_t = (bf16_t*)(ws + WS_WUP); bf16_t* wdn_t = (bf16_t*)(ws + WS_WDN);
    bf16_t* hbuf = (bf16_t*)(ws + WS_H); bf16_t* proj = (bf16_t*)(ws + WS_PROJ); bf16_t* qbuf = (bf16_t*)(ws + WS_Q); bf16_t* knope = (bf16_t*)(ws + WS_KN);
    bf16_t* vtm = (bf16_t*)(ws + WS_VTM); bf16_t* vts = (bf16_t*)(ws + WS_VTS); bf16_t* mix = (bf16_t*)(ws + WS_MIX); bf16_t* ubuf = (bf16_t*)(ws + WS_U); bf16_t* x1b = (bf16_t*)(ws + WS_X1);

    const TrSet TS{w_in, w_qb, w_kvb, w_o, w_up, w_down, g_qa, g_kva, win_t, wqb_t, wkvb_t, wo_t, wup_t, wdn_t};
    const int lo = args.ph_lo, hi = args.ph_hi;
    volatile LAS unsigned* bst = (volatile LAS unsigned*)(lds + 131072);
    if (tid < 2) bst[tid] = 0u;
    __syncthreads();
    XcdBarrier xbar; xbar.bar = (unsigned*)(ws + WS_BAR); xbar.x = 0; xbar.st = bst;
    if (hi - lo > 1) xbar = xcd_barrier_post((unsigned*)(ws + WS_BAR), bst);
    if (lo < 0) grid.sync();
#ifndef PH_MASK
#define PH_MASK 0x3ff
#endif
#define IN(k) (((PH_MASK >> (k)) & 1) && lo <= (k) && (k) < hi)
#define GSYNC() xcd_barrier(xbar)
#define SEAM2(k, k2) do { if (IN(k) && IN(k2)) GSYNC(); } while (0)
#define SEAM(k) SEAM2(k, (k) + 1)
#ifndef REPMASK
#define REPMASK 0
#endif
#ifndef REPN
#define REPN 3
#endif
#ifndef XSYNC
#define XSYNC 0
#endif
#ifndef TPROBE
#define TPROBE -1
#endif
#define STAMP(j) do { if (TPROBE >= 0 && bx == 0 && wave == 0) { if ((j) == TPROBE) tp0 = __builtin_amdgcn_s_memrealtime(); if ((j) == TPROBE + 1) tp1 = __builtin_amdgcn_s_memrealtime(); } } while (0)
#define REP(k) for (int rep_ = 0; rep_ < (((REPMASK >> (k)) & 1) ? REPN : 1); ++rep_)

    unsigned long long tp0 = 0, tp1 = 0;
    STAMP(0);
    const int pm_t = 8 * (bx & 7) + ((bx >> 3) & 7), mj = bx >> 6, bt = pm_t >> 3;
    const int rm0 = 256 * pm_t + 64 * mj + 8 * wave;
    if (IN(0)) {
        LAS float* scr = (LAS float*)(lds + wave * 16384);
        p0_mod_block(cvec, w_ada, b_ada, mod, lds, bx, tid);
        tr_run(TS, 0, NITEMS_EARLY, gw, NGW, scr, lane);
        const int gt = vcu * 512 + tid, NGT = G * 512;
        for (int i = gt; i < (NPROJ - IN_COLS) * DM / 8; i += NGT) ((u32x4*)(win_t + (size_t)IN_COLS * DM))[i] = (u32x4){0u, 0u, 0u, 0u};
        for (int i = gt; i < SEQ * 16; i += NGT) {
            const int pos = i >> 4, fi = i & 15;
            double f = (fi & 3) == 0 ? 1.0 : ((fi & 3) == 1 ? 0.5623413251903491 : ((fi & 3) == 2 ? 0.31622776601683794 : 0.1778279410038923));
            const int dec = fi >> 2; f *= (dec == 0 ? 1.0 : (dec == 1 ? 0.1 : (dec == 2 ? 0.01 : 0.001)));
            const float ang32 = (float)pos * (float)f;
            const double rev = (double)ang32 * 0.15915494309189535;
            const float fr = (float)(rev - __builtin_rint(rev));
            ropec[i] = __builtin_amdgcn_cosf(fr); ropes[i] = __builtin_amdgcn_sinf(fr);
        }
    }
    f32x4 rv[16], rvn[16];
    rows_load4(x, rm0, rv, lane); rows_load4(x, rm0 + 4, rvn, lane);
    SEAM(0);
    STAMP(1);
    for (int xs_ = 0; xs_ < XSYNC; ++xs_) GSYNC();
    if (IN(1)) {
        unsigned* tc = (unsigned*)(ws + WS_CNT) + 64 * pm_t;
        {
            rows_finish4(rv, hbuf + (size_t)rm0 * DM, norm_mix_g, mod + bt * 6144 + 1024, mod + bt * 6144, lane);
            rows_finish4(rvn, hbuf + (size_t)(rm0 + 4) * DM, norm_mix_g, mod + bt * 6144 + 1024, mod + bt * 6144, lane);
        }
        team_wait(tc + 4 * 64 * 64);
#pragma unroll 1
        for (int rnd = 0; rnd < 2; ++rnd) {
            if (rnd == 0 || mj < 2) {
                pg8::Gemm g{hbuf, win_t, MT, NPROJ, DM, DM}; const pg8::ListOrder S{pm_t, 1, rnd == 0 ? mj : 4 + mj, 0};
                EpiProj E{proj, ssq_q, ssq_kv, ropec, ropes, vts};
                pg8::gemm_phase<EpiProj, true, pg8::ListOrder>(lds, g, S, E);
            }
            if (rnd == 0) team_wait(tc + 5 * 64 * 64);
        }
        { pg8::Gemm g{proj, wqb_t, MT, QW, QL, NPROJ}; const pg8::ListOrder S{pm_t, mj == 2 ? 2 : (mj == 3 ? 1 : 0), mj == 2 ? 0 : 2, 1};
          EpiQ E{qbuf, ssq_q, ropec, ropes}; pg8::gemm_phase<EpiQ, true, pg8::ListOrder>(lds, g, S, E); }
        { pg8::Gemm g{proj + QL, wkvb_t, MT, KVW, KVL, NPROJ}; const pg8::ListOrder S{pm_t, mj == 3 ? 2 : (mj == 2 ? 0 : 1), mj == 3 ? 2 : mj, 3};
          EpiKV E{knope, vtm, ssq_kv}; pg8::gemm_phase<EpiKV, true, pg8::ListOrder>(lds, g, S, E); }
        if (mj < 3) {
            LAS float* scr = (LAS float*)(lds + wave * 16384);
            const int f0 = NITEMS_EARLY + 72 * pm_t + 24 * mj;
            tr_run(TS, f0, f0 + 24, wave, 8, scr, lane);
        }
    }
    STAMP(2); STAMP(3);
    SEAM2(1, 4);
    STAMP(4);
    REP(4) { if (rep_) GSYNC();
    if (IN(4)) {
        if (wave >= 4) __builtin_amdgcn_s_setprio(1);
        for (int it = vcu; it < 768; it += G) {
            if (it < 256) {
                const int b = it >> 5, h = (it >> 2) & 7, pp = it & 3;
#pragma unroll 1
                for (int k = 0; k < 2; ++k) {
                    const int qb = k == 0 ? 7 - pp : pp;
                    const size_t row0 = (size_t)b * SEQ + qb * 256;
                    attn_unit<96, 0>(lds, qbuf + row0 * QW + h * 96, QW, knope + (size_t)b * SEQ * 512 + h * 64, 512, proj + (size_t)b * SEQ * NPROJ + 640, NPROJ,
                                     vtm + (size_t)(b * 8 + h) * 64 * SEQ, mix + row0 * DM + h * 64, qb * 256, 0, 4 * qb + 3, 0.f, 0.f, tid, wave, lane);
                }
            } else {
                const int id = it - 256, b = id >> 6, hq = (id >> 3) & 7, qb = id & 7, kvh = hq >> 2;
                const size_t row0 = (size_t)b * SEQ + qb * 256;
                const float slope2 = exp2f(-(float)(hq + 1)) * LOG2E, sink2 = sinks[hq] * LOG2E;
                attn_unit<64, 1>(lds, proj + row0 * NPROJ + 672 + hq * 64, NPROJ, proj + (size_t)b * SEQ * NPROJ + 1184 + kvh * 64, NPROJ, nullptr, 0,
                                 vts + (size_t)(b * 2 + kvh) * 64 * SEQ, mix + row0 * DM + 512 + hq * 64, qb * 256, qb == 0 ? 0 : 4 * qb - 2, 4 * qb + 3, slope2, sink2, tid, wave, lane);
            }
        }
        __builtin_amdgcn_s_setprio(0);
        __syncthreads();
    }
    }
    SEAM(4);
    STAMP(5);
    if (IN(5)) {
        pg8::Gemm g{mix, wo_t, MT, DM, DM, DM}; pg8::StaticOrder S; S.init(MT, DM, G, bx);
        EpiResNorm E{x, x1b, hbuf, mod, norm_mlp_g, PanelX{(float*)(ws + WS_SSQX1), (unsigned*)(ws + WS_CNT)}};
        pg8::gemm_phase<EpiResNorm, false>(lds, g, S, E);
    }
    if (IN(5) && IN(7)) { pg8::StaticOrder S; S.init(MT, DM, G, bx); pg8::Unit u; S.next(0, u); team_wait((unsigned*)(ws + WS_CNT) + 2 * 64 * 64 + 64 * u.pm); }
    STAMP(6);
    REP(7) { if (rep_) GSYNC();
    if (IN(7)) {
        pg8::Gemm g{hbuf, wup_t, MT, FF, DM, DM}; pg8::StaticOrder S; S.init(MT, FF, G, bx);
        EpiUp E{ubuf};
        pg8::gemm_phase<EpiUp, true>(lds, g, S, E);
    }
    }
    if (IN(7) && IN(8)) { pg8::StaticOrder S; S.init(MT, DM, G, bx); pg8::Unit u; S.next(0, u); team_wait((unsigned*)(ws + WS_CNT) + 3 * 64 * 64 + 64 * u.pm); }
    STAMP(7);
    if (IN(8)) {
        pg8::Gemm g{ubuf, wdn_t, MT, DM, FF, FF}; pg8::StaticOrder S; S.init(MT, DM, G, bx);
        EpiResFinal E{x1b, out, mod, final_g, PanelX{(float*)(ws + WS_SSQX2), (unsigned*)(ws + WS_CNT) + 64 * 64}};
        pg8::gemm_phase<EpiResFinal, false>(lds, g, S, E);
    }
    STAMP(8);
    if (TPROBE >= 0 && bx == 0 && wave == 0) { const unsigned long long tgt = __builtin_amdgcn_s_memrealtime() + 4ull * (tp1 - tp0); while (__builtin_amdgcn_s_memrealtime() < tgt) __builtin_amdgcn_s_sleep(8); }
#undef IN
#undef SEAM
}

extern "C" void kernel_launch(void* const* d_in, const int* in_sizes, int n_in, void* d_out, int out_size, void* d_ws, size_t ws_size, hipStream_t stream) {
    static int grid = 0;
    if (grid == 0) {
        if (n_in != 16 || out_size != MT * DM || ws_size < WS_END) { fprintf(stderr, "kernel_launch: unexpected shapes (n_in %d out %d ws %zu)\n", n_in, out_size, ws_size); grid = -1; return; }
        int dev = 0, cus = 0, per_cu = 0;
        hipGetDevice(&dev);
        hipDeviceGetAttribute(&cus, hipDeviceAttributeMultiprocessorCount, dev);
        if (hipFuncSetAttribute((const void*)fwd_megakernel, hipFuncAttributeMaxDynamicSharedMemorySize, LDS_BYTES) != hipSuccess) { fprintf(stderr, "kernel_launch: hipFuncSetAttribute failed\n"); }
        if (hipOccupancyMaxActiveBlocksPerMultiprocessor(&per_cu, (const void*)fwd_megakernel, 512, LDS_BYTES) != hipSuccess || per_cu < 1) { fprintf(stderr, "kernel_launch: occupancy query says %d\n", per_cu); per_cu = 1; }
        (void)hipGetLastError();
        grid = cus * per_cu;
        if (grid != 256) { fprintf(stderr, "kernel_launch: this kernel needs exactly 256 co-resident workgroups (one per CU), got %d\n", grid); grid = -1; return; }
    }
    if (grid < 0) return;
    hipMemsetAsync((char*)d_ws + WS_SSQQ, 0, WS_ZERO_BYTES - WS_SSQQ, stream);
    Args a{};
    for (int i = 0; i < 16; ++i) a.in[i] = (const float*)d_in[i];
    a.out = (float*)d_out; a.ws = (unsigned char*)d_ws;
#if MK_PER_PHASE
    for (int p = 0; p < NPHASE; ++p) {
        a.ph_lo = p; a.ph_hi = p + 1;
        hipLaunchKernelGGL(fwd_megakernel, dim3(grid), dim3(512), LDS_BYTES, stream, a);
    }
#else
    a.ph_lo = 0; a.ph_hi = NPHASE;
    void* kargs[] = {&a};
    hipError_t e = hipLaunchCooperativeKernel((const void*)fwd_megakernel, dim3(grid), dim3(512), kargs, LDS_BYTES, stream);
    if (e != hipSuccess) fprintf(stderr, "cooperative launch failed: %s (grid %d)\n", hipGetErrorString(e), grid);
#endif
}
```
